# Optimizing an MI355X kernel written in HIP

```python
import math
import jax, jax.numpy as jnp
from jax import lax
import numpy as np

D_MODEL = 1024
BATCH = 2
SEQ = 8192
DEPTH = 4

N_MIXERS = 2
FOURIER_GROUPS = 4
GROUP_DIM = D_MODEL // FOURIER_GROUPS
HEAD_DIM = 64
N_HEADS = D_MODEL // HEAD_DIM
N_KV_HEADS = N_HEADS // 4
GQA_GROUP = N_HEADS // N_KV_HEADS
WINDOW = 128
BLOCK = 128
N_BUCKETS = 32
MAX_DISTANCE = 128
N_EXPERTS = 16
CAPACITY_FACTOR = 2
D_EXPERT = 2 * D_MODEL
EPS = 1e-6
NEG_INF = -1e30
N_FOURIER_LAYERS = (DEPTH + 1) // 2
N_ATTN_LAYERS = DEPTH // 2

kernel_name = "hybrid_fnet_swa_ec_moe_encoder"


def rms_norm(x, gain):
    xf = x.astype(jnp.float32)
    y = xf * lax.rsqrt(jnp.mean(xf * xf, axis=-1, keepdims=True) + EPS)
    return (y * gain.astype(jnp.float32)).astype(x.dtype)


def modulate(x, gain, shift, scale):
    return rms_norm(x, gain) * (1 + scale[:, None, :]) + shift[:, None, :]


def t5_buckets(rel):
    half = N_BUCKETS // 2
    max_exact = half // 2
    ret = jnp.where(rel > 0, half, 0)
    n = jnp.abs(rel)
    nf = jnp.maximum(n, 1).astype(jnp.float32)
    large = max_exact + (jnp.log(nf / max_exact) / math.log(MAX_DISTANCE / max_exact)
                         * (half - max_exact)).astype(jnp.int32)
    large = jnp.minimum(large, half - 1)
    return ret + jnp.where(n < max_exact, n, large)


def fourier_mix(h, w_out):
    B, S, D = h.shape
    hg = h.astype(jnp.float32).reshape(B, S, FOURIER_GROUPS, GROUP_DIM)
    mixed = jnp.fft.fft2(hg, axes=(1, 3), norm="ortho").real
    return mixed.reshape(B, S, D).astype(h.dtype) @ w_out


def windowed_gqa(h, w_qkv, w_out, q_gain, k_gain, sink, rel_bias):
    B, S, D = h.shape
    nb = S // BLOCK
    qkv = h @ w_qkv
    q, k, v = jnp.split(qkv, [N_HEADS * HEAD_DIM, (N_HEADS + N_KV_HEADS) * HEAD_DIM], axis=-1)
    q = rms_norm(q.reshape(B, S, N_HEADS, HEAD_DIM), q_gain)
    k = rms_norm(k.reshape(B, S, N_KV_HEADS, HEAD_DIM), k_gain)
    v = v.reshape(B, S, N_KV_HEADS, HEAD_DIM)
    qb = q.reshape(B, nb, BLOCK, N_KV_HEADS, GQA_GROUP, HEAD_DIM)

    def band(t):
        tp = jnp.pad(t, ((0, 0), (BLOCK, BLOCK), (0, 0), (0, 0)))
        tp = tp.reshape(B, nb + 2, BLOCK, N_KV_HEADS, HEAD_DIM)
        return jnp.concatenate([tp[:, :-2], tp[:, 1:-1], tp[:, 2:]], axis=2)

    kb, vb = band(k), band(v)
    scores = jnp.einsum('bnqhgd,bnjhd->bnhgqj', qb, kb).astype(jnp.float32) * (HEAD_DIM ** -0.5)

    q_off = jnp.arange(BLOCK)
    k_off = jnp.arange(3 * BLOCK) - BLOCK
    rel = k_off[None, :] - q_off[:, None]
    bias = rel_bias.astype(jnp.float32)[t5_buckets(rel)]
    bias = jnp.transpose(bias, (2, 0, 1)).reshape(N_KV_HEADS, GQA_GROUP, BLOCK, 3 * BLOCK)
    key_pos = jnp.arange(nb)[:, None] * BLOCK + k_off[None, :]
    valid = (jnp.abs(rel) <= WINDOW)[None] & ((key_pos >= 0) & (key_pos < S))[:, None, :]
    scores = jnp.where(valid[None, :, None, None], scores + bias, NEG_INF)

    sink_l = sink.astype(jnp.float32).reshape(N_KV_HEADS, GQA_GROUP)[None, None, :, :, None, None]
    m = jnp.maximum(scores.max(axis=-1, keepdims=True), sink_l)
    p = jnp.exp(scores - m)
    probs = (p / (p.sum(axis=-1, keepdims=True) + jnp.exp(sink_l - m))).astype(h.dtype)
    out = jnp.einsum('bnhgqj,bnjhd->bnqhgd', probs, vb).reshape(B, S, D)
    return out @ w_out


def ec_moe(h, w_router, w_gate, w_up, w_down):
    B, S, D = h.shape
    cap = CAPACITY_FACTOR * S // N_EXPERTS
    logits = jnp.einsum('bsd,de->bse', h, w_router).astype(jnp.float32)
    affinity = jax.nn.softmax(logits, axis=-1)
    gate, idx = lax.top_k(jnp.swapaxes(affinity, 1, 2), cap)
    xin = jax.vmap(lambda hb, ib: hb[ib])(h, idx)
    g = jnp.einsum('becd,edf->becf', xin, w_gate)
    u = jnp.einsum('becd,edf->becf', xin, w_up)
    y = jnp.einsum('becf,efd->becd', jax.nn.silu(g) * u, w_down)
    y = y * gate[..., None].astype(y.dtype)
    flat_idx = (idx + jnp.arange(B)[:, None, None] * S).reshape(-1)
    out = jnp.zeros((B * S, D), dtype=y.dtype).at[flat_idx].add(y.reshape(-1, D))
    return out.reshape(B, S, D)


def setup_inputs(seed: int = 0) -> dict:
    key = jax.random.key(seed)
    ks = jax.random.split(key, 20)
    D, F, E = D_MODEL, D_EXPERT, N_EXPERTS
    QKV = (N_HEADS + 2 * N_KV_HEADS) * HEAD_DIM
    nrm = jax.random.normal
    f32 = jnp.float32
    return {
        "x": nrm(ks[0], (BATCH, SEQ, D), f32),
        "c": nrm(ks[1], (BATCH, D), f32),
        "w_ada": nrm(ks[2], (DEPTH, D, 6 * D), f32) * (0.5 * D ** -0.5),
        "b_ada": nrm(ks[3], (DEPTH, 6 * D), f32) * 0.01,
        "norm_mix": 1.0 + 0.02 * nrm(ks[4], (DEPTH, D), f32),
        "norm_ffn": 1.0 + 0.02 * nrm(ks[5], (DEPTH, D), f32),
        "w_fourier_out": nrm(ks[6], (N_FOURIER_LAYERS, D, D), f32) * D ** -0.5,
        "w_qkv": nrm(ks[7], (N_ATTN_LAYERS, D, QKV), f32) * D ** -0.5,
        "w_attn_out": nrm(ks[8], (N_ATTN_LAYERS, N_HEADS * HEAD_DIM, D), f32) * (N_HEADS * HEAD_DIM) ** -0.5,
        "q_gain": 1.0 + 0.02 * nrm(ks[9], (N_ATTN_LAYERS, HEAD_DIM), f32),
        "k_gain": 1.0 + 0.02 * nrm(ks[10], (N_ATTN_LAYERS, HEAD_DIM), f32),
        "sink": nrm(ks[11], (N_ATTN_LAYERS, N_HEADS), f32),
        "rel_bias": 0.5 * nrm(ks[12], (N_BUCKETS, N_HEADS), f32),
        "w_router": nrm(ks[13], (DEPTH, D, E), f32) * D ** -0.5,
        "w_gate": nrm(ks[14], (DEPTH, E, D, F), f32) * D ** -0.5,
        "w_up": nrm(ks[15], (DEPTH, E, D, F), f32) * D ** -0.5,
        "w_down": nrm(ks[16], (DEPTH, E, F, D), f32) * F ** -0.5,
    }


def reference(x, c, w_ada, b_ada, norm_mix, norm_ffn, w_fourier_out, w_qkv, w_attn_out,
              q_gain, k_gain, sink, rel_bias, w_router, w_gate, w_up, w_down):
    c_act = jax.nn.silu(c)
    for layer in range(DEPTH):
        mod = c_act @ w_ada[layer] + b_ada[layer]
        sh1, sc1, g1, sh2, sc2, g2 = jnp.split(mod, 6, axis=-1)
        h = modulate(x, norm_mix[layer], sh1, sc1)
        j = layer // N_MIXERS
        if layer % N_MIXERS == 0:
            y = fourier_mix(h, w_fourier_out[j])
        else:
            y = windowed_gqa(h, w_qkv[j], w_attn_out[j], q_gain[j], k_gain[j], sink[j], rel_bias)
        x = x + g1[:, None, :] * y
        h = modulate(x, norm_ffn[layer], sh2, sc2)
        x = x + g2[:, None, :] * ec_moe(h, w_router[layer], w_gate[layer], w_up[layer], w_down[layer])
    return x
```

```cpp
#include <hip/hip_runtime.h>
#include <math.h>
#include <stdint.h>

namespace gold {
constexpr int D = 1024, NB = 2, S = 8192, DEPTH = 4, T = NB * S;
constexpr int NG = 4, GD = 256, HD = 64, NH = 16, NKV = 4, WIN = 128, NE = 16, CAP = 1024, DE = 2048, QKVN = 1536;
constexpr float EPS = 1e-6f;

__device__ __forceinline__ float wave_sum(float v) {
#pragma unroll
    for (int o = 1; o < 64; o <<= 1) v += __shfl_xor(v, o);
    return v;
}
__device__ __forceinline__ float wave_max(float v) {
#pragma unroll
    for (int o = 1; o < 64; o <<= 1) v = fmaxf(v, __shfl_xor(v, o));
    return v;
}
__device__ __forceinline__ float siluf(float x) { return x / (1.f + expf(-x)); }

__global__ void k_tables(float* ctab, float* stab, float* dftmat, float* biasrel, const float* rel_bias) {
    const int i = blockIdx.x * blockDim.x + threadIdx.x;
    if (i < S) { ctab[i] = (float)cospi(2.0 * i / S); stab[i] = (float)sinpi(2.0 * i / S); }
    if (i < GD * 2 * GD) { const int n = i / (2 * GD), j = i % (2 * GD), cs = j / GD, m = j % GD; const int p = (n * m) % GD;
        dftmat[i] = cs ? (float)sinpi(2.0 * p / GD) : (float)cospi(2.0 * p / GD); }
    if (i < NH * 257) { const int h = i / 257, r = i % 257, rel = r - 128; const int n = rel < 0 ? -rel : rel;
        int bk;
        if (n < 8) bk = n; else { bk = 8 + (n >= 12) + (n >= 16) + (n >= 23) + (n >= 32) + (n >= 46) + (n >= 64) + (n >= 91); }
        bk += (rel > 0) ? 16 : 0;
        biasrel[i] = rel_bias[bk * NH + h]; }
}
__global__ void k_mod(const float* c, const float* w_ada, const float* b_ada, float* mod) {
    const int gid = blockIdx.x * blockDim.x + threadIdx.x;
    if (gid >= DEPTH * 6 * D) return;
    const int l = gid / (6 * D), j = gid % (6 * D);
    const float* w = w_ada + (size_t)l * D * 6 * D + j;
    float a0 = 0.f, a1 = 0.f;
    for (int i = 0; i < D; ++i) { const float wv = w[(size_t)i * 6 * D]; a0 += siluf(c[i]) * wv; a1 += siluf(c[D + i]) * wv; }
    mod[((size_t)l * NB + 0) * 6 * D + j] = a0 + b_ada[l * 6 * D + j];
    mod[((size_t)l * NB + 1) * 6 * D + j] = a1 + b_ada[l * 6 * D + j];
}
__global__ void k_modulate(const float* x, const float* gain, const float* sh, const float* sc, float* h) {
    const int row = blockIdx.x * (blockDim.x / 64) + (threadIdx.x >> 6), lane = threadIdx.x & 63;
    if (row >= T) return;
    const int b = row / S;
    const float* xr = x + (size_t)row * D; float v[16]; float ss = 0.f;
#pragma unroll
    for (int j = 0; j < 16; ++j) { v[j] = xr[lane + 64 * j]; ss += v[j] * v[j]; }
    const float r = rsqrtf(wave_sum(ss) * (1.f / D) + EPS);
#pragma unroll
    for (int j = 0; j < 16; ++j) { const int cidx = lane + 64 * j; h[(size_t)row * D + cidx] = v[j] * r * gain[cidx] * (1.f + sc[b * 6 * D + cidx]) + sh[b * 6 * D + cidx]; }
}

struct APlain { const float* A; long long lda; size_t zstride;
    __device__ __forceinline__ float4 load4(int z, int row, int k) const { return *(const float4*)(A + (size_t)z * zstride + (size_t)row * lda + k); } };
struct AGather { const float* A; long long lda; const int* idx;
    __device__ __forceinline__ float4 load4(int z, int row, int k) const { const int tok = (z / NE) * S + idx[z * CAP + row]; return *(const float4*)(A + (size_t)tok * lda + k); } };
struct ADft { const float* ct; const float* st;
    __device__ __forceinline__ float4 load4(int z, int row, int k) const { const int s0 = k >> 1; const int p0 = (row * s0) & (S - 1), p1 = (row * (s0 + 1)) & (S - 1);
        return make_float4(ct[p0], -st[p0], ct[p1], -st[p1]); } };
struct BPlain { const float* B; long long ldb; size_t zstride; __device__ __forceinline__ const float* ptr(int z) const { return B + (size_t)z * zstride; } };
struct BExpert { const float* B; long long ldb; size_t estride; __device__ __forceinline__ const float* ptr(int z) const { return B + (size_t)(z % NE) * estride; } };

template <class AL, class BL, class EP>
__global__ __launch_bounds__(256) void sgemm(AL al, BL bl, EP ep, int K) {
    __shared__ float As[16][128 + 4];
    __shared__ float Bs[16][128 + 4];
    const int t = threadIdx.x, z = blockIdx.z, m0 = blockIdx.y * 128, n0 = blockIdx.x * 128;
    const int ty = t / 16, tx = t % 16;
    const float* Bp = bl.ptr(z);
    float acc[8][8];
#pragma unroll
    for (int i = 0; i < 8; ++i)
#pragma unroll
        for (int j = 0; j < 8; ++j) acc[i][j] = 0.f;
    const int ar = t / 2, ak = (t % 2) * 8;
    const int br = t / 16, bc = (t % 16) * 8;
    for (int k0 = 0; k0 < K; k0 += 16) {
        const float4 a0 = al.load4(z, m0 + ar, k0 + ak), a1 = al.load4(z, m0 + ar, k0 + ak + 4);
        const float4 b0 = *(const float4*)(Bp + (size_t)(k0 + br) * bl.ldb + n0 + bc), b1 = *(const float4*)(Bp + (size_t)(k0 + br) * bl.ldb + n0 + bc + 4);
        __syncthreads();
        As[ak + 0][ar] = a0.x; As[ak + 1][ar] = a0.y; As[ak + 2][ar] = a0.z; As[ak + 3][ar] = a0.w;
        As[ak + 4][ar] = a1.x; As[ak + 5][ar] = a1.y; As[ak + 6][ar] = a1.z; As[ak + 7][ar] = a1.w;
        *(float4*)&Bs[br][bc] = b0; *(float4*)&Bs[br][bc + 4] = b1;
        __syncthreads();
#pragma unroll
        for (int k = 0; k < 16; ++k) {
            float a[8], b[8];
            const float4 x0 = *(const float4*)&As[k][ty * 8], x1 = *(const float4*)&As[k][ty * 8 + 4];
            const float4 y0 = *(const float4*)&Bs[k][tx * 8], y1 = *(const float4*)&Bs[k][tx * 8 + 4];
            a[0] = x0.x; a[1] = x0.y; a[2] = x0.z; a[3] = x0.w; a[4] = x1.x; a[5] = x1.y; a[6] = x1.z; a[7] = x1.w;
            b[0] = y0.x; b[1] = y0.y; b[2] = y0.z; b[3] = y0.w; b[4] = y1.x; b[5] = y1.y; b[6] = y1.z; b[7] = y1.w;
#pragma unroll
            for (int i = 0; i < 8; ++i)
#pragma unroll
                for (int j = 0; j < 8; ++j) acc[i][j] += a[i] * b[j];
        }
    }
#pragma unroll
    for (int i = 0; i < 8; ++i)
#pragma unroll
        for (int j = 0; j < 8; ++j) ep(z, m0 + ty * 8 + i, n0 + tx * 8 + j, acc[i][j]);
}
struct EpStore { float* C; long long ldc; size_t zstride; float scale; float pad;
    __device__ __forceinline__ void operator()(int z, int r, int c, float v) const { C[(size_t)z * zstride + (size_t)r * ldc + c] = v * scale; } };
struct EpChanDft { float* Z;
    __device__ __forceinline__ void operator()(int z, int r, int c, float v) const { const int cs = c / GD, m = c % GD; Z[(size_t)r * 2 * D + cs * D + z * GD + m] = v; } };
struct EpResid { float* x; const float* gate;
    __device__ __forceinline__ void operator()(int z, int r, int c, float v) const { const int b = r / S; x[(size_t)r * D + c] += gate[b * 6 * D + c] * v; } };

__global__ void k_qknorm(float* qkv, const float* qg, const float* kg) {
    const int w = blockIdx.x * (blockDim.x / 64) + (threadIdx.x >> 6), lane = threadIdx.x & 63;
    if (w >= T * 20) return;
    const int row = w / 20, hs = w % 20;
    float* p = qkv + (size_t)row * QKVN + hs * HD + lane;
    const float v = *p; const float r = rsqrtf(wave_sum(v * v) * (1.f / HD) + EPS);
    *p = v * r * (hs < NH ? qg[lane] : kg[lane]);
}
__global__ void k_attn(const float* qkv, const float* biasrel, const float* sink, float* o) {
    __shared__ float qs[64]; __shared__ float ps[320];
    const int row = blockIdx.x / NH, h = blockIdx.x % NH, b = row / S, s = row % S, lane = threadIdx.x, kvh = h / 4;
    qs[lane] = qkv[(size_t)row * QKVN + h * HD + lane];
    __syncthreads();
    const int lo = max(0, s - WIN), hi = min(S - 1, s + WIN), nk = hi - lo + 1;
    float sc[5]; float mx = -1e30f;
#pragma unroll
    for (int u = 0; u < 5; ++u) { const int j = lane + 64 * u; sc[u] = -1e30f;
        if (j < nk) { const int kp = lo + j; const float* kr = qkv + ((size_t)b * S + kp) * QKVN + NH * HD + kvh * HD; float d = 0.f;
            for (int e = 0; e < HD; ++e) d += qs[e] * kr[e];
            sc[u] = d * 0.125f + biasrel[h * 257 + (kp - s + 128)]; }
        mx = fmaxf(mx, sc[u]); }
    const float sk = sink[h];
    const float m = fmaxf(wave_max(mx), sk);
    float psum = 0.f;
#pragma unroll
    for (int u = 0; u < 5; ++u) { const int j = lane + 64 * u; if (j < nk) { const float p = expf(sc[u] - m); ps[j] = p; psum += p; } }
    const float den = wave_sum(psum) + expf(sk - m);
    __syncthreads();
    float acc = 0.f;
    for (int j = 0; j < nk; ++j) acc += ps[j] * qkv[((size_t)b * S + lo + j) * QKVN + (NH + NKV) * HD + kvh * HD + lane];
    o[(size_t)row * D + h * HD + lane] = acc / den;
}

__global__ void k_router(const float* h2, const float* wr, float* aff) {
    const int row = blockIdx.x * (blockDim.x / 64) + (threadIdx.x >> 6), lane = threadIdx.x & 63;
    if (row >= T) return;
    float p[NE];
#pragma unroll
    for (int e = 0; e < NE; ++e) p[e] = 0.f;
    for (int j = 0; j < 16; ++j) { const int d = lane + 64 * j; const float hv = h2[(size_t)row * D + d];
#pragma unroll
        for (int e = 0; e < NE; ++e) p[e] += hv * wr[d * NE + e]; }
    float mx = -1e30f;
#pragma unroll
    for (int e = 0; e < NE; ++e) { p[e] = wave_sum(p[e]); mx = fmaxf(mx, p[e]); }
    float sum = 0.f;
#pragma unroll
    for (int e = 0; e < NE; ++e) { p[e] = expf(p[e] - mx); sum += p[e]; }
    const int b = row / S, s = row % S;
    if (lane < NE) { float v = 0.f;
#pragma unroll
        for (int e = 0; e < NE; ++e) v = (lane == e) ? p[e] : v;
        aff[((size_t)b * NE + lane) * S + s] = v / sum; }
}
__global__ __launch_bounds__(1024) void k_topk(const float* aff, int* idx, float* gate, int* slotmap) {
    __shared__ float a[S];
    const int z = blockIdx.x, t = threadIdx.x;
    for (int i = t; i < S; i += 1024) a[i] = aff[(size_t)z * S + i];
    __syncthreads();
    float mine[8]; int rank[8];
#pragma unroll
    for (int u = 0; u < 8; ++u) { mine[u] = a[t + 1024 * u]; rank[u] = 0; }
    for (int j = 0; j < S; ++j) { const float v = a[j];
#pragma unroll
        for (int u = 0; u < 8; ++u) rank[u] += (v > mine[u] || (v == mine[u] && j < t + 1024 * u)) ? 1 : 0; }
#pragma unroll
    for (int u = 0; u < 8; ++u) { const int i = t + 1024 * u;
        if (rank[u] < CAP) { idx[z * CAP + rank[u]] = i; gate[z * CAP + rank[u]] = mine[u]; slotmap[(size_t)z * S + i] = rank[u]; }
        else slotmap[(size_t)z * S + i] = -1; }
}
__global__ void k_swiglu(float* g, const float* u, size_t n) { const size_t i = (size_t)blockIdx.x * blockDim.x + threadIdx.x; if (i < n) g[i] = siluf(g[i]) * u[i]; }
__global__ void k_combine(float* x, const float* Y, const float* gate, const int* slotmap, const float* g2) {
    const int row = blockIdx.x, b = row / S, s = row % S, c = threadIdx.x * 4;
    float4 acc = make_float4(0.f, 0.f, 0.f, 0.f);
    for (int e = 0; e < NE; ++e) { const int z = b * NE + e; const int sl = slotmap[(size_t)z * S + s];
        if (sl >= 0) { const float gt = gate[z * CAP + sl]; const float4 y = *(const float4*)(Y + ((size_t)z * CAP + sl) * D + c);
            acc.x += gt * y.x; acc.y += gt * y.y; acc.z += gt * y.z; acc.w += gt * y.w; } }
    float4* xp = (float4*)(x + (size_t)row * D + c); float4 xv = *xp; const float* g = g2 + b * 6 * D + c;
    xv.x += g[0] * acc.x; xv.y += g[1] * acc.y; xv.z += g[2] * acc.z; xv.w += g[3] * acc.w; *xp = xv;
}
}

extern "C" void kernel_launch(void* const* d_in, const int* in_sizes, int n_in, void* d_out, int out_size, void* d_ws, size_t ws_size, hipStream_t stream) {
    using namespace gold;
    const float* x_in = (const float*)d_in[0]; const float* c = (const float*)d_in[1]; const float* w_ada = (const float*)d_in[2]; const float* b_ada = (const float*)d_in[3];
    const float* norm_mix = (const float*)d_in[4]; const float* norm_ffn = (const float*)d_in[5]; const float* w_fo = (const float*)d_in[6]; const float* w_qkv = (const float*)d_in[7];
    const float* w_ao = (const float*)d_in[8]; const float* q_gain = (const float*)d_in[9]; const float* k_gain = (const float*)d_in[10]; const float* sink = (const float*)d_in[11];
    const float* rel_bias = (const float*)d_in[12]; const float* w_router = (const float*)d_in[13]; const float* w_gate = (const float*)d_in[14]; const float* w_up = (const float*)d_in[15];
    const float* w_down = (const float*)d_in[16];
    float* x = (float*)d_out;
    float* ws = (float*)d_ws; size_t off = 0;
    auto take = [&](size_t n) { float* p = ws + off; off += (n + 63) & ~(size_t)63; return p; };
    float* mod = take((size_t)DEPTH * NB * 6 * D); float* ctab = take(S); float* stab = take(S); float* dftmat = take(GD * 2 * GD); float* biasrel = take(NH * 257);
    float* h = take((size_t)T * D); float* Z = take((size_t)T * 2 * D); float* mixed = take((size_t)T * D); float* qkv = take((size_t)T * QKVN); float* ao = take((size_t)T * D);
    float* aff = take((size_t)NB * NE * S); int* idx = (int*)take((size_t)NB * NE * CAP); float* gate = take((size_t)NB * NE * CAP); int* slotmap = (int*)take((size_t)NB * NE * S);
    float* G = take((size_t)NB * NE * CAP * DE); float* U = take((size_t)NB * NE * CAP * DE); float* Y = take((size_t)NB * NE * CAP * D);
    if (off * 4 > ws_size) return;

    hipMemcpyAsync(x, x_in, (size_t)T * D * 4, hipMemcpyDeviceToDevice, stream);
    k_tables<<<(GD * 2 * GD + 255) / 256, 256, 0, stream>>>(ctab, stab, dftmat, biasrel, rel_bias);
    k_mod<<<(DEPTH * 6 * D + 255) / 256, 256, 0, stream>>>(c, w_ada, b_ada, mod);
    const float fscale = 1.0f / sqrtf((float)S * GD);
    for (int l = 0; l < DEPTH; ++l) {
        const float* m = mod + (size_t)l * NB * 6 * D;
        const int j = l / 2;
        k_modulate<<<T / 4, 256, 0, stream>>>(x, norm_mix + l * D, m + 0 * D, m + 1 * D, h);
        if (l % 2 == 0) {
            sgemm<<<dim3(512 / 128, T / 128, NG), 256, 0, stream>>>(APlain{h, D, (size_t)GD}, BPlain{dftmat, 2 * GD, 0}, EpChanDft{Z}, GD);
            sgemm<<<dim3(D / 128, S / 128, NB), 256, 0, stream>>>(ADft{ctab, stab}, BPlain{Z, D, (size_t)S * 2 * D}, EpStore{mixed, D, (size_t)S * D, fscale, 0.f}, 2 * S);
            sgemm<<<dim3(D / 128, T / 128, 1), 256, 0, stream>>>(APlain{mixed, D, 0}, BPlain{w_fo + (size_t)j * D * D, D, 0}, EpResid{x, m + 2 * D}, D);
        } else {
            sgemm<<<dim3(QKVN / 128, T / 128, 1), 256, 0, stream>>>(APlain{h, D, 0}, BPlain{w_qkv + (size_t)j * D * QKVN, QKVN, 0}, EpStore{qkv, QKVN, 0, 1.f, 0.f}, D);
            k_qknorm<<<T * 20 / 4, 256, 0, stream>>>(qkv, q_gain + j * HD, k_gain + j * HD);
            k_attn<<<T * NH, 64, 0, stream>>>(qkv, biasrel, sink + j * NH, ao);
            sgemm<<<dim3(D / 128, T / 128, 1), 256, 0, stream>>>(APlain{ao, D, 0}, BPlain{w_ao + (size_t)j * D * D, D, 0}, EpResid{x, m + 2 * D}, D);
        }
        k_modulate<<<T / 4, 256, 0, stream>>>(x, norm_ffn + l * D, m + 3 * D, m + 4 * D, h);
        k_router<<<T / 4, 256, 0, stream>>>(h, w_router + (size_t)l * D * NE, aff);
        k_topk<<<NB * NE, 1024, 0, stream>>>(aff, idx, gate, slotmap);
        sgemm<<<dim3(DE / 128, CAP / 128, NB * NE), 256, 0, stream>>>(AGather{h, D, idx}, BExpert{w_gate + (size_t)l * NE * D * DE, DE, (size_t)D * DE}, EpStore{G, DE, (size_t)CAP * DE, 1.f, 0.f}, D);
        sgemm<<<dim3(DE / 128, CAP / 128, NB * NE), 256, 0, stream>>>(AGather{h, D, idx}, BExpert{w_up + (size_t)l * NE * D * DE, DE, (size_t)D * DE}, EpStore{U, DE, (size_t)CAP * DE, 1.f, 0.f}, D);
        k_swiglu<<<(unsigned)(((size_t)NB * NE * CAP * DE + 255) / 256), 256, 0, stream>>>(G, U, (size_t)NB * NE * CAP * DE);
        sgemm<<<dim3(D / 128, CAP / 128, NB * NE), 256, 0, stream>>>(APlain{G, DE, (size_t)CAP * DE}, BExpert{w_down + (size_t)l * NE * DE * D, D, (size_t)DE * D}, EpStore{Y, D, (size_t)CAP * D, 1.f, 0.f}, DE);
        k_combine<<<T, 256, 0, stream>>>(x, Y, gate, slotmap, m + 5 * D);
    }
}
```

```cpp
#include <hip/hip_runtime.h>
#include <math.h>
#include <stdint.h>
#include <stdio.h>

namespace pg8 {
#define PG8_LAS __attribute__((address_space(3)))
typedef unsigned short bf16_t;
typedef short bf16x8 __attribute__((ext_vector_type(8)));
typedef float f32x4 __attribute__((ext_vector_type(4)));
typedef unsigned u32x4 __attribute__((ext_vector_type(4)));
constexpr int BM = 256, BK = 64, HALF = 128, HTB = HALF * BK * 2  , STAGE_BYTES = 8 * HTB, NXCD = 8;

__host__ __device__ __forceinline__ int lds_byte(int r, int c) { const int st = (r >> 4) * 2 + (c >> 5), rr = r & 15, cc = c & 31, ob = rr * 64 + cc * 2; return st * 1024 + (ob ^ (((ob >> 9) & 1) << 5)); }
__host__ __device__ __forceinline__ void stage_rc(int b, int& R, int& C) { const int st = b / 1024, sb = b % 1024, swz = sb ^ (((sb >> 9) & 1) << 5); R = (st >> 1) * 16 + swz / 64; C = (st & 1) * 32 + (swz % 64) / 2; }
__host__ __device__ __forceinline__ int perm32(int rho) { const int n = rho >> 4, i = rho & 15; return 8 * (i >> 2) + 4 * n + (i & 3); }

struct Unit { const char* A; const char* B; int pm, pn; };

__device__ __forceinline__ bool tile_of(int i, int G, int c, int nM, int nN, int wgm, int& tm, int& tn) {
    const int nwg = nM * nN; const long L = (long)i * G + c; if (L >= nwg) return false;
    int wgid = (int)L; { const int q = nwg / NXCD, r = nwg % NXCD, xcd = wgid % NXCD, off = wgid / NXCD; wgid = (xcd < r ? xcd * (q + 1) : r * (q + 1) + (xcd - r) * q) + off; }
    const int nig = wgm * nN, gid = wgid / nig, fm = gid * wgm, gsz = (nM - fm) < wgm ? (nM - fm) : wgm;
    tm = fm + ((wgid % nig) % gsz); tn = (wgid % nig) / gsz; return true;
}

__device__ __forceinline__ unsigned cvt_pk_bf16(float lo, float hi) { unsigned r; asm volatile("v_cvt_pk_bf16_f32 %0, %1, %2" : "=v"(r) : "v"(lo), "v"(hi)); return r; }

template <class Epi, class Sched, int K, int lda, int ldb, bool ALIGN_EPI = true, bool SP2 = true>
__device__ __forceinline__ void gemm_phase(PG8_LAS unsigned char* lds, const Sched& S, const Epi& E) {
    int tid_l = threadIdx.x; asm volatile("" : "+v"(tid_l));
    const int tid = tid_l, wid = __builtin_amdgcn_readfirstlane(tid >> 6), lane = tid & 63, wr = wid >> 2, wc = wid & 3, fr = lane & 15, fq = lane >> 4;
    const int nt = K / BK;
    unsigned voffA[2], voffB[2];
#pragma unroll
    for (int i = 0; i < 2; ++i) { int R, C; stage_rc(tid * 16 + i * 8192, R, C); const int Rb = Epi::PERM ? ((R & ~31) + perm32(R & 31)) : R;
        voffA[i] = (unsigned)(R * lda + C) * 2u; voffB[i] = (unsigned)(Rb * ldb + C) * 2u; }
    const size_t kstep = (size_t)(BK * 2);
    const size_t hstepA = (size_t)HALF * lda * 2, hstepB = (size_t)HALF * ldb * 2;
    const unsigned ldsw = (unsigned)wid * 1024u;
    const int aoff = lds_byte(wr * 64 + fr, fq * 8), boff = lds_byte(wc * 32 + fr, fq * 8);
#define PG8_SA(b, h) (((b) * 2 + (h)) * HTB)
#define PG8_SB(b, h) ((4 + (b) * 2 + (h)) * HTB)
#define PG8_STAGE(bufoff, gbase, voff) do { _Pragma("unroll") for (int _i = 0; _i < 2; ++_i) \
        __builtin_amdgcn_global_load_lds((const unsigned*)((const char*)(gbase) + (voff)[_i]), (PG8_LAS unsigned*)(lds + (bufoff) + ldsw + _i * 8192), 16, 0, 0); } while (0)
#define PG8_LDA(dst, b, h) do { _Pragma("unroll") for (int m = 0; m < 4; ++m) _Pragma("unroll") for (int k = 0; k < 2; ++k) dst[m][k] = *(const PG8_LAS bf16x8*)(lds + PG8_SA(b, h) + aoff + m * 2048 + k * 1024); } while (0)
#define PG8_LDB(dst, b, h) do { _Pragma("unroll") for (int n = 0; n < 2; ++n) _Pragma("unroll") for (int k = 0; k < 2; ++k) dst[n][k] = *(const PG8_LAS bf16x8*)(lds + PG8_SB(b, h) + boff + n * 2048 + k * 1024); } while (0)
#define PG8_MMA(ai, bj, At, Bt) do { __builtin_amdgcn_s_setprio(1); _Pragma("unroll") for (int m = 0; m < 4; ++m) _Pragma("unroll") for (int n = 0; n < 2; ++n) _Pragma("unroll") for (int k = 0; k < 2; ++k) \
        acc[ai][bj][m][n] = __builtin_amdgcn_mfma_f32_16x16x32_bf16(Bt[n][k], At[m][k], acc[ai][bj][m][n], 0, 0, 0); __builtin_amdgcn_s_setprio(0); } while (0)
#define PG8_WAIT_V(n) asm volatile("s_waitcnt vmcnt(" #n ")" ::: "memory")
#define PG8_WAIT_L(n) asm volatile("s_waitcnt lgkmcnt(" #n ")" ::: "memory")
#define PG8_BAR __builtin_amdgcn_s_barrier()
#define PG8_SCHED __builtin_amdgcn_sched_barrier(0)
    Unit cur, nxt; int ui = 0;
    if (!S.next(0, cur)) return;
    f32x4 acc[2][2][4][2];
#pragma unroll
    for (int a = 0; a < 2; ++a)
#pragma unroll
        for (int b = 0; b < 2; ++b)
#pragma unroll
            for (int m = 0; m < 4; ++m)
#pragma unroll
                for (int n = 0; n < 2; ++n) acc[a][b][m][n] = (f32x4){0.f, 0.f, 0.f, 0.f};
    bf16x8 At[4][2], B0[2][2], B1[2][2];
    const char* cA = cur.A; const char* cB = cur.B;
    if constexpr (SP2) {
        PG8_STAGE(PG8_SB(0, 0), cB, voffB); PG8_STAGE(PG8_SB(0, 1), cB + hstepB, voffB); PG8_STAGE(PG8_SA(0, 0), cA, voffA); PG8_STAGE(PG8_SA(0, 1), cA + hstepA, voffA);
        if (wr == 1) PG8_BAR;
        PG8_WAIT_V(2); PG8_BAR;
        PG8_STAGE(PG8_SB(1, 0), cB + kstep, voffB); PG8_STAGE(PG8_SA(1, 0), cA + kstep, voffA); PG8_STAGE(PG8_SB(1, 1), cB + hstepB + kstep, voffB);
        PG8_WAIT_V(6); PG8_BAR;
    } else {
        PG8_STAGE(PG8_SB(0, 0), cB, voffB); PG8_STAGE(PG8_SA(0, 0), cA, voffA); PG8_STAGE(PG8_SB(0, 1), cB + hstepB, voffB); PG8_STAGE(PG8_SA(0, 1), cA + hstepA, voffA);
        if (wr == 1) PG8_BAR;
        PG8_WAIT_V(4); PG8_BAR;
        PG8_STAGE(PG8_SB(1, 0), cB + kstep, voffB); PG8_STAGE(PG8_SA(1, 0), cA + kstep, voffA); PG8_STAGE(PG8_SB(1, 1), cB + hstepB + kstep, voffB);
        PG8_WAIT_V(6); PG8_BAR;
    }
    for (;;) {
        const bool has_next = S.next(ui + 1, nxt);
        const char* nA = has_next ? nxt.A : cA; const char* nB = has_next ? nxt.B : cB;
        for (int t = 0; t < nt; t += 2) {
            const bool last = (t == nt - 2);
            const char* a1 = cA + (size_t)(t + 1) * kstep;
            const char* a2 = last ? nA : cA + (size_t)(t + 2) * kstep; const char* b2 = last ? nB : cB + (size_t)(t + 2) * kstep;
            const char* a3 = a2 + kstep; const char* b3 = b2 + kstep;
            if constexpr (SP2) {
            PG8_LDB(B0, 0, 0); PG8_LDB(B1, 0, 1); PG8_SCHED; PG8_LDA(At, 0, 0); PG8_STAGE(PG8_SA(1, 1), a1 + hstepA, voffA);
            PG8_WAIT_V(8); PG8_WAIT_L(0); PG8_BAR; PG8_MMA(0, 0, At, B0); PG8_MMA(0, 1, At, B1); PG8_BAR; PG8_SCHED;
            PG8_LDA(At, 0, 1); PG8_STAGE(PG8_SB(0, 0), b2, voffB); PG8_STAGE(PG8_SB(0, 1), b2 + hstepB, voffB); PG8_STAGE(PG8_SA(0, 0), a2, voffA);
            PG8_WAIT_V(8); PG8_WAIT_L(0); PG8_BAR; PG8_MMA(1, 0, At, B0); PG8_MMA(1, 1, At, B1); PG8_BAR; PG8_SCHED;
            PG8_LDB(B0, 1, 0); PG8_LDB(B1, 1, 1); PG8_SCHED; PG8_LDA(At, 1, 0); PG8_STAGE(PG8_SA(0, 1), a2 + hstepA, voffA);
            PG8_WAIT_V(8); PG8_WAIT_L(0); PG8_BAR; PG8_MMA(0, 0, At, B0); PG8_MMA(0, 1, At, B1); PG8_BAR; PG8_SCHED;
            PG8_LDA(At, 1, 1); PG8_STAGE(PG8_SB(1, 0), b3, voffB); PG8_STAGE(PG8_SB(1, 1), b3 + hstepB, voffB); PG8_STAGE(PG8_SA(1, 0), a3, voffA);
            PG8_WAIT_V(8); PG8_WAIT_L(0); PG8_BAR; PG8_MMA(1, 0, At, B0); PG8_MMA(1, 1, At, B1); PG8_BAR; PG8_SCHED;
            } else {
            PG8_LDB(B0, 0, 0); PG8_SCHED; PG8_LDA(At, 0, 0); PG8_STAGE(PG8_SA(1, 1), a1 + hstepA, voffA);
            PG8_WAIT_L(8); PG8_BAR; PG8_WAIT_L(0); PG8_MMA(0, 0, At, B0); PG8_BAR; PG8_SCHED;
            PG8_LDB(B1, 0, 1); PG8_STAGE(PG8_SB(0, 0), b2, voffB);
            PG8_BAR; PG8_WAIT_L(0); PG8_MMA(0, 1, At, B1); PG8_BAR;
            PG8_LDA(At, 0, 1); PG8_STAGE(PG8_SA(0, 0), a2, voffA);
            PG8_BAR; PG8_WAIT_L(0); PG8_MMA(1, 0, At, B0); PG8_BAR; PG8_SCHED;
            PG8_STAGE(PG8_SB(0, 1), b2 + hstepB, voffB);
            PG8_WAIT_V(6); PG8_BAR; PG8_MMA(1, 1, At, B1); PG8_BAR;
            PG8_LDB(B0, 1, 0); PG8_SCHED; PG8_LDA(At, 1, 0); PG8_STAGE(PG8_SA(0, 1), a2 + hstepA, voffA);
            PG8_WAIT_L(8); PG8_BAR; PG8_WAIT_L(0); PG8_MMA(0, 0, At, B0); PG8_BAR; PG8_SCHED;
            PG8_LDB(B1, 1, 1); PG8_STAGE(PG8_SB(1, 0), b3, voffB);
            PG8_BAR; PG8_WAIT_L(0); PG8_MMA(0, 1, At, B1); PG8_BAR;
            PG8_LDA(At, 1, 1); PG8_STAGE(PG8_SA(1, 0), a3, voffA);
            PG8_BAR; PG8_WAIT_L(0); PG8_MMA(1, 0, At, B0); PG8_BAR; PG8_SCHED;
            PG8_STAGE(PG8_SB(1, 1), b3 + hstepB, voffB);
            PG8_WAIT_V(6); PG8_BAR; PG8_MMA(1, 1, At, B1); PG8_BAR;
            }
        }
        if constexpr (ALIGN_EPI) { if (wr == 0) PG8_BAR; }
        { int t2 = threadIdx.x; asm volatile("" : "+v"(t2)); const int l2 = t2 & 63; E(acc, cur, wr, wc, l2 & 15, l2 >> 4); }
        if constexpr (false) { E(acc, cur, wr, wc, fr, fq); }
        if (!has_next) break;
#pragma unroll
        for (int a = 0; a < 2; ++a)
#pragma unroll
            for (int b = 0; b < 2; ++b)
#pragma unroll
                for (int m = 0; m < 4; ++m)
#pragma unroll
                    for (int n = 0; n < 2; ++n) acc[a][b][m][n] = (f32x4){0.f, 0.f, 0.f, 0.f};
        cur = nxt; cA = nA; cB = nB; ++ui;
        if constexpr (ALIGN_EPI) { if (wr == 1) PG8_BAR; }
    }
    PG8_WAIT_V(0);
    if constexpr (!ALIGN_EPI) { if (wr == 0) PG8_BAR; }
    PG8_BAR;
    #undef PG8_SA
#undef PG8_SB
#undef PG8_STAGE
#undef PG8_LDA
#undef PG8_LDB
#undef PG8_MMA
#undef PG8_WAIT_V
#undef PG8_WAIT_L
#undef PG8_BAR
#undef PG8_SCHED
}

__device__ __forceinline__ float silu_f(float g) { return g * __builtin_amdgcn_rcpf(1.0f + __builtin_amdgcn_exp2f(-1.44269504f * g)); }
struct EpiSwiGLU { static constexpr bool PERM = true, AFTER_DRAIN = false; bf16_t* O; long long ldc;
    __device__ __forceinline__ void operator()(const f32x4 (&acc)[2][2][4][2], const Unit& u, int wr, int wc, int fr, int fq) const {
        const int row0 = u.pm * BM + wr * 64 + fr, col0 = u.pn * HALF + wc * 32 + 8 * fq;
#pragma unroll
        for (int ai = 0; ai < 2; ++ai)
#pragma unroll
            for (int m = 0; m < 4; ++m) { bf16_t* rowp = O + (size_t)(row0 + ai * HALF + m * 16) * ldc + col0;
                const f32x4 g0 = acc[ai][0][m][0], g1 = acc[ai][0][m][1], u0 = acc[ai][1][m][0], u1 = acc[ai][1][m][1];
                u32x4 w; w.x = cvt_pk_bf16(silu_f(g0[0]) * u0[0], silu_f(g0[1]) * u0[1]); w.y = cvt_pk_bf16(silu_f(g0[2]) * u0[2], silu_f(g0[3]) * u0[3]);
                w.z = cvt_pk_bf16(silu_f(g1[0]) * u1[0], silu_f(g1[1]) * u1[1]); w.w = cvt_pk_bf16(silu_f(g1[2]) * u1[2], silu_f(g1[3]) * u1[3]);
                *(u32x4*)rowp = w; }
    }
};
struct EpiBf16 { static constexpr bool PERM = true, AFTER_DRAIN = false; bf16_t* O; long long ldc; const float* rs; float scale; int coff;
    __device__ __forceinline__ void operator()(const f32x4 (&acc)[2][2][4][2], const Unit& u, int wr, int wc, int fr, int fq) const {
        const int row0 = u.pm * BM + wr * 64 + fr, col0 = coff + u.pn * BM + wc * 32 + 8 * fq;
#pragma unroll
        for (int ai = 0; ai < 2; ++ai)
#pragma unroll
            for (int m = 0; m < 4; ++m) { const int row = row0 + ai * HALF + m * 16; bf16_t* rowp = O + (size_t)row * ldc + col0; const float s = rs ? rs[row] : scale;
#pragma unroll
                for (int bj = 0; bj < 2; ++bj) { const f32x4 v0 = acc[ai][bj][m][0] * s, v1 = acc[ai][bj][m][1] * s;
                    u32x4 w; w.x = cvt_pk_bf16(v0[0], v0[1]); w.y = cvt_pk_bf16(v0[2], v0[3]); w.z = cvt_pk_bf16(v1[0], v1[1]); w.w = cvt_pk_bf16(v1[2], v1[3]);
                    *(u32x4*)(rowp + bj * HALF) = w; } }
    }
};
struct EpiResid { static constexpr bool PERM = false, AFTER_DRAIN = false; float* X; const float* g;
    __device__ __forceinline__ void operator()(const f32x4 (&acc)[2][2][4][2], const Unit& u, int wr, int wc, int fr, int fq) const {
        const int row0 = u.pm * BM + wr * 64 + fr, col0 = u.pn * BM + wc * 32 + 4 * fq;
        const float* gp = g + (size_t)((u.pm * BM) >> 13) * 6144 + col0;
        f32x4 gv[2][2];
#pragma unroll
        for (int bj = 0; bj < 2; ++bj)
#pragma unroll
            for (int n = 0; n < 2; ++n) gv[bj][n] = *(const f32x4*)(gp + bj * HALF + n * 16);
#pragma unroll
        for (int ai = 0; ai < 2; ++ai)
#pragma unroll
            for (int m = 0; m < 4; ++m) { float* rowp = X + (size_t)(row0 + ai * HALF + m * 16) * 1024 + col0;
#pragma unroll
                for (int bj = 0; bj < 2; ++bj)
#pragma unroll
                    for (int n = 0; n < 2; ++n) { f32x4* p = (f32x4*)(rowp + bj * HALF + n * 16); *p = *p + gv[bj][n] * acc[ai][bj][m][n]; } }
    }
};
struct EpiF32 { static constexpr bool PERM = false, AFTER_DRAIN = false; float* C; long long ldc;
    __device__ __forceinline__ void operator()(const f32x4 (&acc)[2][2][4][2], const Unit& u, int wr, int wc, int fr, int fq) const {
        const int row0 = u.pm * BM + wr * 64 + fr, col0 = u.pn * BM + wc * 32 + 4 * fq;
#pragma unroll
        for (int ai = 0; ai < 2; ++ai)
#pragma unroll
            for (int m = 0; m < 4; ++m) { float* rowp = C + (size_t)(row0 + ai * HALF + m * 16) * ldc + col0;
#pragma unroll
                for (int bj = 0; bj < 2; ++bj)
#pragma unroll
                    for (int n = 0; n < 2; ++n) *(f32x4*)(rowp + bj * HALF + n * 16) = acc[ai][bj][m][n]; }
    }
};
struct SchedPlain { const char* A; const char* B; size_t a_tile, b_tile; int nM, nN, G, c, wgm, pad;
    __device__ __forceinline__ bool next(int i, Unit& u) const { int tm, tn; if (!tile_of(i, G, c, nM, nN, wgm, tm, tn)) return false;
        u.pm = tm; u.pn = tn; u.A = A + (size_t)tm * a_tile; u.B = B + (size_t)tn * b_tile; return true; } };
struct SchedMoE { const char* A; const char* B; size_t a_tile, b_tile; int nN, G, c, pad;
    __device__ __forceinline__ bool next(int i, Unit& u) const { int tm, tn; if (!tile_of(i, G, c, 128, nN, 8, tm, tn)) return false;
        const int e = tm >> 3, b = (tm >> 2) & 1, r = tm & 3, pm = ((b * 16 + e) << 2) + r;
        u.pm = pm; u.pn = tn; u.A = A + (size_t)pm * a_tile; u.B = B + (size_t)(e * nN + tn) * b_tile; return true; } };
}

constexpr int D = 1024, NB = 2, S = 8192, DEPTH = 4, T = NB * S;
constexpr int NG = 4, GD = 256, HD = 64, NH = 16, NKV = 4, WIN = 128, NE = 16, CAP = 1024, DE = 2048, QKVN = 1536;
constexpr float EPS = 1e-6f;
constexpr int NWAVES = 8, NTHR = 512;

constexpr size_t MiB = 1u << 20;
constexpr size_t WS_CTL = 0, CTL_ZERO_BYTES = 1 * MiB;
constexpr size_t WS_MOD = 1 * MiB;
constexpr size_t WS_TAB = 2 * MiB;
constexpr size_t WS_MBT = 4 * MiB;
constexpr size_t WS_WQKV = 8 * MiB;
constexpr size_t WS_WAO = 14 * MiB;
constexpr size_t WS_WFO = 18 * MiB;
constexpr size_t WS_WFF = 22 * MiB;
constexpr size_t WS_CS = 30 * MiB;
constexpr size_t WS_AFF = 32 * MiB;
constexpr size_t WS_IDX = 33 * MiB;
constexpr size_t WS_GATE = 33 * MiB + 512 * 1024;
constexpr size_t WS_SLOT = 34 * MiB;
constexpr size_t WS_MISC = 35 * MiB;
constexpr size_t WS_PAR = 36 * MiB;
constexpr int PAR_NMIX = 0, PAR_NFFN = 4096, PAR_QG = 8192, PAR_KG = 8192 + 128, PAR_SINK = 8192 + 256, PAR_WR = 16384;
constexpr size_t WS_H = 64 * MiB;
constexpr size_t WS_XIN = 96 * MiB;
constexpr size_t WS_ACT = 160 * MiB;
constexpr size_t WS_Y = 288 * MiB;
constexpr size_t WS_QKV = 352 * MiB;
constexpr size_t WS_O = 400 * MiB;
constexpr size_t WS_TA = 432 * MiB;
constexpr size_t WS_YF = 464 * MiB;
constexpr size_t WS_PQ = 496 * MiB;
constexpr size_t WS_W1 = 576 * MiB;
constexpr size_t WS_W2 = 1088 * MiB;
constexpr size_t WS_GOLD = 1344 * MiB;
constexpr size_t WS_END = 1792 * MiB;
constexpr int CW_BAR = 4096;

constexpr int RING_BYTES = 133120;
constexpr int MISC_OFF = RING_BYTES;
constexpr int LDS_BYTES = 147456;

#define GAS __attribute__((address_space(1)))
#define LAS __attribute__((address_space(3)))
typedef unsigned short bf16;
typedef unsigned v4u __attribute__((ext_vector_type(4)));
typedef unsigned v2u __attribute__((ext_vector_type(2)));
typedef float f32x4 __attribute__((ext_vector_type(4)));
typedef short bf16x8 __attribute__((ext_vector_type(8)));
#define LDS_WAIT() asm volatile("s_waitcnt lgkmcnt(0)" ::: "memory")
#define VM_WAIT() asm volatile("s_waitcnt vmcnt(0)" ::: "memory")
__device__ __forceinline__ unsigned f2bf(float f) { unsigned u = __builtin_bit_cast(unsigned, f); return (u + 0x7fffu + ((u >> 16) & 1u)) >> 16; }
__device__ __forceinline__ unsigned pk2(float lo, float hi) { return f2bf(lo) | (f2bf(hi) << 16); }
__device__ __forceinline__ float bf_lo(unsigned w) { return __builtin_bit_cast(float, w << 16); }
__device__ __forceinline__ float bf_hi(unsigned w) { return __builtin_bit_cast(float, w & 0xffff0000u); }
__device__ __forceinline__ float shx(float v, int o, int lane) { return __builtin_bit_cast(float, __builtin_amdgcn_ds_bpermute((lane ^ o) << 2, __builtin_bit_cast(int, v))); }
__device__ __forceinline__ unsigned shl_from(unsigned v, int src_lane) { return (unsigned)__builtin_amdgcn_ds_bpermute((src_lane & 63) << 2, (int)v); }
__device__ __forceinline__ float wave_sum(float v, int lane) {
#pragma unroll
    for (int o = 1; o < 64; o <<= 1) v += shx(v, o, lane);
    return v;
}

#define XB_TMO      128
#define XB_XCNT(j)  (256  + 64 * (j))
#define XB_XSUB(j)  (1280 + 64 * (j))
#define XB_XGEN(j)  (2304 + 64 * (j))
#define XB_TOP      3328
#define XB_TOPGEN   3392
#define XCD_BAR_WORDS 3456
#define XB_SPIN_CAP (1u << 18)

__device__ __forceinline__ unsigned xb_ld(unsigned* p)              { return __hip_atomic_load(p, __ATOMIC_RELAXED, __HIP_MEMORY_SCOPE_AGENT); }
__device__ __forceinline__ unsigned xb_add(unsigned* p, unsigned v) { return __hip_atomic_fetch_add(p, v, __ATOMIC_RELAXED, __HIP_MEMORY_SCOPE_AGENT); }
__device__ __forceinline__ unsigned xb_xcc_id() { return (unsigned)__builtin_amdgcn_s_getreg((3 << 11) | 20) & 0xFu; }
#define XB_SPIN(cond, bar) do { unsigned _sp = 0; while (cond) { __builtin_amdgcn_s_sleep(1); \
    if ((++_sp & 255u) == 0u) { if (xb_ld(&(bar)[XB_TMO])) break; if (_sp > XB_SPIN_CAP) { atomicAdd(&(bar)[XB_TMO], 1u); break; } } } } while (0)

struct XcdBarrier {
    unsigned* bar; unsigned x;
    volatile LAS unsigned* st;
};

__device__ __forceinline__ XcdBarrier xcd_barrier_post(unsigned* bar, volatile LAS unsigned* st) {
    XcdBarrier b; b.bar = bar; b.x = xb_xcc_id(); b.st = st;
    if (threadIdx.x == 0) (void)xb_add(&bar[XB_XCNT(b.x)], 1u);
    return b;
}
__device__ __forceinline__ void xcd_barrier_complete(unsigned* bar, unsigned x, unsigned& nloc, unsigned& nx) {
    const unsigned G = gridDim.x * gridDim.y * gridDim.z;
    unsigned sum, cnt, mine, sp = 0u;
    for (;;) {
        sum = 0u; cnt = 0u; mine = 0u;
#pragma unroll
        for (unsigned j = 0; j < 16; ++j) { const unsigned c = xb_ld(&bar[XB_XCNT(j)]); sum += c; cnt += (c > 0u) ? 1u : 0u; mine = (j == x) ? c : mine; }
        if (sum == G) break;
        __builtin_amdgcn_s_sleep(1);
        if ((++sp & 255u) == 0u) { if (xb_ld(&bar[XB_TMO])) break; if (sp > XB_SPIN_CAP) { atomicAdd(&bar[XB_TMO], 1u); break; } }
    }
    nloc = mine > 0u ? mine : 1u; nx = cnt > 0u ? cnt : 1u;
}

__device__ __forceinline__ void xcd_barrier(const XcdBarrier& b) {
    asm volatile("s_waitcnt vmcnt(0)" ::: "memory");
    __syncthreads();
    if (threadIdx.x == 0) {
        unsigned* bar = b.bar;
        __builtin_amdgcn_s_waitcnt(0);
        unsigned nloc = b.st[0], nx = b.st[1];
        if (nloc == 0u) { xcd_barrier_complete(bar, b.x, nloc, nx); b.st[0] = nloc; b.st[1] = nx; }
        const unsigned old = xb_add(&bar[XB_XSUB(b.x)], 1u);
        const unsigned gen = old / nloc;
        if (old + 1u == (gen + 1u) * nloc) {
            __builtin_amdgcn_fence(__ATOMIC_RELEASE, "agent");
            asm volatile("s_waitcnt vmcnt(0)" ::: "memory");
            const unsigned og = xb_add(&bar[XB_TOP], 1u);
            const unsigned tg = og / nx;
            if (og + 1u == (tg + 1u) * nx) xb_add(&bar[XB_TOPGEN], 1u);
            else XB_SPIN(xb_ld(&bar[XB_TOPGEN]) == tg, bar);
            __builtin_amdgcn_fence(__ATOMIC_ACQUIRE, "agent");
            xb_add(&bar[XB_XGEN(b.x)], 1u);
            asm volatile("s_waitcnt vmcnt(0)" ::: "memory");
        } else {
            XB_SPIN(xb_ld(&bar[XB_XGEN(b.x)]) == gen, bar);
            __builtin_amdgcn_fence(__ATOMIC_ACQUIRE, "agent");
            asm volatile("s_waitcnt vmcnt(0)" ::: "memory");
        }
    }
    __syncthreads();
}


struct Params { const float* in[17]; float* out; unsigned char* ws; int ph_lo, ph_hi; };
enum { IN_X = 0, IN_C, IN_WADA, IN_BADA, IN_NMIX, IN_NFFN, IN_WFO, IN_WQKV, IN_WAO, IN_QG, IN_KG, IN_SINK, IN_RELB, IN_WR, IN_WG, IN_WU, IN_WD };
struct Frame { LAS unsigned char* lds; int tid, lane, wave, vcu, G; };

__device__ __forceinline__ void cvt_tile64(const float* __restrict__ src, int N, bf16* __restrict__ dst, int ldk, LAS float* scr, int lane, float scale) {
    f32x4 v[16];
    const int kr = lane >> 4, nc = (lane & 15) * 4;
#pragma unroll
    for (int i = 0; i < 16; ++i) v[i] = *(const GAS f32x4*)(src + (size_t)(4 * i + kr) * N + nc);
#pragma unroll
    for (int i = 0; i < 16; ++i) { LAS float* p = scr + (4 * i + kr) * 65 + nc; p[0] = v[i].x; p[1] = v[i].y; p[2] = v[i].z; p[3] = v[i].w; }
    LDS_WAIT(); asm volatile("" ::: "memory");
    const int c = lane & 7;
#pragma unroll
    for (int j = 0; j < 8; ++j) { const int n = (lane >> 3) + 8 * j; const LAS float* s = scr + (8 * c) * 65 + n;
        v4u o; o.x = pk2(s[0 * 65] * scale, s[1 * 65] * scale); o.y = pk2(s[2 * 65] * scale, s[3 * 65] * scale); o.z = pk2(s[4 * 65] * scale, s[5 * 65] * scale); o.w = pk2(s[6 * 65] * scale, s[7 * 65] * scale);
        *(GAS v4u*)(dst + (size_t)n * ldk + 8 * c) = o; }
    LDS_WAIT(); asm volatile("" ::: "memory");
}

__device__ __forceinline__ void cvt_moe_layer(const Params& p, Frame& F, int l, int w0, int nw) {
    LAS float* scr = (LAS float*)(F.lds + F.wave * 16640);
    bf16* W1 = (bf16*)(p.ws + WS_W1) + (size_t)l * NE * 4096 * 1024; bf16* W2 = (bf16*)(p.ws + WS_W2) + (size_t)l * NE * 1024 * 2048;
    const float* wg = p.in[IN_WG] + (size_t)l * NE * D * DE; const float* wu = p.in[IN_WU] + (size_t)l * NE * D * DE; const float* wd = p.in[IN_WD] + (size_t)l * NE * DE * D;
    for (int it = w0; it < 3 * 8192; it += nw) {
        const int kind = it >> 13, r = it & 8191;
        if (kind < 2) { const int e = r >> 9, kt = (r >> 5) & 15, ntile = r & 31; const int n0 = ntile * 64, k0 = kt * 64;
            const float* src = (kind ? wu : wg) + (size_t)e * D * DE + (size_t)k0 * DE + n0;
            bf16* dst = W1 + ((size_t)e * 4096 + (size_t)(n0 >> 7) * 256 + kind * 128 + (n0 & 127)) * 1024 + k0;
            cvt_tile64(src, DE, dst, 1024, scr, F.lane, 1.0f);
        } else { const int e = r >> 9, kt = (r >> 4) & 31, ntile = r & 15; const int n0 = ntile * 64, k0 = kt * 64;
            const float* src = wd + (size_t)e * DE * D + (size_t)k0 * D + n0;
            bf16* dst = W2 + ((size_t)e * 1024 + n0) * 2048 + k0;
            cvt_tile64(src, D, dst, 2048, scr, F.lane, 1.0f);
        }
    }
}

__device__ __forceinline__ void phase_ma(const Params& p, Frame& F, int l) {
    LAS float* wrp = (LAS float*)F.lds;
    const float* wr = (const float*)(p.ws + WS_PAR) + PAR_WR + (size_t)l * D * NE;
    for (int s = F.tid; s < D * NE; s += NTHR) { const int c = s >> 4, e = s & 15; wrp[(((e * 4 + (c >> 8)) * 4 + (c & 3)) << 6) + ((c & 255) >> 2)] = wr[s]; }
    __syncthreads();
    const float* mod = (const float*)(p.ws + WS_MOD) + (size_t)l * NB * 6 * D;
    const float* gain = (const float*)(p.ws + WS_PAR) + PAR_NFFN + l * D;
    const int gw = F.vcu * NWAVES + F.wave, NGW = F.G * NWAVES;
    const int b = (gw * 2) / NGW, wsub = gw - b * (NGW / 2), nsub = NGW / 2;
    f32x4 Av[4], Bv[4];
#pragma unroll
    for (int j = 0; j < 4; ++j) { const int c = 256 * j + 4 * F.lane; const f32x4 g = *(const f32x4*)(gain + c), sc = *(const f32x4*)(mod + b * 6 * D + 4 * D + c);
        Av[j] = g * (sc + 1.0f); Bv[j] = *(const f32x4*)(mod + b * 6 * D + 3 * D + c); }
    const float* x = p.out; bf16* H = (bf16*)(p.ws + WS_H); float* aff = (float*)(p.ws + WS_AFF);
    for (int s = wsub; s < S; s += nsub) {
        const int row = b * S + s;
        asm volatile("" ::: "memory");
        f32x4 h[4]; float ss = 0.f;
#pragma unroll
        for (int j = 0; j < 4; ++j) { h[j] = *(const GAS f32x4*)(x + (size_t)row * D + 256 * j + 4 * F.lane); ss += (h[j].x * h[j].x + h[j].y * h[j].y) + (h[j].z * h[j].z + h[j].w * h[j].w); }
        const float rstd = rsqrtf(wave_sum(ss, F.lane) * (1.0f / D) + EPS);
#pragma unroll
        for (int j = 0; j < 4; ++j) { h[j] = h[j] * rstd * Av[j] + Bv[j];
            v2u o; o.x = pk2(h[j].x, h[j].y); o.y = pk2(h[j].z, h[j].w); *(GAS v2u*)(H + (size_t)row * D + 256 * j + 4 * F.lane) = o; }
        float v[16];
#pragma unroll
        for (int e = 0; e < 16; ++e) { float a = 0.f;
#pragma unroll
            for (int j = 0; j < 4; ++j) { const LAS float* w = wrp + (((e * 4 + j) * 4) << 6) + F.lane; a += h[j].x * w[0] + h[j].y * w[64] + h[j].z * w[128] + h[j].w * w[192]; }
            v[e] = a; }
        float t8[8], t4[4], t2[2], t1;
        { const bool hi = (F.lane & 32) != 0;
#pragma unroll
          for (int i = 0; i < 8; ++i) { const float send = hi ? v[i] : v[i + 8], keep = hi ? v[i + 8] : v[i]; t8[i] = keep + shx(send, 32, F.lane); } }
        { const bool hi = (F.lane & 16) != 0;
#pragma unroll
          for (int i = 0; i < 4; ++i) { const float send = hi ? t8[i] : t8[i + 4], keep = hi ? t8[i + 4] : t8[i]; t4[i] = keep + shx(send, 16, F.lane); } }
        { const bool hi = (F.lane & 8) != 0;
#pragma unroll
          for (int i = 0; i < 2; ++i) { const float send = hi ? t4[i] : t4[i + 2], keep = hi ? t4[i + 2] : t4[i]; t2[i] = keep + shx(send, 8, F.lane); } }
        { const bool hi = (F.lane & 4) != 0; const float send = hi ? t2[0] : t2[1], keep = hi ? t2[1] : t2[0]; t1 = keep + shx(send, 4, F.lane); }
        t1 += shx(t1, 1, F.lane); t1 += shx(t1, 2, F.lane);
        float mx = t1;
#pragma unroll
        for (int o = 4; o < 64; o <<= 1) mx = fmaxf(mx, shx(mx, o, F.lane));
        const float pe = expf(t1 - mx); float sum = pe;
#pragma unroll
        for (int o = 4; o < 64; o <<= 1) sum += shx(sum, o, F.lane);
        const int e = ((F.lane >> 5) & 1) * 8 + ((F.lane >> 4) & 1) * 4 + ((F.lane >> 3) & 1) * 2 + ((F.lane >> 2) & 1);
        if ((F.lane & 3) == 0) aff[((size_t)b * NE + e) * S + s] = pe / sum;
    }
}

__device__ __forceinline__ void phase_mb(const Params& p, Frame& F) {
    LAS unsigned* hist = (LAS unsigned*)F.lds;
    LAS unsigned* ctl = hist + 256;
    LAS unsigned* wtot = hist + 320;
    const float* aff = (const float*)(p.ws + WS_AFF); int* idx = (int*)(p.ws + WS_IDX); float* gate = (float*)(p.ws + WS_GATE); int* slotmap = (int*)(p.ws + WS_SLOT);
    for (int z = F.vcu; z < NB * NE; z += F.G) {
        unsigned key[16];
#pragma unroll
        for (int q = 0; q < 4; ++q) { const v4u k4 = *(const GAS v4u*)(aff + (size_t)z * S + F.tid * 16 + 4 * q); key[4 * q] = k4.x; key[4 * q + 1] = k4.y; key[4 * q + 2] = k4.z; key[4 * q + 3] = k4.w; }
        unsigned prefix = 0u, need = CAP;
#pragma unroll
        for (int pass = 0; pass < 4; ++pass) {
            const int shift = 24 - 8 * pass;
            __syncthreads();
            if (F.tid < 256) hist[F.tid] = 0u;
            __syncthreads();
#pragma unroll
            for (int u = 0; u < 16; ++u) { const unsigned hi = (pass == 0) ? 0u : (key[u] >> ((shift + 8) & 31)); if (hi == prefix) atomicAdd((unsigned*)&hist[(key[u] >> shift) & 255u], 1u); }
            __syncthreads();
            if (F.wave == 0) {
                const unsigned h0 = hist[4 * F.lane], h1 = hist[4 * F.lane + 1], h2 = hist[4 * F.lane + 2], h3 = hist[4 * F.lane + 3];
                const unsigned tot = h0 + h1 + h2 + h3; unsigned suf = tot;
#pragma unroll
                for (int o = 1; o < 64; o <<= 1) { const unsigned t = shl_from(suf, F.lane + o); if (F.lane + o < 64) suf += t; }
                unsigned cum = suf - tot;
                if (cum < need && need <= cum + tot) {
                    unsigned d = 4 * F.lane + 3, c = h3;
                    if (cum + c < need) { cum += c; d = 4 * F.lane + 2; c = h2;
                        if (cum + c < need) { cum += c; d = 4 * F.lane + 1; c = h1;
                            if (cum + c < need) { cum += c; d = 4 * F.lane; c = h0; } } }
                    ctl[0] = (prefix << 8) | d; ctl[1] = need - cum; }
            }
            __syncthreads();
            prefix = ctl[0]; need = ctl[1];
        }
        unsigned cnt = 0u;
#pragma unroll
        for (int u = 0; u < 16; ++u) cnt += (key[u] > prefix ? 1u : 0u) + (key[u] == prefix ? 65536u : 0u);
        unsigned inc = cnt;
#pragma unroll
        for (int o = 1; o < 64; o <<= 1) { const unsigned t = shl_from(inc, F.lane - o); if (F.lane >= o) inc += t; }
        if (F.lane == 63) wtot[F.wave] = inc;
        __syncthreads();
        unsigned base = inc - cnt;
        for (int w = 0; w < F.wave; ++w) base += wtot[w];
        unsigned ng = base & 0xffffu, ne = base >> 16;
#pragma unroll
        for (int u = 0; u < 16; ++u) { const int i = F.tid * 16 + u; const bool gt = key[u] > prefix, eq = key[u] == prefix; const bool sel = gt || (eq && ne < need);
            const int slot = (int)(ng + (ne < need ? ne : need));
            if (sel) { idx[z * CAP + slot] = i; gate[z * CAP + slot] = __builtin_bit_cast(float, key[u]); }
            slotmap[(size_t)z * S + i] = sel ? slot : -1;
            ng += gt ? 1u : 0u; ne += eq ? 1u : 0u; }
        __syncthreads();
    }
}

__device__ __forceinline__ void phase_mc(const Params& p, Frame& F) {
    const int* idx = (const int*)(p.ws + WS_IDX); const bf16* H = (const bf16*)(p.ws + WS_H); bf16* X = (bf16*)(p.ws + WS_XIN);
    const int gw = F.vcu * NWAVES + F.wave, NGW = F.G * NWAVES;
    for (int d = gw; d < NB * NE * CAP; d += NGW) { const int z = d >> 10, b = z >> 4; const int src = b * S + idx[d];
        const GAS v4u* sp = (const GAS v4u*)(H + (size_t)src * D) + F.lane; GAS v4u* dp = (GAS v4u*)(X + (size_t)d * D) + F.lane;
        const v4u a = sp[0], c = sp[64]; dp[0] = a; dp[64] = c; }
}

__device__ __forceinline__ void phase_mf(const Params& p, Frame& F, int l) {
    const int* slotmap = (const int*)(p.ws + WS_SLOT); const bf16* Y = (const bf16*)(p.ws + WS_Y); float* x = p.out;
    const float* mod = (const float*)(p.ws + WS_MOD) + (size_t)l * NB * 6 * D;
    const int gw = F.vcu * NWAVES + F.wave, NGW = F.G * NWAVES;
    for (int row = gw; row < T; row += NGW) { const int b = row >> 13, s = row & (S - 1);
        int sl[16];
#pragma unroll
        for (int e = 0; e < 16; ++e) sl[e] = __builtin_amdgcn_readfirstlane(slotmap[((size_t)(b * NE + e)) * S + s]);
        float acc[16];
#pragma unroll
        for (int i = 0; i < 16; ++i) acc[i] = 0.f;
#pragma unroll
        for (int e = 0; e < 16; ++e) { if (sl[e] >= 0) { const GAS v4u* yp = (const GAS v4u*)(Y + ((size_t)(b * NE + e) * CAP + sl[e]) * D) + F.lane; const v4u a = yp[0], c = yp[64];
                acc[0] += bf_lo(a.x); acc[1] += bf_hi(a.x); acc[2] += bf_lo(a.y); acc[3] += bf_hi(a.y); acc[4] += bf_lo(a.z); acc[5] += bf_hi(a.z); acc[6] += bf_lo(a.w); acc[7] += bf_hi(a.w);
                acc[8] += bf_lo(c.x); acc[9] += bf_hi(c.x); acc[10] += bf_lo(c.y); acc[11] += bf_hi(c.y); acc[12] += bf_lo(c.z); acc[13] += bf_hi(c.z); acc[14] += bf_lo(c.w); acc[15] += bf_hi(c.w); } }
#pragma unroll
        for (int j = 0; j < 2; ++j) { const int c0 = 512 * j + 8 * F.lane; GAS f32x4* xp = (GAS f32x4*)(x + (size_t)row * D + c0); const f32x4* gp = (const f32x4*)(mod + b * 6 * D + 5 * D + c0);
            const f32x4 g0 = gp[0], g1 = gp[1]; f32x4 x0 = xp[0], x1 = xp[1];
            x0.x += g0.x * acc[8 * j + 0]; x0.y += g0.y * acc[8 * j + 1]; x0.z += g0.z * acc[8 * j + 2]; x0.w += g0.w * acc[8 * j + 3];
            x1.x += g1.x * acc[8 * j + 4]; x1.y += g1.y * acc[8 * j + 5]; x1.z += g1.z * acc[8 * j + 6]; x1.w += g1.w * acc[8 * j + 7];
            xp[0] = x0; xp[1] = x1; }
    }
}


#define MFMA16(a, b, c) __builtin_amdgcn_mfma_f32_16x16x32_bf16((a), (b), (c), 0, 0, 0)
typedef short s16x4 __attribute__((ext_vector_type(4)));
__device__ __forceinline__ unsigned lds_addr(LAS void* p) { return (unsigned)(size_t)p; }
__device__ __forceinline__ bf16x8 tr_frag(unsigned a0, unsigned a1) {
    s16x4 lo, hi;
    asm volatile("ds_read_b64_tr_b16 %0, %2\n\tds_read_b64_tr_b16 %1, %3\n\ts_waitcnt lgkmcnt(0)" : "=&v"(lo), "=&v"(hi) : "v"(a0), "v"(a1) : "memory");
    return __builtin_shufflevector(lo, hi, 0, 1, 2, 3, 4, 5, 6, 7);
}
__device__ __forceinline__ void tr_frag4(unsigned a0, unsigned a1, unsigned a2, unsigned a3, unsigned a4, unsigned a5, unsigned a6, unsigned a7, bf16x8& f0, bf16x8& f1, bf16x8& f2, bf16x8& f3) {
    s16x4 r0, r1, r2, r3, r4, r5, r6, r7;
    asm volatile("ds_read_b64_tr_b16 %0, %8\n\tds_read_b64_tr_b16 %1, %9\n\tds_read_b64_tr_b16 %2, %10\n\tds_read_b64_tr_b16 %3, %11\n\t"
                 "ds_read_b64_tr_b16 %4, %12\n\tds_read_b64_tr_b16 %5, %13\n\tds_read_b64_tr_b16 %6, %14\n\tds_read_b64_tr_b16 %7, %15\n\ts_waitcnt lgkmcnt(0)"
                 : "=&v"(r0), "=&v"(r1), "=&v"(r2), "=&v"(r3), "=&v"(r4), "=&v"(r5), "=&v"(r6), "=&v"(r7)
                 : "v"(a0), "v"(a1), "v"(a2), "v"(a3), "v"(a4), "v"(a5), "v"(a6), "v"(a7) : "memory");
    f0 = __builtin_shufflevector(r0, r1, 0, 1, 2, 3, 4, 5, 6, 7); f1 = __builtin_shufflevector(r2, r3, 0, 1, 2, 3, 4, 5, 6, 7);
    f2 = __builtin_shufflevector(r4, r5, 0, 1, 2, 3, 4, 5, 6, 7); f3 = __builtin_shufflevector(r6, r7, 0, 1, 2, 3, 4, 5, 6, 7);
}
__device__ __forceinline__ unsigned off_b(unsigned row, unsigned ch) { return 256u * row + 16u * (ch ^ (((row & 3u) << 2) | ((row >> 2) & 3u))); }
__device__ __forceinline__ unsigned tr_read_addr_16(unsigned lane, unsigned c, unsigned ks, unsigned t) {
    const unsigned g = lane >> 4, q = (lane & 15) >> 2, pp = lane & 3;
    return off_b(32 * ks + 8 * g + 4 * t + q, 2 * c + (pp >> 1)) + 8 * (pp & 1);
}

__device__ __forceinline__ void phase_aa(const Params& p, Frame& F, int l) {
    const float* mod = (const float*)(p.ws + WS_MOD) + (size_t)l * NB * 6 * D; const float* gain = (const float*)(p.ws + WS_PAR) + PAR_NMIX + l * D;
    const int gw = F.vcu * NWAVES + F.wave, NGW = F.G * NWAVES;
    const int b = (gw * 2) / NGW, wsub = gw - b * (NGW / 2), nsub = NGW / 2;
    f32x4 Av[4], Bv[4];
#pragma unroll
    for (int j = 0; j < 4; ++j) { const int c = 256 * j + 4 * F.lane; const f32x4 g = *(const f32x4*)(gain + c), sc = *(const f32x4*)(mod + b * 6 * D + 1 * D + c);
        Av[j] = g * (sc + 1.0f); Bv[j] = *(const f32x4*)(mod + b * 6 * D + 0 * D + c); }
    const float* x = p.out; bf16* H = (bf16*)(p.ws + WS_H);
    for (int s = wsub; s < S; s += nsub) {
        const int row = b * S + s;
        asm volatile("" ::: "memory");
        f32x4 h[4]; float ss = 0.f;
#pragma unroll
        for (int j = 0; j < 4; ++j) { h[j] = *(const GAS f32x4*)(x + (size_t)row * D + 256 * j + 4 * F.lane); ss += (h[j].x * h[j].x + h[j].y * h[j].y) + (h[j].z * h[j].z + h[j].w * h[j].w); }
        const float rstd = rsqrtf(wave_sum(ss, F.lane) * (1.0f / D) + EPS);
#pragma unroll
        for (int j = 0; j < 4; ++j) { h[j] = h[j] * rstd * Av[j] + Bv[j];
            v2u o; o.x = pk2(h[j].x, h[j].y); o.y = pk2(h[j].z, h[j].w); *(GAS v2u*)(H + (size_t)row * D + 256 * j + 4 * F.lane) = o; }
    }
}

constexpr int AT_KP = 144, AT_VP = 160;
constexpr int AT_KOFF = 0, AT_VOFF = 384 * AT_KP, AT_BOFF = AT_VOFF + 384 * AT_VP;
__device__ __forceinline__ void phase_ac(const Params& p, Frame& F, int l) {
    const int jl = l >> 1;
    const bf16* QKV = (const bf16*)(p.ws + WS_QKV); bf16* O = (bf16*)(p.ws + WS_O);
    const float* biasrel = (const float*)(p.ws + WS_TAB);
    const float* par = (const float*)(p.ws + WS_PAR); const float* qg = par + PAR_QG + jl * HD; const float* kg = par + PAR_KG + jl * HD; const float* sink = par + PAR_SINK + jl * NH;
    LAS unsigned char* Kimg = F.lds + AT_KOFF; LAS unsigned char* Vimg = F.lds + AT_VOFF; LAS float* btab = (LAS float*)(F.lds + AT_BOFF);
    const int lane = F.lane, g4 = lane >> 4, ql = lane & 15;
    const int hq = F.wave >> 1, th = F.wave & 1;
    constexpr float LOG2E = 1.44269504f;
    for (int U = F.vcu; U < NB * 64 * NKV; U += F.G) {
        const int b = U >> 8, n = (U >> 2) & 63, kvh = U & 3, h = kvh * 4 + hq;
        __syncthreads();
        { const int part = F.tid & 7; f32x4 kg0 = *(const f32x4*)(kg + part * 8), kg1 = *(const f32x4*)(kg + part * 8 + 4);
#pragma unroll
          for (int i = 0; i < 6; ++i) { const int row = (F.tid >> 3) + 64 * i; const int kpos = n * 128 - 128 + row; const bool ok = (kpos >= 0) && (kpos < S);
              v4u kq = (v4u){0u, 0u, 0u, 0u}, vq = (v4u){0u, 0u, 0u, 0u};
              if (ok) { const bf16* base = QKV + ((size_t)b * S + kpos) * QKVN + NH * HD + kvh * HD + part * 8; kq = *(const GAS v4u*)base; vq = *(const GAS v4u*)(base + NKV * HD); }
              float f[8] = {bf_lo(kq.x), bf_hi(kq.x), bf_lo(kq.y), bf_hi(kq.y), bf_lo(kq.z), bf_hi(kq.z), bf_lo(kq.w), bf_hi(kq.w)};
              float ss = 0.f;
#pragma unroll
              for (int e = 0; e < 8; ++e) ss += f[e] * f[e];
              ss += shx(ss, 1, F.lane); ss += shx(ss, 2, F.lane); ss += shx(ss, 4, F.lane);
              const float r = rsqrtf(ss * (1.0f / HD) + EPS);
              v4u ko; ko.x = pk2(f[0] * r * kg0.x, f[1] * r * kg0.y); ko.y = pk2(f[2] * r * kg0.z, f[3] * r * kg0.w); ko.z = pk2(f[4] * r * kg1.x, f[5] * r * kg1.y); ko.w = pk2(f[6] * r * kg1.z, f[7] * r * kg1.w);
              *(LAS v4u*)(Kimg + row * AT_KP + part * 16) = ko; *(LAS v4u*)(Vimg + row * AT_VP + part * 16) = vq; } }
        for (int i = F.tid; i < 4 * 257; i += NTHR) { const int gg = i / 257, r = i - gg * 257; btab[gg * 260 + r] = biasrel[(kvh * 4 + gg) * 257 + r]; }
        __syncthreads();
        const float sk = sink[h] * LOG2E;
        const LAS float* bt = btab + hq * 260;
        const unsigned vbase = lds_addr(Vimg) + (unsigned)(((lane & 15) >> 2) * AT_VP + (lane & 3) * 8);
        f32x4 qa[2][2];
#pragma unroll
        for (int ds = 0; ds < 2; ++ds) { qa[ds][0] = *(const f32x4*)(qg + 32 * ds + 8 * g4); qa[ds][1] = *(const f32x4*)(qg + 32 * ds + 8 * g4 + 4); }
#pragma unroll 1
        for (int qh = 0; qh < 2; ++qh) {
            bf16x8 qf[2][2];
#pragma unroll
            for (int q2 = 0; q2 < 2; ++q2) { const int tok = n * 128 + th * 64 + 32 * qh + 16 * q2 + ql; const bf16* qp = QKV + ((size_t)b * S + tok) * QKVN + h * HD + 8 * g4;
                const v4u w0 = *(const GAS v4u*)qp, w1 = *(const GAS v4u*)(qp + 32);
                float f[16] = {bf_lo(w0.x), bf_hi(w0.x), bf_lo(w0.y), bf_hi(w0.y), bf_lo(w0.z), bf_hi(w0.z), bf_lo(w0.w), bf_hi(w0.w), bf_lo(w1.x), bf_hi(w1.x), bf_lo(w1.y), bf_hi(w1.y), bf_lo(w1.z), bf_hi(w1.z), bf_lo(w1.w), bf_hi(w1.w)};
                float ss = 0.f;
#pragma unroll
                for (int e = 0; e < 16; ++e) ss += f[e] * f[e];
                ss += shx(ss, 16, F.lane); ss += shx(ss, 32, F.lane);
                const float r = rsqrtf(ss * (1.0f / HD) + EPS) * (0.125f * LOG2E);
#pragma unroll
                for (int ds = 0; ds < 2; ++ds) { v4u o; o.x = pk2(f[8 * ds + 0] * r * qa[ds][0].x, f[8 * ds + 1] * r * qa[ds][0].y); o.y = pk2(f[8 * ds + 2] * r * qa[ds][0].z, f[8 * ds + 3] * r * qa[ds][0].w);
                    o.z = pk2(f[8 * ds + 4] * r * qa[ds][1].x, f[8 * ds + 5] * r * qa[ds][1].y); o.w = pk2(f[8 * ds + 6] * r * qa[ds][1].z, f[8 * ds + 7] * r * qa[ds][1].w);
                    qf[q2][ds] = __builtin_bit_cast(bf16x8, o); } }
            float mrun[2], lrun[2]; f32x4 oacc[4][2];
#pragma unroll
            for (int q2 = 0; q2 < 2; ++q2) { mrun[q2] = sk; lrun[q2] = 0.f;
#pragma unroll
                for (int db = 0; db < 4; ++db) oacc[db][q2] = (f32x4){0.f, 0.f, 0.f, 0.f}; }
#pragma unroll 1
            for (int c = th; c < th + 5; ++c) {
                bf16x8 kf[4][2];
#pragma unroll
                for (int kb = 0; kb < 4; ++kb)
#pragma unroll
                    for (int ds = 0; ds < 2; ++ds) kf[kb][ds] = *(const LAS bf16x8*)(Kimg + (64 * c + 16 * kb + ql) * AT_KP + (32 * ds + 8 * g4) * 2);
                f32x4 sacc[4][2];
#pragma unroll
                for (int kb = 0; kb < 4; ++kb)
#pragma unroll
                    for (int q2 = 0; q2 < 2; ++q2) { f32x4 a = (f32x4){0.f, 0.f, 0.f, 0.f}; a = MFMA16(kf[kb][0], qf[q2][0], a); a = MFMA16(kf[kb][1], qf[q2][1], a); sacc[kb][q2] = a; }
                bf16x8 pf[2][2];
#pragma unroll
                for (int q2 = 0; q2 < 2; ++q2) { const int qoff = th * 64 + 32 * qh + 16 * q2 + ql;
                    float mx = -1e30f;
#pragma unroll
                    for (int kb = 0; kb < 4; ++kb)
#pragma unroll
                        for (int j = 0; j < 4; ++j) { const int koff = 64 * c + 16 * kb + 4 * g4 + j - 128; const int rel = koff - qoff; const int kpos = n * 128 + koff;
                            const bool ok = ((unsigned)(rel + 128) <= 256u) && (kpos >= 0) && (kpos < S);
                            const int bi = ok ? rel + 128 : 0;
                            const float sv = ok ? sacc[kb][q2][j] + bt[bi] : -1e30f; sacc[kb][q2][j] = sv; mx = fmaxf(mx, sv); }
                    mx = fmaxf(mx, shx(mx, 16, F.lane)); mx = fmaxf(mx, shx(mx, 32, F.lane));
                    const float mnew = fmaxf(mrun[q2], mx), alpha = __builtin_amdgcn_exp2f(mrun[q2] - mnew); mrun[q2] = mnew;
                    float ps = 0.f; float pv[4][4];
#pragma unroll
                    for (int kb = 0; kb < 4; ++kb)
#pragma unroll
                        for (int j = 0; j < 4; ++j) { pv[kb][j] = __builtin_amdgcn_exp2f(sacc[kb][q2][j] - mnew); ps += pv[kb][j]; }
                    lrun[q2] = lrun[q2] * alpha + ps;
#pragma unroll
                    for (int db = 0; db < 4; ++db) oacc[db][q2] = oacc[db][q2] * alpha;
#pragma unroll
                    for (int ks2 = 0; ks2 < 2; ++ks2) { v4u o; o.x = pk2(pv[2 * ks2][0], pv[2 * ks2][1]); o.y = pk2(pv[2 * ks2][2], pv[2 * ks2][3]); o.z = pk2(pv[2 * ks2 + 1][0], pv[2 * ks2 + 1][1]); o.w = pk2(pv[2 * ks2 + 1][2], pv[2 * ks2 + 1][3]);
                        pf[q2][ks2] = __builtin_bit_cast(bf16x8, o); } }
#pragma unroll
                for (int ks2 = 0; ks2 < 2; ++ks2)
#pragma unroll
                    for (int db = 0; db < 4; ++db) { const unsigned a0 = vbase + (unsigned)((64 * c + 32 * ks2 + 4 * g4) * AT_VP + 32 * db); const bf16x8 vf = tr_frag(a0, a0 + 16u * AT_VP);
                        oacc[db][0] = MFMA16(vf, pf[0][ks2], oacc[db][0]); oacc[db][1] = MFMA16(vf, pf[1][ks2], oacc[db][1]); }
            }
#pragma unroll
            for (int q2 = 0; q2 < 2; ++q2) { float lt = lrun[q2]; lt += shx(lt, 16, F.lane); lt += shx(lt, 32, F.lane); lt += __builtin_amdgcn_exp2f(sk - mrun[q2]);
                const float inv = 1.0f / lt; const int tok = n * 128 + th * 64 + 32 * qh + 16 * q2 + ql; bf16* op = O + ((size_t)b * S + tok) * D + h * HD + 4 * g4;
#pragma unroll
                for (int db = 0; db < 4; ++db) { const f32x4 v = oacc[db][q2] * inv; v2u o; o.x = pk2(v.x, v.y); o.y = pk2(v.z, v.w); *(GAS v2u*)(op + 16 * db) = o; } }
        }
    }
}

__device__ __forceinline__ void phase_fa(const Params& p, Frame& F, int l) {
    const float* mod = (const float*)(p.ws + WS_MOD) + (size_t)l * NB * 6 * D; const float* gain = (const float*)(p.ws + WS_PAR) + PAR_NMIX + l * D;
    const float* x = p.out; bf16* TA = (bf16*)(p.ws + WS_TA);
    const float* __restrict__ R64T = (const float*)(p.ws + WS_TAB + 65536);
    LAS unsigned short* hb = (LAS unsigned short*)F.lds;
    for (int U = F.vcu; U < NB * 128; U += F.G) {
        const int b = U >> 7, s2 = U & 127;
        __syncthreads();
        { f32x4 Av[4], Bv[4];
#pragma unroll
          for (int j = 0; j < 4; ++j) { const int c = 256 * j + 4 * F.lane; const f32x4 g = *(const f32x4*)(gain + c), sc = *(const f32x4*)(mod + b * 6 * D + 1 * D + c);
              Av[j] = g * (sc + 1.0f); Bv[j] = *(const f32x4*)(mod + b * 6 * D + 0 * D + c); }
          for (int r8 = 0; r8 < 8; ++r8) { const int s1 = F.wave * 8 + r8; const int row = b * S + 128 * s1 + s2;
              f32x4 h[4]; float ss = 0.f;
#pragma unroll
              for (int j = 0; j < 4; ++j) { h[j] = *(const GAS f32x4*)(x + (size_t)row * D + 256 * j + 4 * F.lane); ss += (h[j].x * h[j].x + h[j].y * h[j].y) + (h[j].z * h[j].z + h[j].w * h[j].w); }
              const float rstd = rsqrtf(wave_sum(ss, F.lane) * (1.0f / D) + EPS);
#pragma unroll
              for (int j = 0; j < 4; ++j) { h[j] = h[j] * rstd * Av[j] + Bv[j];
                  v2u o; o.x = pk2(h[j].x, h[j].y); o.y = pk2(h[j].z, h[j].w); *(LAS v2u*)(hb + s1 * 1024 + 256 * j + 4 * F.lane) = o; } } }
        __syncthreads();
        for (int pass = 0; pass < 2; ++pass) {
            const int col = F.tid + 512 * pass;
            float ev[32], ov[32];
            ev[0] = __builtin_bit_cast(float, (unsigned)hb[col] << 16); ov[0] = __builtin_bit_cast(float, (unsigned)hb[32 * 1024 + col] << 16);
#pragma unroll
            for (int s = 1; s < 32; ++s) { const float a = __builtin_bit_cast(float, (unsigned)hb[s * 1024 + col] << 16), c2 = __builtin_bit_cast(float, (unsigned)hb[(64 - s) * 1024 + col] << 16); ev[s] = a + c2; ov[s] = a - c2; }
            bf16* tb = TA + (size_t)b * 32 * 2 * 128 * 1024 + (size_t)s2 * 1024 + col;
#pragma unroll 1
            for (int r = 0; r <= 32; ++r) { const float* __restrict__ cr = R64T + r * 32; float a = ev[0] + ((r & 1) ? -ov[0] : ov[0]);
#pragma unroll
                for (int s = 1; s < 32; ++s) a += ev[s] * cr[s];
                const int uh = (r == 0) ? 0 : (r == 32 ? 1 : 2 * r);
                tb[(size_t)uh * 128 * 1024] = (bf16)f2bf(a); }
#pragma unroll 1
            for (int r = 33; r < 64; ++r) { const float* __restrict__ cr = R64T + r * 32; float a = 0.f;
#pragma unroll
                for (int s = 1; s < 32; ++s) a += ov[s] * cr[s];
                tb[(size_t)(2 * (r - 32) + 1) * 128 * 1024] = (bf16)f2bf(a); }
        }
    }
}

__device__ __forceinline__ void phase_fb(const Params& p, Frame& F) {
    const bf16* TA = (const bf16*)(p.ws + WS_TA); const bf16* MBT = (const bf16*)(p.ws + WS_MBT); bf16* YF = (bf16*)(p.ws + WS_YF); float* Yr4096 = (float*)(p.ws + WS_MISC + 8192);
    const int lane = F.lane, g4 = lane >> 4, ql = lane & 15;
    for (int U = F.vcu; U < NB * 32 * 4; U += F.G) {
        const int b = U >> 7, u = (U >> 2) & 31, cq = U & 3;
        __syncthreads();
        const bf16* src = TA + ((size_t)(b * 32 + u) * 256) * 1024 + cq * 256;
#pragma unroll 4
        for (int i = 0; i < 16; ++i) { const int q = F.tid + 512 * i, row = q >> 5, c32 = q & 31;
            const v4u v = *(const GAS v4u*)(src + (size_t)row * 1024 + c32 * 8);
            *(LAS v4u*)(F.lds + (c32 >> 4) * 65536 + off_b(row, c32 & 15)) = v; }
        __syncthreads();
        f32x4 acc[16][2];
#pragma unroll
        for (int cb = 0; cb < 16; ++cb) { acc[cb][0] = (f32x4){0.f, 0.f, 0.f, 0.f}; acc[cb][1] = (f32x4){0.f, 0.f, 0.f, 0.f}; }
        const bf16* mrow = MBT + ((size_t)u * 256 + 32 * F.wave + ql) * 256 + 8 * g4;
        const unsigned lbase = lds_addr(F.lds);
#pragma unroll 1
        for (int ks = 0; ks < 8; ++ks) {
            const bf16x8 m0 = *(const GAS bf16x8*)(mrow + 32 * ks), m1 = *(const GAS bf16x8*)(mrow + 16 * 256 + 32 * ks);
#pragma unroll
            for (int c4 = 0; c4 < 4; ++c4) { bf16x8 f0, f1, f2, f3; unsigned a[8];
#pragma unroll
                for (int i = 0; i < 4; ++i) { const int cb = 4 * c4 + i; a[2 * i] = lbase + (cb >> 3) * 65536 + tr_read_addr_16(lane, cb & 7, ks, 0); a[2 * i + 1] = lbase + (cb >> 3) * 65536 + tr_read_addr_16(lane, cb & 7, ks, 1); }
                tr_frag4(a[0], a[1], a[2], a[3], a[4], a[5], a[6], a[7], f0, f1, f2, f3);
                acc[4 * c4 + 0][0] = MFMA16(f0, m0, acc[4 * c4 + 0][0]); acc[4 * c4 + 0][1] = MFMA16(f0, m1, acc[4 * c4 + 0][1]);
                acc[4 * c4 + 1][0] = MFMA16(f1, m0, acc[4 * c4 + 1][0]); acc[4 * c4 + 1][1] = MFMA16(f1, m1, acc[4 * c4 + 1][1]);
                acc[4 * c4 + 2][0] = MFMA16(f2, m0, acc[4 * c4 + 2][0]); acc[4 * c4 + 2][1] = MFMA16(f2, m1, acc[4 * c4 + 2][1]);
                acc[4 * c4 + 3][0] = MFMA16(f3, m0, acc[4 * c4 + 3][0]); acc[4 * c4 + 3][1] = MFMA16(f3, m1, acc[4 * c4 + 3][1]); }
        }
#pragma unroll
        for (int mb = 0; mb < 2; ++mb) { const int o = 32 * F.wave + 16 * mb + ql, ri = o >> 7, jj = o & 127;
            bf16* yp = YF + (((size_t)(b * 4096 + u * 128 + jj)) * 2 + ri) * 1024 + cq * 256 + 4 * g4;
#pragma unroll
            for (int cb = 0; cb < 16; ++cb) { const f32x4 v = acc[cb][mb]; v2u w; w.x = pk2(v.x, v.y); w.y = pk2(v.z, v.w); *(GAS v2u*)(yp + 16 * cb) = w; } }
        if (u == 0 && F.tid < 256) {
            const int col = F.tid; const LAS unsigned char* img = F.lds + (col >> 7) * 65536; const int cc = col & 127; float a = 0.f;
            for (int s2 = 0; s2 < 128; ++s2) { const unsigned short hv = *(const LAS unsigned short*)(img + off_b(s2, cc >> 3) + 2 * (cc & 7)); const float v = __builtin_bit_cast(float, (unsigned)hv << 16); a += (s2 & 1) ? -v : v; }
            Yr4096[b * 1024 + cq * 256 + col] = a; }
    }
}

__device__ __forceinline__ void phase_fd(const Params& p, Frame& F, int l) {
    const float* mod = (const float*)(p.ws + WS_MOD) + (size_t)l * NB * 6 * D; const float* PQ = (const float*)(p.ws + WS_PQ); const float* y4096 = (const float*)(p.ws + WS_MISC);
    float* x = p.out;
    const int gw = F.vcu * NWAVES + F.wave, NGW = F.G * NWAVES;
    for (int row = gw; row < T; row += NGW) { const int b = row >> 13, k = row & (S - 1), m = k & 63, q = k >> 6;
        int r; float sg = 1.0f; bool special = false;
        if (m >= 1 && m <= 31) { r = m * 128 + q; }
        else if (m >= 33) { const int kp = S - k; r = (kp & 63) * 128 + (kp >> 6); sg = -1.0f; }
        else if (m == 0) { if (q <= 63) r = q; else if (q == 64) { r = 0; special = true; } else { r = 128 - q; sg = -1.0f; } }
        else { if (q <= 63) r = 64 + q; else { r = 64 + (127 - q); sg = -1.0f; } }
        const float* P = PQ + ((size_t)(b * 4096 + r)) * 2048;
#pragma unroll
        for (int j = 0; j < 4; ++j) { const int c = 256 * j + 4 * F.lane; f32x4 y;
            if (special) y = *(const f32x4*)(y4096 + b * 1024 + c); else y = *(const GAS f32x4*)(P + c) + *(const GAS f32x4*)(P + 1024 + c) * sg;
            GAS f32x4* xp = (GAS f32x4*)(x + (size_t)row * D + c); const f32x4 g = *(const f32x4*)(mod + b * 6 * D + 2 * D + c); *xp = *xp + g * y; }
    }
}
__device__ __forceinline__ void fc_extra(const Params& p, Frame& F, int l) {
    const float* Yr = (const float*)(p.ws + WS_MISC + 8192); float* y4096 = (float*)(p.ws + WS_MISC); const bf16* W = (const bf16*)(p.ws + WS_WFF) + (size_t)(l >> 1) * 2048 * 1024;
    const int gw = F.vcu * NWAVES + F.wave, NGW = F.G * NWAVES;
    for (int o = gw; o < NB * 1024; o += NGW) { const int b = o >> 10, j = o & 1023; float a = 0.f;
#pragma unroll
        for (int i = 0; i < 2; ++i) { const int c = 512 * i + 8 * F.lane; const v4u w = *(const GAS v4u*)(W + (size_t)j * 1024 + c); const f32x4 y0 = *(const GAS f32x4*)(Yr + b * 1024 + c), y1 = *(const GAS f32x4*)(Yr + b * 1024 + c + 4);
            a += y0.x * bf_lo(w.x) + y0.y * bf_hi(w.x) + y0.z * bf_lo(w.y) + y0.w * bf_hi(w.y) + y1.x * bf_lo(w.z) + y1.y * bf_hi(w.z) + y1.z * bf_lo(w.w) + y1.w * bf_hi(w.w); }
        a = wave_sum(a, F.lane); if (F.lane == 0) y4096[o] = a; }
}

__device__ __forceinline__ void pro_small(const Params& p, Frame& F) {
    const int gt = F.vcu * NTHR + F.tid, NGT = F.G * NTHR;
    float* mod = (float*)(p.ws + WS_MOD);
    if (gt < DEPTH * 6 * D) { const int l = gt / (6 * D), j = gt - l * 6 * D; const float* w = p.in[IN_WADA] + (size_t)l * D * 6 * D + j; const float* c = p.in[IN_C];
        float a0 = 0.f, a1 = 0.f;
#pragma unroll 8
        for (int i = 0; i < D; ++i) { const float wv = w[(size_t)i * 6 * D]; const float c0 = c[i], c1 = c[D + i]; a0 += c0 / (1.f + expf(-c0)) * wv; a1 += c1 / (1.f + expf(-c1)) * wv; }
        const float bb = p.in[IN_BADA][l * 6 * D + j];
        mod[((size_t)l * NB + 0) * 6 * D + j] = a0 + bb; mod[((size_t)l * NB + 1) * 6 * D + j] = a1 + bb; }
    { float* par = (float*)(p.ws + WS_PAR);
      for (int i = gt; i < 4096; i += NGT) { par[PAR_NMIX + i] = p.in[IN_NMIX][i]; par[PAR_NFFN + i] = p.in[IN_NFFN][i]; }
      for (int i = gt; i < 128; i += NGT) { par[PAR_QG + i] = p.in[IN_QG][i]; par[PAR_KG + i] = p.in[IN_KG][i]; }
      for (int i = gt; i < 32; i += NGT) par[PAR_SINK + i] = p.in[IN_SINK][i];
      for (int i = gt; i < DEPTH * D * NE; i += NGT) par[PAR_WR + i] = p.in[IN_WR][i]; }
    float* biasrel = (float*)(p.ws + WS_TAB); float* R64T = (float*)(p.ws + WS_TAB + 65536); bf16* MBT = (bf16*)(p.ws + WS_MBT); bf16* CS = (bf16*)(p.ws + WS_CS);
    for (int i = gt; i < NH * 257; i += NGT) { const int h = i / 257, r = i - h * 257, rel = r - 128, n = rel < 0 ? -rel : rel;
        int bk = (n < 8) ? n : 8 + (n >= 12) + (n >= 16) + (n >= 23) + (n >= 32) + (n >= 46) + (n >= 64) + (n >= 91);
        bk += (rel > 0) ? 16 : 0; biasrel[i] = p.in[IN_RELB][bk * NH + h] * 1.44269504f; }
    for (int i = gt; i < 64 * 32; i += NGT) { const int r = i >> 5, s = i & 31; float sv, cv;
        if (r <= 32) { sincospif((float)((r * s) & 63) / 32.0f, &sv, &cv); R64T[i] = cv; } else { sincospif((float)(((r - 32) * s) & 63) / 32.0f, &sv, &cv); R64T[i] = -sv; } }
    for (int i = gt; i < 512 * 256; i += NGT) { const int rr = i >> 8, m = i & 255, cs = rr >> 8, nn = rr & 255; float sv, cv; sincospif((float)((nn * m) & 255) / 128.0f, &sv, &cv); CS[i] = (bf16)f2bf(cs ? sv : cv); }
    for (int i = gt; i < 32 * 256 * 256; i += NGT) { const int u = i >> 16, o = (i >> 8) & 255, K = i & 255, ri = o >> 7, j = o & 127, half = K >> 7, s2 = K & 127; float val = 0.f;
        if (u >= 1) { const int k = u + 64 * j; float sv, cv; sincospif((float)((s2 * k) & 8191) / 4096.0f, &sv, &cv);
            val = (ri == 0) ? (half == 0 ? cv : sv) : (half == 0 ? -sv : cv); }
        else { const int blk = j >> 6, k = (blk ? 32 : 0) + 64 * (j & 63); if (half == blk) { float sv, cv; sincospif((float)((s2 * k) & 8191) / 4096.0f, &sv, &cv); val = (ri == 0) ? cv : -sv; } }
        MBT[i] = (bf16)f2bf(val); }
}
__device__ __forceinline__ void pro_cvt_dense(const Params& p, Frame& F) {
    LAS float* scr = (LAS float*)(F.lds + F.wave * 16640);
    const int gw = F.vcu * NWAVES + F.wave, NGW = F.G * NWAVES;
    constexpr int I_QKV = 16 * 24, I_SQ = 16 * 16, NIT = 2 * I_QKV + 4 * I_SQ;
    for (int it = gw; it < NIT; it += NGW) {
        int r = it;
        if (r < 2 * I_QKV) { const int j = r / I_QKV; r -= j * I_QKV; const int kt = r / 24, ntile = r % 24;
            cvt_tile64(p.in[IN_WQKV] + (size_t)j * D * QKVN + (size_t)kt * 64 * QKVN + ntile * 64, QKVN, (bf16*)(p.ws + WS_WQKV) + ((size_t)j * QKVN + ntile * 64) * D + kt * 64, D, scr, F.lane, 1.0f); continue; }
        r -= 2 * I_QKV; const int which = r / (2 * I_SQ); r -= which * 2 * I_SQ; const int j = r / I_SQ; r -= j * I_SQ; const int kt = r >> 4, ntile = r & 15;
        const float* src = (which ? p.in[IN_WFO] : p.in[IN_WAO]) + (size_t)j * D * D + (size_t)kt * 64 * D + ntile * 64;
        bf16* dst = (bf16*)(p.ws + (which ? WS_WFO : WS_WAO)) + ((size_t)j * D + ntile * 64) * D + kt * 64;
        cvt_tile64(src, D, dst, D, scr, F.lane, 1.0f);
    }
}

namespace pg8 {
struct SchedFC { const char* A; const char* B; int G, c;
    __device__ __forceinline__ bool next(int i, Unit& u) const { int tm, tn; if (!tile_of(i, G, c, 32, 8, 8, tm, tn)) return false;
        u.pm = tm; u.pn = tn; u.A = A + (size_t)tm * (256 * 2048 * 2) + (tn >= 4 ? 2048 : 0); u.B = B + (size_t)tn * (256 * 1024 * 2); return true; } };
struct SchedFold { const char* A; const char* B; int G, c;
    __device__ __forceinline__ bool next(int i, Unit& u) const { const long L = (long)i * G + c; if (L >= 32) return false; const int g = (int)L & 3, tm = ((int)L >> 2) & 3, cs = (int)L >> 4;
        u.pm = tm + 4 * cs; u.pn = g; u.A = A + (size_t)tm * (256 * 1024 * 2) + g * 512; u.B = B + (size_t)cs * (256 * 256 * 2); return true; } };
}

constexpr int NPHASE = 1 + 10 * DEPTH;
__global__ void __launch_bounds__(NTHR, 2) mk_fwd(Params p) {
    extern __shared__ __attribute__((aligned(16))) unsigned char lds_raw[];
    Frame F; F.lds = (LAS unsigned char*)lds_raw;
    F.tid = threadIdx.x; F.lane = F.tid & 63; F.wave = __builtin_amdgcn_readfirstlane(F.tid >> 6);
    F.G = gridDim.x; { const int bx = blockIdx.x; F.vcu = (F.G % 8 == 0) ? (bx % 8) * (F.G / 8) + bx / 8 : bx; }
    volatile LAS unsigned* MISC = (volatile LAS unsigned*)(F.lds + MISC_OFF);
    if (F.tid < 32) MISC[F.tid] = 0u;
    __syncthreads();
    XcdBarrier bar = xcd_barrier_post((unsigned*)(p.ws + WS_CTL) + CW_BAR, MISC + 8);
    const int lo = p.ph_lo, hi = p.ph_hi;
#define IN(k) (lo <= (k) && (k) < hi)
#define SEAM(k) do { if (IN(k) && IN((k) + 1)) xcd_barrier(bar); } while (0)
#define RELAUNDER() do { int t_ = threadIdx.x; asm volatile("" : "+v"(t_)); F.tid = t_; F.lane = t_ & 63; } while (0)
#define PHASE_CTX() Params q; do { unsigned long long w_ = (unsigned long long)p.ws, o_ = (unsigned long long)p.out; asm volatile("" : "+s"(w_), "+s"(o_)); q.ws = (unsigned char*)w_; q.out = (float*)o_; RELAUNDER(); } while (0)

    if (IN(0)) {
        RELAUNDER(); pro_small(p, F);
        RELAUNDER(); pro_cvt_dense(p, F);
        const int gw = F.vcu * NWAVES + F.wave, NGW = F.G * NWAVES;
        for (int l = 0; l < DEPTH; ++l) { RELAUNDER(); cvt_moe_layer(p, F, l, gw, NGW); }
        __syncthreads();
    }
    SEAM(0);
    for (int l = 0; l < DEPTH; ++l) {
        const int base = 1 + 10 * l; const bool fourier = (l & 1) == 0; const int jl = l >> 1;
                if (IN(base + 0)) {
            PHASE_CTX();
            if (fourier) {
                phase_fa(q, F, l);
                __syncthreads();
                pg8::SchedFold Sc{(const char*)(q.ws + WS_WFO + (size_t)jl * D * D * 2), (const char*)(q.ws + WS_CS), F.G, F.vcu};
                pg8::EpiBf16 E{(bf16*)(q.ws + WS_WFF + (size_t)jl * 2048 * 1024 * 2), 1024, nullptr, 1.0f / 1448.15468787f, 0};
                pg8::gemm_phase<pg8::EpiBf16, pg8::SchedFold, 256, 1024, 256>(F.lds, Sc, E);
            } else phase_aa(q, F, l);
        }
        SEAM(base + 0);
        if (IN(base + 1)) {
            PHASE_CTX();
            if (fourier) phase_fb(q, F);
            else {
                pg8::SchedPlain Sc{(const char*)(q.ws + WS_H), (const char*)(q.ws + WS_WQKV + (size_t)jl * QKVN * D * 2), (size_t)256 * 1024 * 2, (size_t)256 * 1024 * 2, 64, 6, F.G, (int)blockIdx.x, 8, 0};
                pg8::EpiBf16 E{(bf16*)(q.ws + WS_QKV), QKVN, nullptr, 1.0f, 0};
                pg8::gemm_phase<pg8::EpiBf16, pg8::SchedPlain, 1024, 1024, 1024>(F.lds, Sc, E);
            }
        }
        SEAM(base + 1);
        if (IN(base + 2)) {
            PHASE_CTX();
            if (fourier) {
                pg8::SchedFC Sc{(const char*)(q.ws + WS_YF), (const char*)(q.ws + WS_WFF + (size_t)jl * 2048 * 1024 * 2), F.G, (int)blockIdx.x};
                pg8::EpiF32 E{(float*)(q.ws + WS_PQ), 2048};
                pg8::gemm_phase<pg8::EpiF32, pg8::SchedFC, 1024, 2048, 1024>(F.lds, Sc, E);
                RELAUNDER(); fc_extra(q, F, l);
            } else phase_ac(q, F, l);
        }
        SEAM(base + 2);
        if (IN(base + 3)) {
            PHASE_CTX();
            if (fourier) phase_fd(q, F, l);
            else {
                pg8::SchedPlain Sc{(const char*)(q.ws + WS_O), (const char*)(q.ws + WS_WAO + (size_t)jl * D * D * 2), (size_t)256 * 1024 * 2, (size_t)256 * 1024 * 2, 64, 4, F.G, (int)blockIdx.x, 8, 0};
                pg8::EpiResid E{q.out, (const float*)(q.ws + WS_MOD) + (size_t)l * NB * 6 * D + 2 * D};
                pg8::gemm_phase<pg8::EpiResid, pg8::SchedPlain, 1024, 1024, 1024>(F.lds, Sc, E);
            }
        }
        SEAM(base + 3);
        if (IN(base + 4)) { PHASE_CTX(); phase_ma(q, F, l); }
        SEAM(base + 4);
        if (IN(base + 5)) { PHASE_CTX(); phase_mb(q, F); }
        SEAM(base + 5);
        if (IN(base + 6)) { PHASE_CTX(); phase_mc(q, F); }
        SEAM(base + 6);
        if (IN(base + 7)) {
            PHASE_CTX();
            pg8::SchedMoE Sc{(const char*)(q.ws + WS_XIN), (const char*)(q.ws + WS_W1 + (size_t)l * NE * 4096 * 1024 * 2), (size_t)256 * 1024 * 2, (size_t)256 * 1024 * 2, 16, F.G, (int)blockIdx.x, 0};
            pg8::EpiSwiGLU E{(bf16*)(q.ws + WS_ACT), 2048};
            pg8::gemm_phase<pg8::EpiSwiGLU, pg8::SchedMoE, 1024, 1024, 1024>(F.lds, Sc, E);
        }
        SEAM(base + 7);
        if (IN(base + 8)) {
            PHASE_CTX();
            pg8::SchedMoE Sc{(const char*)(q.ws + WS_ACT), (const char*)(q.ws + WS_W2 + (size_t)l * NE * 1024 * 2048 * 2), (size_t)256 * 2048 * 2, (size_t)256 * 2048 * 2, 4, F.G, (int)blockIdx.x, 0};
            pg8::EpiBf16 E{(bf16*)(q.ws + WS_Y), 1024, (const float*)(q.ws + WS_GATE), 1.0f, 0};
            pg8::gemm_phase<pg8::EpiBf16, pg8::SchedMoE, 2048, 2048, 2048>(F.lds, Sc, E);
        }
        SEAM(base + 8);
        if (IN(base + 9)) { PHASE_CTX(); phase_mf(q, F, l); }
        SEAM(base + 9);
    }
#undef IN
#undef SEAM
}

#ifndef MK_MODE
#define MK_MODE 0
#endif
extern "C" void kernel_launch(void* const* d_in, const int* in_sizes, int n_in, void* d_out, int out_size, void* d_ws, size_t ws_size, hipStream_t stream) {
    static int grid = 0;
    if (grid == 0) {
        int dev = 0, cus = 0;
        if (n_in != 17 || ws_size < WS_END || hipGetDevice(&dev) != hipSuccess || hipDeviceGetAttribute(&cus, hipDeviceAttributeMultiprocessorCount, dev) != hipSuccess) { fprintf(stderr, "kernel_launch: bad arguments\n"); grid = -1; return; }
        if (hipFuncSetAttribute((const void*)mk_fwd, hipFuncAttributeMaxDynamicSharedMemorySize, LDS_BYTES) != hipSuccess) { fprintf(stderr, "kernel_launch: hipFuncSetAttribute failed\n"); grid = -1; return; }
        int per_cu = 0; (void)hipOccupancyMaxActiveBlocksPerMultiprocessor(&per_cu, (const void*)mk_fwd, NTHR, LDS_BYTES); (void)hipGetLastError();
        grid = cus;
    }
    if (grid < 0) return;
    Params P{}; for (int i = 0; i < 17; ++i) P.in[i] = (const float*)d_in[i]; P.out = (float*)d_out; P.ws = (unsigned char*)d_ws;
    (void)hipMemcpyAsync(d_out, d_in[0], (size_t)T * D * 4, hipMemcpyDeviceToDevice, stream);
#if MK_MODE == 0
    (void)hipMemsetAsync((char*)d_ws + WS_CTL, 0, CTL_ZERO_BYTES, stream);
    P.ph_lo = 0; P.ph_hi = NPHASE; hipLaunchKernelGGL(mk_fwd, dim3(grid), dim3(NTHR), LDS_BYTES, stream, P);
#else
    for (int ph = 0; ph < NPHASE; ++ph) { (void)hipMemsetAsync((char*)d_ws + WS_CTL, 0, CTL_ZERO_BYTES, stream); P.ph_lo = ph; P.ph_hi = ph + 1; hipLaunchKernelGGL(mk_fwd, dim3(grid), dim3(NTHR), LDS_BYTES, stream, P); }
#endif
}
```

```cpp
#include <hip/hip_runtime.h>
#include <math.h>
#include <stdint.h>
#include <stdio.h>

namespace pg8 {
#define PG8_LAS __attribute__((address_space(3)))
typedef unsigned short bf16_t;
typedef short bf16x8 __attribute__((ext_vector_type(8)));
typedef float f32x4 __attribute__((ext_vector_type(4)));
typedef unsigned u32x4 __attribute__((ext_vector_type(4)));
constexpr int BM = 256, BK = 64, HALF = 128, HTB = HALF * BK * 2  , STAGE_BYTES = 8 * HTB, NXCD = 8;

__host__ __device__ __forceinline__ int lds_byte(int r, int c) { const int st = (r >> 4) * 2 + (c >> 5), rr = r & 15, cc = c & 31, ob = rr * 64 + cc * 2; return st * 1024 + (ob ^ (((ob >> 9) & 1) << 5)); }
__host__ __device__ __forceinline__ void stage_rc(int b, int& R, int& C) { const int st = b / 1024, sb = b % 1024, swz = sb ^ (((sb >> 9) & 1) << 5); R = (st >> 1) * 16 + swz / 64; C = (st & 1) * 32 + (swz % 64) / 2; }
__host__ __device__ __forceinline__ int perm32(int rho) { const int n = rho >> 4, i = rho & 15; return 8 * (i >> 2) + 4 * n + (i & 3); }

struct Unit { const char* A; const char* B; int pm, pn; };

__device__ __forceinline__ bool tile_of(int i, int G, int c, int nM, int nN, int wgm, int& tm, int& tn) {
    const int nwg = nM * nN; const long L = (long)i * G + c; if (L >= nwg) return false;
    int wgid = (int)L; { const int q = nwg / NXCD, r = nwg % NXCD, xcd = wgid % NXCD, off = wgid / NXCD; wgid = (xcd < r ? xcd * (q + 1) : r * (q + 1) + (xcd - r) * q) + off; }
    const int nig = wgm * nN, gid = wgid / nig, fm = gid * wgm, gsz = (nM - fm) < wgm ? (nM - fm) : wgm;
    tm = fm + ((wgid % nig) % gsz); tn = (wgid % nig) / gsz; return true;
}

__device__ __forceinline__ unsigned cvt_pk_bf16(float lo, float hi) { unsigned r; asm volatile("v_cvt_pk_bf16_f32 %0, %1, %2" : "=v"(r) : "v"(lo), "v"(hi)); return r; }

template <class Epi, class Sched, int K, int lda, int ldb, bool ALIGN_EPI = true, bool SP2 = true>
__device__ __forceinline__ void gemm_phase(PG8_LAS unsigned char* lds, const Sched& S, const Epi& E) {
    int tid_l = threadIdx.x; asm volatile("" : "+v"(tid_l));
    const int tid = tid_l, wid = __builtin_amdgcn_readfirstlane(tid >> 6), lane = tid & 63, wr = wid >> 2, wc = wid & 3, fr = lane & 15, fq = lane >> 4;
    const int nt = K / BK;
    unsigned voffA[2], voffB[2];
#pragma unroll
    for (int i = 0; i < 2; ++i) { int R, C; stage_rc(tid * 16 + i * 8192, R, C); const int Rb = Epi::PERM ? ((R & ~31) + perm32(R & 31)) : R;
        voffA[i] = (unsigned)(R * lda + C) * 2u; voffB[i] = (unsigned)(Rb * ldb + C) * 2u; }
    const size_t kstep = (size_t)(BK * 2);
    const size_t hstepA = (size_t)HALF * lda * 2, hstepB = (size_t)HALF * ldb * 2;
    const unsigned ldsw = (unsigned)wid * 1024u;
    const int aoff = lds_byte(wr * 64 + fr, fq * 8), boff = lds_byte(wc * 32 + fr, fq * 8);
#define PG8_SA(b, h) (((b) * 2 + (h)) * HTB)
#define PG8_SB(b, h) ((4 + (b) * 2 + (h)) * HTB)
#define PG8_STAGE(bufoff, gbase, voff) do { _Pragma("unroll") for (int _i = 0; _i < 2; ++_i) \
        __builtin_amdgcn_global_load_lds((const unsigned*)((const char*)(gbase) + (voff)[_i]), (PG8_LAS unsigned*)(lds + (bufoff) + ldsw + _i * 8192), 16, 0, 0); } while (0)
#define PG8_LDA(dst, b, h) do { _Pragma("unroll") for (int m = 0; m < 4; ++m) _Pragma("unroll") for (int k = 0; k < 2; ++k) dst[m][k] = *(const PG8_LAS bf16x8*)(lds + PG8_SA(b, h) + aoff + m * 2048 + k * 1024); } while (0)
#define PG8_LDB(dst, b, h) do { _Pragma("unroll") for (int n = 0; n < 2; ++n) _Pragma("unroll") for (int k = 0; k < 2; ++k) dst[n][k] = *(const PG8_LAS bf16x8*)(lds + PG8_SB(b, h) + boff + n * 2048 + k * 1024); } while (0)
#define PG8_MMA(ai, bj, At, Bt) do { __builtin_amdgcn_s_setprio(1); _Pragma("unroll") for (int m = 0; m < 4; ++m) _Pragma("unroll") for (int n = 0; n < 2; ++n) _Pragma("unroll") for (int k = 0; k < 2; ++k) \
        acc[ai][bj][m][n] = __builtin_amdgcn_mfma_f32_16x16x32_bf16(Bt[n][k], At[m][k], acc[ai][bj][m][n], 0, 0, 0); __builtin_amdgcn_s_setprio(0); } while (0)
#define PG8_WAIT_V(n) asm volatile("s_waitcnt vmcnt(" #n ")" ::: "memory")
#define PG8_WAIT_L(n) asm volatile("s_waitcnt lgkmcnt(" #n ")" ::: "memory")
#define PG8_BAR __builtin_amdgcn_s_barrier()
#define PG8_SCHED __builtin_amdgcn_sched_barrier(0)
    Unit cur, nxt; int ui = 0;
    if (!S.next(0, cur)) return;
    f32x4 acc[2][2][4][2];
#pragma unroll
    for (int a = 0; a < 2; ++a)
#pragma unroll
        for (int b = 0; b < 2; ++b)
#pragma unroll
            for (int m = 0; m < 4; ++m)
#pragma unroll
                for (int n = 0; n < 2; ++n) acc[a][b][m][n] = (f32x4){0.f, 0.f, 0.f, 0.f};
    bf16x8 At[4][2], B0[2][2], B1[2][2];
    const char* cA = cur.A; const char* cB = cur.B;
    if constexpr (SP2) {
        PG8_STAGE(PG8_SB(0, 0), cB, voffB); PG8_STAGE(PG8_SB(0, 1), cB + hstepB, voffB); PG8_STAGE(PG8_SA(0, 0), cA, voffA); PG8_STAGE(PG8_SA(0, 1), cA + hstepA, voffA);
        if (wr == 1) PG8_BAR;
        PG8_WAIT_V(2); PG8_BAR;
        PG8_STAGE(PG8_SB(1, 0), cB + kstep, voffB); PG8_STAGE(PG8_SA(1, 0), cA + kstep, voffA); PG8_STAGE(PG8_SB(1, 1), cB + hstepB + kstep, voffB);
        PG8_WAIT_V(6); PG8_BAR;
    } else {
        PG8_STAGE(PG8_SB(0, 0), cB, voffB); PG8_STAGE(PG8_SA(0, 0), cA, voffA); PG8_STAGE(PG8_SB(0, 1), cB + hstepB, voffB); PG8_STAGE(PG8_SA(0, 1), cA + hstepA, voffA);
        if (wr == 1) PG8_BAR;
        PG8_WAIT_V(4); PG8_BAR;
        PG8_STAGE(PG8_SB(1, 0), cB + kstep, voffB); PG8_STAGE(PG8_SA(1, 0), cA + kstep, voffA); PG8_STAGE(PG8_SB(1, 1), cB + hstepB + kstep, voffB);
        PG8_WAIT_V(6); PG8_BAR;
    }
    for (;;) {
        const bool has_next = S.next(ui + 1, nxt);
        const char* nA = has_next ? nxt.A : cA; const char* nB = has_next ? nxt.B : cB;
        for (int t = 0; t < nt; t += 2) {
            const bool last = (t == nt - 2);
            const char* a1 = cA + (size_t)(t + 1) * kstep;
            const char* a2 = last ? nA : cA + (size_t)(t + 2) * kstep; const char* b2 = last ? nB : cB + (size_t)(t + 2) * kstep;
            const char* a3 = a2 + kstep; const char* b3 = b2 + kstep;
            if constexpr (SP2) {
            PG8_LDB(B0, 0, 0); PG8_LDB(B1, 0, 1); PG8_SCHED; PG8_LDA(At, 0, 0); PG8_STAGE(PG8_SA(1, 1), a1 + hstepA, voffA);
            PG8_WAIT_V(8); PG8_WAIT_L(0); PG8_BAR; PG8_MMA(0, 0, At, B0); PG8_MMA(0, 1, At, B1); PG8_BAR; PG8_SCHED;
            PG8_LDA(At, 0, 1); PG8_STAGE(PG8_SB(0, 0), b2, voffB); PG8_STAGE(PG8_SB(0, 1), b2 + hstepB, voffB); PG8_STAGE(PG8_SA(0, 0), a2, voffA);
            PG8_WAIT_V(8); PG8_WAIT_L(0); PG8_BAR; PG8_MMA(1, 0, At, B0); PG8_MMA(1, 1, At, B1); PG8_BAR; PG8_SCHED;
            PG8_LDB(B0, 1, 0); PG8_LDB(B1, 1, 1); PG8_SCHED; PG8_LDA(At, 1, 0); PG8_STAGE(PG8_SA(0, 1), a2 + hstepA, voffA);
            PG8_WAIT_V(8); PG8_WAIT_L(0); PG8_BAR; PG8_MMA(0, 0, At, B0); PG8_MMA(0, 1, At, B1); PG8_BAR; PG8_SCHED;
            PG8_LDA(At, 1, 1); PG8_STAGE(PG8_SB(1, 0), b3, voffB); PG8_STAGE(PG8_SB(1, 1), b3 + hstepB, voffB); PG8_STAGE(PG8_SA(1, 0), a3, voffA);
            PG8_WAIT_V(8); PG8_WAIT_L(0); PG8_BAR; PG8_MMA(1, 0, At, B0); PG8_MMA(1, 1, At, B1); PG8_BAR; PG8_SCHED;
            } else {
            PG8_LDB(B0, 0, 0); PG8_SCHED; PG8_LDA(At, 0, 0); PG8_STAGE(PG8_SA(1, 1), a1 + hstepA, voffA);
            PG8_WAIT_L(8); PG8_BAR; PG8_WAIT_L(0); PG8_MMA(0, 0, At, B0); PG8_BAR; PG8_SCHED;
            PG8_LDB(B1, 0, 1); PG8_STAGE(PG8_SB(0, 0), b2, voffB);
            PG8_BAR; PG8_WAIT_L(0); PG8_MMA(0, 1, At, B1); PG8_BAR;
            PG8_LDA(At, 0, 1); PG8_STAGE(PG8_SA(0, 0), a2, voffA);
            PG8_BAR; PG8_WAIT_L(0); PG8_MMA(1, 0, At, B0); PG8_BAR; PG8_SCHED;
            PG8_STAGE(PG8_SB(0, 1), b2 + hstepB, voffB);
            PG8_WAIT_V(6); PG8_BAR; PG8_MMA(1, 1, At, B1); PG8_BAR;
            PG8_LDB(B0, 1, 0); PG8_SCHED; PG8_LDA(At, 1, 0); PG8_STAGE(PG8_SA(0, 1), a2 + hstepA, voffA);
            PG8_WAIT_L(8); PG8_BAR; PG8_WAIT_L(0); PG8_MMA(0, 0, At, B0); PG8_BAR; PG8_SCHED;
            PG8_LDB(B1, 1, 1); PG8_STAGE(PG8_SB(1, 0), b3, voffB);
            PG8_BAR; PG8_WAIT_L(0); PG8_MMA(0, 1, At, B1); PG8_BAR;
            PG8_LDA(At, 1, 1); PG8_STAGE(PG8_SA(1, 0), a3, voffA);
            PG8_BAR; PG8_WAIT_L(0); PG8_MMA(1, 0, At, B0); PG8_BAR; PG8_SCHED;
            PG8_STAGE(PG8_SB(1, 1), b3 + hstepB, voffB);
            PG8_WAIT_V(6); PG8_BAR; PG8_MMA(1, 1, At, B1); PG8_BAR;
            }
        }
        if constexpr (ALIGN_EPI) { if (wr == 0) PG8_BAR; }
        { int t2 = threadIdx.x; asm volatile("" : "+v"(t2)); const int l2 = t2 & 63; E(acc, cur, wr, wc, l2 & 15, l2 >> 4); }
        if constexpr (false) { E(acc, cur, wr, wc, fr, fq); }
        if (!has_next) break;
#pragma unroll
        for (int a = 0; a < 2; ++a)
#pragma unroll
            for (int b = 0; b < 2; ++b)
#pragma unroll
                for (int m = 0; m < 4; ++m)
#pragma unroll
                    for (int n = 0; n < 2; ++n) acc[a][b][m][n] = (f32x4){0.f, 0.f, 0.f, 0.f};
        cur = nxt; cA = nA; cB = nB; ++ui;
        if constexpr (ALIGN_EPI) { if (wr == 1) PG8_BAR; }
    }
    PG8_WAIT_V(0);
    if constexpr (!ALIGN_EPI) { if (wr == 0) PG8_BAR; }
    PG8_BAR;
    #undef PG8_SA
#undef PG8_SB
#undef PG8_STAGE
#undef PG8_LDA
#undef PG8_LDB
#undef PG8_MMA
#undef PG8_WAIT_V
#undef PG8_WAIT_L
#undef PG8_BAR
#undef PG8_SCHED
}

__device__ __forceinline__ float silu_f(float g) { return g * __builtin_amdgcn_rcpf(1.0f + __builtin_amdgcn_exp2f(-1.44269504f * g)); }
struct EpiSwiGLU { static constexpr bool PERM = true, AFTER_DRAIN = false; bf16_t* O; long long ldc;
    __device__ __forceinline__ void operator()(const f32x4 (&acc)[2][2][4][2], const Unit& u, int wr, int wc, int fr, int fq) const {
        const int row0 = u.pm * BM + wr * 64 + fr, col0 = u.pn * HALF + wc * 32 + 8 * fq;
#pragma unroll
        for (int ai = 0; ai < 2; ++ai)
#pragma unroll
            for (int m = 0; m < 4; ++m) { bf16_t* rowp = O + (size_t)(row0 + ai * HALF + m * 16) * ldc + col0;
                const f32x4 g0 = acc[ai][0][m][0], g1 = acc[ai][0][m][1], u0 = acc[ai][1][m][0], u1 = acc[ai][1][m][1];
                u32x4 w; w.x = cvt_pk_bf16(silu_f(g0[0]) * u0[0], silu_f(g0[1]) * u0[1]); w.y = cvt_pk_bf16(silu_f(g0[2]) * u0[2], silu_f(g0[3]) * u0[3]);
                w.z = cvt_pk_bf16(silu_f(g1[0]) * u1[0], silu_f(g1[1]) * u1[1]); w.w = cvt_pk_bf16(silu_f(g1[2]) * u1[2], silu_f(g1[3]) * u1[3]);
                *(u32x4*)rowp = w; }
    }
};
struct EpiBf16 { static constexpr bool PERM = true, AFTER_DRAIN = false; bf16_t* O; long long ldc; const float* rs; float scale; int coff;
    __device__ __forceinline__ void operator()(const f32x4 (&acc)[2][2][4][2], const Unit& u, int wr, int wc, int fr, int fq) const {
        const int row0 = u.pm * BM + wr * 64 + fr, col0 = coff + u.pn * BM + wc * 32 + 8 * fq;
#pragma unroll
        for (int ai = 0; ai < 2; ++ai)
#pragma unroll
            for (int m = 0; m < 4; ++m) { const int row = row0 + ai * HALF + m * 16; bf16_t* rowp = O + (size_t)row * ldc + col0; const float s = rs ? rs[row] : scale;
#pragma unroll
                for (int bj = 0; bj < 2; ++bj) { const f32x4 v0 = acc[ai][bj][m][0] * s, v1 = acc[ai][bj][m][1] * s;
                    u32x4 w; w.x = cvt_pk_bf16(v0[0], v0[1]); w.y = cvt_pk_bf16(v0[2], v0[3]); w.z = cvt_pk_bf16(v1[0], v1[1]); w.w = cvt_pk_bf16(v1[2], v1[3]);
                    *(u32x4*)(rowp + bj * HALF) = w; } }
    }
};
struct EpiResid { static constexpr bool PERM = false, AFTER_DRAIN = false; float* X; const float* g;
    __device__ __forceinline__ void operator()(const f32x4 (&acc)[2][2][4][2], const Unit& u, int wr, int wc, int fr, int fq) const {
        const int row0 = u.pm * BM + wr * 64 + fr, col0 = u.pn * BM + wc * 32 + 4 * fq;
        const float* gp = g + (size_t)((u.pm * BM) >> 13) * 6144 + col0;
        f32x4 gv[2][2];
#pragma unroll
        for (int bj = 0; bj < 2; ++bj)
#pragma unroll
            for (int n = 0; n < 2; ++n) gv[bj][n] = *(const f32x4*)(gp + bj * HALF + n * 16);
#pragma unroll
        for (int ai = 0; ai < 2; ++ai)
#pragma unroll
            for (int m = 0; m < 4; ++m) { float* rowp = X + (size_t)(row0 + ai * HALF + m * 16) * 1024 + col0;
#pragma unroll
                for (int bj = 0; bj < 2; ++bj)
#pragma unroll
                    for (int n = 0; n < 2; ++n) { f32x4* p = (f32x4*)(rowp + bj * HALF + n * 16); *p = *p + gv[bj][n] * acc[ai][bj][m][n]; } }
    }
};
struct EpiF32 { static constexpr bool PERM = false, AFTER_DRAIN = false; float* C; long long ldc;
    __device__ __forceinline__ void operator()(const f32x4 (&acc)[2][2][4][2], const Unit& u, int wr, int wc, int fr, int fq) const {
        const int row0 = u.pm * BM + wr * 64 + fr, col0 = u.pn * BM + wc * 32 + 4 * fq;
#pragma unroll
        for (int ai = 0; ai < 2; ++ai)
#pragma unroll
            for (int m = 0; m < 4; ++m) { float* rowp = C + (size_t)(row0 + ai * HALF + m * 16) * ldc + col0;
#pragma unroll
                for (int bj = 0; bj < 2; ++bj)
#pragma unroll
                    for (int n = 0; n < 2; ++n) *(f32x4*)(rowp + bj * HALF + n * 16) = acc[ai][bj][m][n]; }
    }
};
struct SchedPlain { const char* A; const char* B; size_t a_tile, b_tile; int nM, nN, G, c, wgm, pad;
    __device__ __forceinline__ bool next(int i, Unit& u) const { int tm, tn; if (!tile_of(i, G, c, nM, nN, wgm, tm, tn)) return false;
        u.pm = tm; u.pn = tn; u.A = A + (size_t)tm * a_tile; u.B = B + (size_t)tn * b_tile; return true; } };
struct SchedMoE { const char* A; const char* B; size_t a_tile, b_tile; int nN, G, c, i0, cnt, pad;
    __device__ __forceinline__ bool next(int i, Unit& u) const { int tm, tn; if (i >= cnt || !tile_of(i + i0, G, c, 128, nN, 8, tm, tn)) return false;
        const int e = tm >> 3, b = (tm >> 2) & 1, r = tm & 3, pm = ((b * 16 + e) << 2) + r;
        u.pm = pm; u.pn = tn; u.A = A + (size_t)pm * a_tile; u.B = B + (size_t)(e * nN + tn) * b_tile; return true; } };
}

constexpr int D = 1024, NB = 2, S = 8192, DEPTH = 4, T = NB * S;
constexpr int NG = 4, GD = 256, HD = 64, NH = 16, NKV = 4, WIN = 128, NE = 16, CAP = 1024, DE = 2048, QKVN = 1536;
constexpr float EPS = 1e-6f;
constexpr int NWAVES = 8, NTHR = 512;

constexpr size_t MiB = 1u << 20;
constexpr size_t WS_CTL = 0, CTL_ZERO_BYTES = 1 * MiB;
constexpr size_t WS_MOD = 1 * MiB;
constexpr size_t WS_TAB = 2 * MiB;
constexpr size_t WS_MBT = 4 * MiB;
constexpr size_t WS_WQKV = 8 * MiB;
constexpr size_t WS_WAO = 14 * MiB;
constexpr size_t WS_WFO = 18 * MiB;
constexpr size_t WS_WFF = 22 * MiB;
constexpr size_t WS_CS = 30 * MiB;
constexpr size_t WS_AFF = 32 * MiB;
constexpr size_t WS_IDX = 33 * MiB;
constexpr size_t WS_GATE = 33 * MiB + 512 * 1024;
constexpr size_t WS_SLOT = 34 * MiB;
constexpr size_t WS_MISC = 35 * MiB;
constexpr size_t WS_PAR = 36 * MiB;
constexpr int PAR_NMIX = 0, PAR_NFFN = 4096, PAR_QG = 8192, PAR_KG = 8192 + 128, PAR_SINK = 8192 + 256, PAR_WR = 16384;
constexpr size_t WS_H = 64 * MiB;
constexpr size_t WS_XIN = 96 * MiB;
constexpr size_t WS_ACT = 160 * MiB;
constexpr size_t WS_Y = 288 * MiB;
constexpr size_t WS_QKV = 352 * MiB;
constexpr size_t WS_O = 400 * MiB;
constexpr size_t WS_TA = 432 * MiB;
constexpr size_t WS_YF = 464 * MiB;
constexpr size_t WS_PQ = 496 * MiB;
constexpr size_t WS_W1 = 576 * MiB;
constexpr size_t WS_W2 = 1088 * MiB;
constexpr size_t WS_GOLD = 1344 * MiB;
constexpr size_t WS_END = 1792 * MiB;
constexpr int CW_BAR = 4096;

constexpr int RING_BYTES = 133120;
constexpr int MISC_OFF = RING_BYTES;
constexpr int LDS_BYTES = 147456;

#define GAS __attribute__((address_space(1)))
#define LAS __attribute__((address_space(3)))
typedef unsigned short bf16;
typedef unsigned v4u __attribute__((ext_vector_type(4)));
typedef unsigned v2u __attribute__((ext_vector_type(2)));
typedef float f32x4 __attribute__((ext_vector_type(4)));
typedef short bf16x8 __attribute__((ext_vector_type(8)));
#define LDS_WAIT() asm volatile("s_waitcnt lgkmcnt(0)" ::: "memory")
#define VM_WAIT() asm volatile("s_waitcnt vmcnt(0)" ::: "memory")
__device__ __forceinline__ unsigned f2bf(float f) { unsigned u = __builtin_bit_cast(unsigned, f); return (u + 0x7fffu + ((u >> 16) & 1u)) >> 16; }
__device__ __forceinline__ unsigned pk2(float lo, float hi) { return f2bf(lo) | (f2bf(hi) << 16); }
__device__ __forceinline__ float bf_lo(unsigned w) { return __builtin_bit_cast(float, w << 16); }
__device__ __forceinline__ float bf_hi(unsigned w) { return __builtin_bit_cast(float, w & 0xffff0000u); }
__device__ __forceinline__ float shx(float v, int o, int lane) { return __builtin_bit_cast(float, __builtin_amdgcn_ds_bpermute((lane ^ o) << 2, __builtin_bit_cast(int, v))); }
__device__ __forceinline__ unsigned shl_from(unsigned v, int src_lane) { return (unsigned)__builtin_amdgcn_ds_bpermute((src_lane & 63) << 2, (int)v); }
__device__ __forceinline__ float wave_sum(float v, int lane) {
#pragma unroll
    for (int o = 1; o < 64; o <<= 1) v += shx(v, o, lane);
    return v;
}

#define XB_TMO      128
#define XB_XCNT(j)  (256  + 64 * (j))
#define XB_XSUB(j)  (1280 + 64 * (j))
#define XB_XGEN(j)  (2304 + 64 * (j))
#define XB_TOP      3328
#define XB_TOPGEN   3392
#define XCD_BAR_WORDS 3456
#define XB_SPIN_CAP (1u << 18)

__device__ __forceinline__ unsigned xb_ld(unsigned* p)              { return __hip_atomic_load(p, __ATOMIC_RELAXED, __HIP_MEMORY_SCOPE_AGENT); }
__device__ __forceinline__ unsigned xb_add(unsigned* p, unsigned v) { return __hip_atomic_fetch_add(p, v, __ATOMIC_RELAXED, __HIP_MEMORY_SCOPE_AGENT); }
__device__ __forceinline__ unsigned xb_xcc_id() { return (unsigned)__builtin_amdgcn_s_getreg((3 << 11) | 20) & 0xFu; }
#define XB_SPIN(cond, bar) do { unsigned _sp = 0; while (cond) { __builtin_amdgcn_s_sleep(1); \
    if ((++_sp & 255u) == 0u) { if (xb_ld(&(bar)[XB_TMO])) break; if (_sp > XB_SPIN_CAP) { atomicAdd(&(bar)[XB_TMO], 1u); break; } } } } while (0)

struct XcdBarrier {
    unsigned* bar; unsigned x;
    volatile LAS unsigned* st;
};

__device__ __forceinline__ XcdBarrier xcd_barrier_post(unsigned* bar, volatile LAS unsigned* st) {
    XcdBarrier b; b.bar = bar; b.x = xb_xcc_id(); b.st = st;
    if (threadIdx.x == 0) (void)xb_add(&bar[XB_XCNT(b.x)], 1u);
    return b;
}
__device__ __forceinline__ void xcd_barrier_complete(unsigned* bar, unsigned x, unsigned& nloc, unsigned& nx) {
    const unsigned G = gridDim.x * gridDim.y * gridDim.z;
    unsigned sum, cnt, mine, sp = 0u;
    for (;;) {
        sum = 0u; cnt = 0u; mine = 0u;
#pragma unroll
        for (unsigned j = 0; j < 16; ++j) { const unsigned c = xb_ld(&bar[XB_XCNT(j)]); sum += c; cnt += (c > 0u) ? 1u : 0u; mine = (j == x) ? c : mine; }
        if (sum == G) break;
        __builtin_amdgcn_s_sleep(1);
        if ((++sp & 255u) == 0u) { if (xb_ld(&bar[XB_TMO])) break; if (sp > XB_SPIN_CAP) { atomicAdd(&bar[XB_TMO], 1u); break; } }
    }
    nloc = mine > 0u ? mine : 1u; nx = cnt > 0u ? cnt : 1u;
}

__device__ __forceinline__ void xcd_barrier(const XcdBarrier& b) {
    asm volatile("s_waitcnt vmcnt(0)" ::: "memory");
    __syncthreads();
    if (threadIdx.x == 0) {
        unsigned* bar = b.bar;
        __builtin_amdgcn_s_waitcnt(0);
        unsigned nloc = b.st[0], nx = b.st[1];
        if (nloc == 0u) { xcd_barrier_complete(bar, b.x, nloc, nx); b.st[0] = nloc; b.st[1] = nx; }
        const unsigned old = xb_add(&bar[XB_XSUB(b.x)], 1u);
        const unsigned gen = old / nloc;
        if (old + 1u == (gen + 1u) * nloc) {
            __builtin_amdgcn_fence(__ATOMIC_RELEASE, "agent");
            asm volatile("s_waitcnt vmcnt(0)" ::: "memory");
            const unsigned og = xb_add(&bar[XB_TOP], 1u);
            const unsigned tg = og / nx;
            if (og + 1u == (tg + 1u) * nx) xb_add(&bar[XB_TOPGEN], 1u);
            else XB_SPIN(xb_ld(&bar[XB_TOPGEN]) == tg, bar);
            __builtin_amdgcn_fence(__ATOMIC_ACQUIRE, "agent");
            xb_add(&bar[XB_XGEN(b.x)], 1u);
            asm volatile("s_waitcnt vmcnt(0)" ::: "memory");
        } else {
            XB_SPIN(xb_ld(&bar[XB_XGEN(b.x)]) == gen, bar);
            __builtin_amdgcn_fence(__ATOMIC_ACQUIRE, "agent");
            asm volatile("s_waitcnt vmcnt(0)" ::: "memory");
        }
    }
    __syncthreads();
}


struct Params { const float* in[17]; float* out; unsigned char* ws; int ph_lo, ph_hi; };
enum { IN_X = 0, IN_C, IN_WADA, IN_BADA, IN_NMIX, IN_NFFN, IN_WFO, IN_WQKV, IN_WAO, IN_QG, IN_KG, IN_SINK, IN_RELB, IN_WR, IN_WG, IN_WU, IN_WD };
struct Frame { LAS unsigned char* lds; int tid, lane, wave, vcu, G; };

struct CvtItem { const float* src; bf16* dst; int N, ldk; };
__device__ __forceinline__ void cvt_load(const CvtItem& it, f32x4 (&v)[16], int lane) {
    const int kr = lane >> 4, nc = (lane & 15) * 4;
#pragma unroll
    for (int i = 0; i < 16; ++i) v[i] = __builtin_nontemporal_load((const GAS f32x4*)(it.src + (size_t)(4 * i + kr) * it.N + nc));
}
__device__ __forceinline__ void cvt_store(const CvtItem& it, const f32x4 (&v)[16], LAS float* scr, int lane) {
    const int kr = lane >> 4, nc = (lane & 15) * 4;
#pragma unroll
    for (int i = 0; i < 16; ++i) { LAS float* p = scr + (4 * i + kr) * 65 + nc; p[0] = v[i].x; p[1] = v[i].y; p[2] = v[i].z; p[3] = v[i].w; }
    LDS_WAIT(); asm volatile("" ::: "memory");
    const int c = lane & 7;
#pragma unroll
    for (int j = 0; j < 8; ++j) { const int n = (lane >> 3) + 8 * j; const LAS float* s = scr + (8 * c) * 65 + n;
        v4u o; o.x = pk2(s[0 * 65], s[1 * 65]); o.y = pk2(s[2 * 65], s[3 * 65]); o.z = pk2(s[4 * 65], s[5 * 65]); o.w = pk2(s[6 * 65], s[7 * 65]);
        __builtin_nontemporal_store(o, (GAS v4u*)(it.dst + (size_t)n * it.ldk + 8 * c)); }
    LDS_WAIT(); asm volatile("" ::: "memory");
}

__device__ __forceinline__ CvtItem moe_item(const Params& p, int l, int it) {
    bf16* W1 = (bf16*)(p.ws + WS_W1) + (size_t)l * NE * 4096 * 1024; bf16* W2 = (bf16*)(p.ws + WS_W2) + (size_t)l * NE * 1024 * 2048;
    const int kind = it >> 13, r = it & 8191; CvtItem ci;
    if (kind < 2) { const int e = r >> 9, kt = (r >> 5) & 15, ntile = r & 31; const int n0 = ntile * 64, k0 = kt * 64;
        ci.src = (kind ? p.in[IN_WU] : p.in[IN_WG]) + (size_t)l * NE * D * DE + (size_t)e * D * DE + (size_t)k0 * DE + n0; ci.N = DE;
        ci.dst = W1 + ((size_t)e * 4096 + (size_t)(n0 >> 7) * 256 + kind * 128 + (n0 & 127)) * 1024 + k0; ci.ldk = 1024;
    } else { const int e = r >> 9, kt = (r >> 4) & 31, ntile = r & 15; const int n0 = ntile * 64, k0 = kt * 64;
        ci.src = p.in[IN_WD] + (size_t)l * NE * DE * D + (size_t)e * DE * D + (size_t)k0 * D + n0; ci.N = D;
        ci.dst = W2 + ((size_t)e * 1024 + n0) * 2048 + k0; ci.ldk = 2048; }
    return ci;
}
__device__ __forceinline__ void cvt_moe_layer(const Params& p, Frame& F, int l, int w0, int nw, int iend) {
    LAS float* scr = (LAS float*)(F.lds + F.wave * 16640);
    if (w0 >= iend) return;
    f32x4 va[16], vb[16];
    CvtItem ca = moe_item(p, l, w0), cb = ca; cvt_load(ca, va, F.lane);
    for (int it = w0; it < iend; it += 2 * nw) {
        const bool hb = it + nw < iend;
        if (hb) { cb = moe_item(p, l, it + nw); cvt_load(cb, vb, F.lane); }
        cvt_store(ca, va, scr, F.lane);
        const bool ha = it + 2 * nw < iend;
        if (ha) { ca = moe_item(p, l, it + 2 * nw); cvt_load(ca, va, F.lane); }
        if (hb) cvt_store(cb, vb, scr, F.lane);
    }
}

__device__ __forceinline__ void phase_ma(const Params& p, Frame& F, int l, const bool fd, const float* xin) {
    LAS float* wrp = (LAS float*)F.lds;
    const float* wr = (const float*)(p.ws + WS_PAR) + PAR_WR + (size_t)l * D * NE;
    for (int s = F.tid; s < D * NE; s += NTHR) { const int c = s >> 4, e = s & 15; wrp[(((e * 4 + (c >> 8)) * 4 + (c & 3)) << 6) + ((c & 255) >> 2)] = wr[s]; }
    __syncthreads();
    const float* mod = (const float*)(p.ws + WS_MOD) + (size_t)l * NB * 6 * D;
    const float* gain = (const float*)(p.ws + WS_PAR) + PAR_NFFN + l * D;
    const int gw = F.vcu * NWAVES + F.wave, NGW = F.G * NWAVES;
    const int b = (gw * 2) / NGW, wsub = gw - b * (NGW / 2), nsub = NGW / 2;
    f32x4 Av[4], Bv[4];
#pragma unroll
    for (int j = 0; j < 4; ++j) { const int c = 256 * j + 4 * F.lane; const f32x4 g = *(const f32x4*)(gain + c), sc = *(const f32x4*)(mod + b * 6 * D + 4 * D + c);
        Av[j] = g * (sc + 1.0f); Bv[j] = *(const f32x4*)(mod + b * 6 * D + 3 * D + c); }
    float* x = p.out; bf16* H = (bf16*)(p.ws + WS_H); float* aff = (float*)(p.ws + WS_AFF);
    const float* PQ = (const float*)(p.ws + WS_PQ); const float* y4096 = (const float*)(p.ws + WS_MISC);
    f32x4 G1[4];
#pragma unroll
    for (int j = 0; j < 4; ++j) G1[j] = fd ? *(const f32x4*)(mod + b * 6 * D + 2 * D + 256 * j + 4 * F.lane) : (f32x4){0.f, 0.f, 0.f, 0.f};
    for (int s0 = wsub; s0 < S; s0 += 4 * nsub) {
        asm volatile("" ::: "memory");
        f32x4 h[4][4]; float rs[4];
#pragma unroll
        for (int r = 0; r < 4; ++r) { const int row = b * S + s0 + r * nsub; float ss = 0.f;
            if (fd) { const int k = s0 + r * nsub, m = k & 63, qd = k >> 6; int rr; float sg = 1.0f; bool special = false;
                if (m >= 1 && m <= 31) { rr = m * 128 + qd; }
                else if (m >= 33) { const int kp = S - k; rr = (kp & 63) * 128 + (kp >> 6); sg = -1.0f; }
                else if (m == 0) { if (qd <= 63) rr = qd; else if (qd == 64) { rr = 0; special = true; } else { rr = 128 - qd; sg = -1.0f; } }
                else { if (qd <= 63) rr = 64 + qd; else { rr = 64 + (127 - qd); sg = -1.0f; } }
                const float* P = PQ + ((size_t)(b * 4096 + rr)) * 2048;
#pragma unroll
                for (int j = 0; j < 4; ++j) { const int cc = 256 * j + 4 * F.lane; f32x4 y;
                    if (special) y = *(const f32x4*)(y4096 + b * 1024 + cc); else y = *(const GAS f32x4*)(P + cc) + *(const GAS f32x4*)(P + 1024 + cc) * sg;
                    const f32x4 xn = *(const GAS f32x4*)(xin + (size_t)row * D + cc) + G1[j] * y; *(GAS f32x4*)(x + (size_t)row * D + cc) = xn; h[r][j] = xn; } }
#pragma unroll
            for (int j = 0; j < 4; ++j) { if (!fd) h[r][j] = *(const GAS f32x4*)(x + (size_t)row * D + 256 * j + 4 * F.lane); ss += (h[r][j].x * h[r][j].x + h[r][j].y * h[r][j].y) + (h[r][j].z * h[r][j].z + h[r][j].w * h[r][j].w); }
            rs[r] = ss; }
#pragma unroll
        for (int r = 0; r < 4; ++r) { const int row = b * S + s0 + r * nsub; const float rstd = rsqrtf(wave_sum(rs[r], F.lane) * (1.0f / D) + EPS);
#pragma unroll
            for (int j = 0; j < 4; ++j) { h[r][j] = h[r][j] * rstd * Av[j] + Bv[j];
                v2u o; o.x = pk2(h[r][j].x, h[r][j].y); o.y = pk2(h[r][j].z, h[r][j].w); *(GAS v2u*)(H + (size_t)row * D + 256 * j + 4 * F.lane) = o; } }
        float th2[4][2];
#pragma unroll
        for (int hh = 0; hh < 2; ++hh) {
            asm volatile("" ::: "memory");
            float v[4][8];
#pragma unroll
            for (int ei = 0; ei < 8; ++ei) { const int e = 8 * hh + ei; float a0 = 0.f, a1 = 0.f, a2 = 0.f, a3 = 0.f;
#pragma unroll
                for (int j = 0; j < 4; ++j) { const LAS float* w = wrp + (((e * 4 + j) * 4) << 6) + F.lane; const float w0 = w[0], w1 = w[64], w2 = w[128], w3 = w[192];
                    a0 += h[0][j].x * w0 + h[0][j].y * w1 + h[0][j].z * w2 + h[0][j].w * w3; a1 += h[1][j].x * w0 + h[1][j].y * w1 + h[1][j].z * w2 + h[1][j].w * w3;
                    a2 += h[2][j].x * w0 + h[2][j].y * w1 + h[2][j].z * w2 + h[2][j].w * w3; a3 += h[3][j].x * w0 + h[3][j].y * w1 + h[3][j].z * w2 + h[3][j].w * w3; }
                v[0][ei] = a0; v[1][ei] = a1; v[2][ei] = a2; v[3][ei] = a3; }
#pragma unroll
            for (int r = 0; r < 4; ++r) { float t4[4], t2[2];
                { const bool hi = (F.lane & 32) != 0;
#pragma unroll
                  for (int i = 0; i < 4; ++i) { const float send = hi ? v[r][i] : v[r][i + 4], keep = hi ? v[r][i + 4] : v[r][i]; t4[i] = keep + shx(send, 32, F.lane); } }
                { const bool hi = (F.lane & 16) != 0;
#pragma unroll
                  for (int i = 0; i < 2; ++i) { const float send = hi ? t4[i] : t4[i + 2], keep = hi ? t4[i + 2] : t4[i]; t2[i] = keep + shx(send, 16, F.lane); } }
                { const bool hi = (F.lane & 8) != 0; const float send = hi ? t2[0] : t2[1], keep = hi ? t2[1] : t2[0]; th2[r][hh] = keep + shx(send, 8, F.lane); } }
        }
#pragma unroll
        for (int r = 0; r < 4; ++r) { float t1;
            { const bool hi = (F.lane & 4) != 0; const float send = hi ? th2[r][0] : th2[r][1], keep = hi ? th2[r][1] : th2[r][0]; t1 = keep + shx(send, 4, F.lane); }
            t1 += shx(t1, 1, F.lane); t1 += shx(t1, 2, F.lane);
            float mx = t1;
#pragma unroll
            for (int o = 4; o < 64; o <<= 1) mx = fmaxf(mx, shx(mx, o, F.lane));
            const float pe = expf(t1 - mx); float sum = pe;
#pragma unroll
            for (int o = 4; o < 64; o <<= 1) sum += shx(sum, o, F.lane);
            const int e = ((F.lane >> 2) & 1) * 8 + ((F.lane >> 5) & 1) * 4 + ((F.lane >> 4) & 1) * 2 + ((F.lane >> 3) & 1);
            if ((F.lane & 3) == 0) aff[((size_t)b * NE + e) * S + s0 + r * nsub] = pe / sum; }
    }
}

__device__ __forceinline__ void phase_mb(const Params& p, Frame& F) {
    LAS unsigned* hist = (LAS unsigned*)F.lds;
    LAS unsigned* ctl = hist + 256;
    LAS unsigned* wtot = hist + 320;
    const float* aff = (const float*)(p.ws + WS_AFF); int* idx = (int*)(p.ws + WS_IDX); float* gate = (float*)(p.ws + WS_GATE); int* slotmap = (int*)(p.ws + WS_SLOT);
    for (int z = F.vcu; z < NB * NE; z += F.G) {
        unsigned key[16];
#pragma unroll
        for (int q = 0; q < 4; ++q) { const v4u k4 = *(const GAS v4u*)(aff + (size_t)z * S + F.tid * 16 + 4 * q); key[4 * q] = k4.x; key[4 * q + 1] = k4.y; key[4 * q + 2] = k4.z; key[4 * q + 3] = k4.w; }
        unsigned prefix = 0u, need = CAP;
#pragma unroll
        for (int pass = 0; pass < 4; ++pass) {
            const int shift = 24 - 8 * pass;
            __syncthreads();
            if (F.tid < 256) hist[F.tid] = 0u;
            __syncthreads();
#pragma unroll
            for (int u = 0; u < 16; ++u) { const unsigned hi = (pass == 0) ? 0u : (key[u] >> ((shift + 8) & 31)); if (hi == prefix) atomicAdd((unsigned*)&hist[(key[u] >> shift) & 255u], 1u); }
            __syncthreads();
            if (F.wave == 0) {
                const unsigned h0 = hist[4 * F.lane], h1 = hist[4 * F.lane + 1], h2 = hist[4 * F.lane + 2], h3 = hist[4 * F.lane + 3];
                const unsigned tot = h0 + h1 + h2 + h3; unsigned suf = tot;
#pragma unroll
                for (int o = 1; o < 64; o <<= 1) { const unsigned t = shl_from(suf, F.lane + o); if (F.lane + o < 64) suf += t; }
                unsigned cum = suf - tot;
                if (cum < need && need <= cum + tot) {
                    unsigned d = 4 * F.lane + 3, c = h3;
                    if (cum + c < need) { cum += c; d = 4 * F.lane + 2; c = h2;
                        if (cum + c < need) { cum += c; d = 4 * F.lane + 1; c = h1;
                            if (cum + c < need) { cum += c; d = 4 * F.lane; c = h0; } } }
                    ctl[0] = (prefix << 8) | d; ctl[1] = need - cum; }
            }
            __syncthreads();
            prefix = ctl[0]; need = ctl[1];
        }
        unsigned cnt = 0u;
#pragma unroll
        for (int u = 0; u < 16; ++u) cnt += (key[u] > prefix ? 1u : 0u) + (key[u] == prefix ? 65536u : 0u);
        unsigned inc = cnt;
#pragma unroll
        for (int o = 1; o < 64; o <<= 1) { const unsigned t = shl_from(inc, F.lane - o); if (F.lane >= o) inc += t; }
        if (F.lane == 63) wtot[F.wave] = inc;
        __syncthreads();
        unsigned base = inc - cnt;
        for (int w = 0; w < F.wave; ++w) base += wtot[w];
        unsigned ng = base & 0xffffu, ne = base >> 16;
#pragma unroll
        for (int u = 0; u < 16; ++u) { const int i = F.tid * 16 + u; const bool gt = key[u] > prefix, eq = key[u] == prefix; const bool sel = gt || (eq && ne < need);
            const int slot = (int)(ng + (ne < need ? ne : need));
            if (sel) { idx[z * CAP + slot] = i; gate[z * CAP + slot] = __builtin_bit_cast(float, key[u]); }
            slotmap[(size_t)z * S + i] = sel ? slot : -1;
            ng += gt ? 1u : 0u; ne += eq ? 1u : 0u; }
        __syncthreads();
    }
}

__device__ __forceinline__ void phase_mc(const Params& p, Frame& F) {
    const int* idx = (const int*)(p.ws + WS_IDX); const bf16* H = (const bf16*)(p.ws + WS_H); bf16* X = (bf16*)(p.ws + WS_XIN);
    const int gw = F.vcu * NWAVES + F.wave, NGW = F.G * NWAVES;
    for (int d = gw; d < NB * NE * CAP; d += NGW) { const int z = d >> 10, b = z >> 4; const int src = b * S + idx[d];
        const GAS v4u* sp = (const GAS v4u*)(H + (size_t)src * D) + F.lane; GAS v4u* dp = (GAS v4u*)(X + (size_t)d * D) + F.lane;
        const v4u a = sp[0], c = sp[64]; dp[0] = a; dp[64] = c; }
}

__device__ __forceinline__ void phase_mf(const Params& p, Frame& F, int l) {
    const int* slotmap = (const int*)(p.ws + WS_SLOT); const bf16* Y = (const bf16*)(p.ws + WS_Y); float* x = p.out; bf16* H = (bf16*)(p.ws + WS_H);
    const float* mod = (const float*)(p.ws + WS_MOD) + (size_t)l * NB * 6 * D;
    const bool nxt = (l + 1 < DEPTH);
    const float* modn = mod + NB * 6 * D; const float* gainn = (const float*)(p.ws + WS_PAR) + PAR_NMIX + (l + 1) * D;
    const int gw = F.vcu * NWAVES + F.wave, NGW = F.G * NWAVES;
    const int b = (gw * 2) / NGW, wsub = gw - b * (NGW / 2), nsub = NGW / 2;
    for (int s = wsub; s < S; s += nsub) { const int row = b * S + s;
        int sl[16];
#pragma unroll
        for (int e = 0; e < 16; ++e) sl[e] = __builtin_amdgcn_readfirstlane(slotmap[((size_t)(b * NE + e)) * S + s]);
        float acc[16];
#pragma unroll
        for (int i = 0; i < 16; ++i) acc[i] = 0.f;
#pragma unroll
        for (int e = 0; e < 16; ++e) { if (sl[e] >= 0) { const GAS v4u* yp = (const GAS v4u*)(Y + ((size_t)(b * NE + e) * CAP + sl[e]) * D) + F.lane; const v4u a = yp[0], c = yp[64];
                acc[0] += bf_lo(a.x); acc[1] += bf_hi(a.x); acc[2] += bf_lo(a.y); acc[3] += bf_hi(a.y); acc[4] += bf_lo(a.z); acc[5] += bf_hi(a.z); acc[6] += bf_lo(a.w); acc[7] += bf_hi(a.w);
                acc[8] += bf_lo(c.x); acc[9] += bf_hi(c.x); acc[10] += bf_lo(c.y); acc[11] += bf_hi(c.y); acc[12] += bf_lo(c.z); acc[13] += bf_hi(c.z); acc[14] += bf_lo(c.w); acc[15] += bf_hi(c.w); } }
        float ss = 0.f;
#pragma unroll
        for (int j = 0; j < 2; ++j) { const int c0 = 512 * j + 8 * F.lane; GAS f32x4* xp = (GAS f32x4*)(x + (size_t)row * D + c0); const f32x4* gp = (const f32x4*)(mod + b * 6 * D + 5 * D + c0);
            const f32x4 g0 = gp[0], g1 = gp[1]; f32x4 x0 = xp[0], x1 = xp[1];
            x0.x += g0.x * acc[8 * j + 0]; x0.y += g0.y * acc[8 * j + 1]; x0.z += g0.z * acc[8 * j + 2]; x0.w += g0.w * acc[8 * j + 3];
            x1.x += g1.x * acc[8 * j + 4]; x1.y += g1.y * acc[8 * j + 5]; x1.z += g1.z * acc[8 * j + 6]; x1.w += g1.w * acc[8 * j + 7];
            xp[0] = x0; xp[1] = x1;
            acc[8 * j + 0] = x0.x; acc[8 * j + 1] = x0.y; acc[8 * j + 2] = x0.z; acc[8 * j + 3] = x0.w; acc[8 * j + 4] = x1.x; acc[8 * j + 5] = x1.y; acc[8 * j + 6] = x1.z; acc[8 * j + 7] = x1.w;
            ss += (x0.x * x0.x + x0.y * x0.y) + (x0.z * x0.z + x0.w * x0.w) + (x1.x * x1.x + x1.y * x1.y) + (x1.z * x1.z + x1.w * x1.w); }
        if (nxt) { const float rstd = rsqrtf(wave_sum(ss, F.lane) * (1.0f / D) + EPS);
#pragma unroll
            for (int j = 0; j < 2; ++j) { const int c0 = 512 * j + 8 * F.lane; v4u o; float hv[8];
#pragma unroll
                for (int i = 0; i < 8; ++i) hv[i] = acc[8 * j + i] * rstd * gainn[c0 + i] * (1.0f + modn[b * 6 * D + 1 * D + c0 + i]) + modn[b * 6 * D + c0 + i];
                o.x = pk2(hv[0], hv[1]); o.y = pk2(hv[2], hv[3]); o.z = pk2(hv[4], hv[5]); o.w = pk2(hv[6], hv[7]); *(GAS v4u*)(H + (size_t)row * D + c0) = o; } }
    }
}


#define MFMA16(a, b, c) __builtin_amdgcn_mfma_f32_16x16x32_bf16((a), (b), (c), 0, 0, 0)
typedef short s16x4 __attribute__((ext_vector_type(4)));
__device__ __forceinline__ unsigned lds_addr(LAS void* p) { return (unsigned)(size_t)p; }
__device__ __forceinline__ bf16x8 tr_frag(unsigned a0, unsigned a1) {
    s16x4 lo, hi;
    asm volatile("ds_read_b64_tr_b16 %0, %2\n\tds_read_b64_tr_b16 %1, %3\n\ts_waitcnt lgkmcnt(0)" : "=&v"(lo), "=&v"(hi) : "v"(a0), "v"(a1) : "memory");
    return __builtin_shufflevector(lo, hi, 0, 1, 2, 3, 4, 5, 6, 7);
}
__device__ __forceinline__ void tr_frag4(unsigned a0, unsigned a1, unsigned a2, unsigned a3, unsigned a4, unsigned a5, unsigned a6, unsigned a7, bf16x8& f0, bf16x8& f1, bf16x8& f2, bf16x8& f3) {
    s16x4 r0, r1, r2, r3, r4, r5, r6, r7;
    asm volatile("ds_read_b64_tr_b16 %0, %8\n\tds_read_b64_tr_b16 %1, %9\n\tds_read_b64_tr_b16 %2, %10\n\tds_read_b64_tr_b16 %3, %11\n\t"
                 "ds_read_b64_tr_b16 %4, %12\n\tds_read_b64_tr_b16 %5, %13\n\tds_read_b64_tr_b16 %6, %14\n\tds_read_b64_tr_b16 %7, %15\n\ts_waitcnt lgkmcnt(0)"
                 : "=&v"(r0), "=&v"(r1), "=&v"(r2), "=&v"(r3), "=&v"(r4), "=&v"(r5), "=&v"(r6), "=&v"(r7)
                 : "v"(a0), "v"(a1), "v"(a2), "v"(a3), "v"(a4), "v"(a5), "v"(a6), "v"(a7) : "memory");
    f0 = __builtin_shufflevector(r0, r1, 0, 1, 2, 3, 4, 5, 6, 7); f1 = __builtin_shufflevector(r2, r3, 0, 1, 2, 3, 4, 5, 6, 7);
    f2 = __builtin_shufflevector(r4, r5, 0, 1, 2, 3, 4, 5, 6, 7); f3 = __builtin_shufflevector(r6, r7, 0, 1, 2, 3, 4, 5, 6, 7);
}
__device__ __forceinline__ unsigned off_b(unsigned row, unsigned ch) { return 256u * row + 16u * (ch ^ (((row & 3u) << 2) | ((row >> 2) & 3u))); }
__device__ __forceinline__ unsigned tr_read_addr_16(unsigned lane, unsigned c, unsigned ks, unsigned t) {
    const unsigned g = lane >> 4, q = (lane & 15) >> 2, pp = lane & 3;
    return off_b(32 * ks + 8 * g + 4 * t + q, 2 * c + (pp >> 1)) + 8 * (pp & 1);
}

__device__ __forceinline__ void phase_aa(const Params& p, Frame& F, int l, const float* x) {
    const float* mod = (const float*)(p.ws + WS_MOD) + (size_t)l * NB * 6 * D; const float* gain = (const float*)(p.ws + WS_PAR) + PAR_NMIX + l * D;
    const int gw = F.vcu * NWAVES + F.wave, NGW = F.G * NWAVES;
    const int b = (gw * 2) / NGW, wsub = gw - b * (NGW / 2), nsub = NGW / 2;
    f32x4 Av[4], Bv[4];
#pragma unroll
    for (int j = 0; j < 4; ++j) { const int c = 256 * j + 4 * F.lane; const f32x4 g = *(const f32x4*)(gain + c), sc = *(const f32x4*)(mod + b * 6 * D + 1 * D + c);
        Av[j] = g * (sc + 1.0f); Bv[j] = *(const f32x4*)(mod + b * 6 * D + 0 * D + c); }
    bf16* H = (bf16*)(p.ws + WS_H);
    for (int s = wsub; s < S; s += nsub) {
        const int row = b * S + s;
        asm volatile("" ::: "memory");
        f32x4 h[4]; float ss = 0.f;
#pragma unroll
        for (int j = 0; j < 4; ++j) { h[j] = *(const GAS f32x4*)(x + (size_t)row * D + 256 * j + 4 * F.lane); ss += (h[j].x * h[j].x + h[j].y * h[j].y) + (h[j].z * h[j].z + h[j].w * h[j].w); }
        const float rstd = rsqrtf(wave_sum(ss, F.lane) * (1.0f / D) + EPS);
#pragma unroll
        for (int j = 0; j < 4; ++j) { h[j] = h[j] * rstd * Av[j] + Bv[j];
            v2u o; o.x = pk2(h[j].x, h[j].y); o.y = pk2(h[j].z, h[j].w); *(GAS v2u*)(H + (size_t)row * D + 256 * j + 4 * F.lane) = o; }
    }
}

constexpr int AT_KP = 144, AT_VP = 160;
constexpr int AT_KOFF = 0, AT_VOFF = 384 * AT_KP, AT_BOFF = AT_VOFF + 384 * AT_VP;
__device__ __forceinline__ void phase_ac(const Params& p, Frame& F, int l) {
    const int jl = l >> 1;
    const bf16* QKV = (const bf16*)(p.ws + WS_QKV); bf16* O = (bf16*)(p.ws + WS_O);
    const float* biasrel = (const float*)(p.ws + WS_TAB);
    const float* par = (const float*)(p.ws + WS_PAR); const float* qg = par + PAR_QG + jl * HD; const float* kg = par + PAR_KG + jl * HD; const float* sink = par + PAR_SINK + jl * NH;
    LAS unsigned char* Kimg = F.lds + AT_KOFF; LAS unsigned char* Vimg = F.lds + AT_VOFF; LAS float* btab = (LAS float*)(F.lds + AT_BOFF);
    const int lane = F.lane, g4 = lane >> 4, ql = lane & 15;
    const int hq = F.wave >> 1, th = F.wave & 1;
    constexpr float LOG2E = 1.44269504f;
    for (int U = F.vcu; U < NB * 64 * NKV; U += F.G) {
        const int b = U >> 8, n = (U >> 2) & 63, kvh = U & 3, h = kvh * 4 + hq;
        __syncthreads();
        { const int part = F.tid & 7; f32x4 kg0 = *(const f32x4*)(kg + part * 8), kg1 = *(const f32x4*)(kg + part * 8 + 4);
#pragma unroll
          for (int i = 0; i < 6; ++i) { const int row = (F.tid >> 3) + 64 * i; const int kpos = n * 128 - 128 + row; const bool ok = (kpos >= 0) && (kpos < S);
              v4u kq = (v4u){0u, 0u, 0u, 0u}, vq = (v4u){0u, 0u, 0u, 0u};
              if (ok) { const bf16* base = QKV + ((size_t)b * S + kpos) * QKVN + NH * HD + kvh * HD + part * 8; kq = *(const GAS v4u*)base; vq = *(const GAS v4u*)(base + NKV * HD); }
              float f[8] = {bf_lo(kq.x), bf_hi(kq.x), bf_lo(kq.y), bf_hi(kq.y), bf_lo(kq.z), bf_hi(kq.z), bf_lo(kq.w), bf_hi(kq.w)};
              float ss = 0.f;
#pragma unroll
              for (int e = 0; e < 8; ++e) ss += f[e] * f[e];
              ss += shx(ss, 1, F.lane); ss += shx(ss, 2, F.lane); ss += shx(ss, 4, F.lane);
              const float r = rsqrtf(ss * (1.0f / HD) + EPS);
              v4u ko; ko.x = pk2(f[0] * r * kg0.x, f[1] * r * kg0.y); ko.y = pk2(f[2] * r * kg0.z, f[3] * r * kg0.w); ko.z = pk2(f[4] * r * kg1.x, f[5] * r * kg1.y); ko.w = pk2(f[6] * r * kg1.z, f[7] * r * kg1.w);
              *(LAS v4u*)(Kimg + row * AT_KP + part * 16) = ko; *(LAS v4u*)(Vimg + row * AT_VP + part * 16) = vq; } }
        for (int i = F.tid; i < 4 * 257; i += NTHR) { const int gg = i / 257, r = i - gg * 257; btab[gg * 260 + r] = biasrel[(kvh * 4 + gg) * 257 + r]; }
        __syncthreads();
        const float sk = sink[h] * LOG2E;
        const LAS float* bt = btab + hq * 260;
        const unsigned vbase = lds_addr(Vimg) + (unsigned)(((lane & 15) >> 2) * AT_VP + (lane & 3) * 8);
        f32x4 qa[2][2];
#pragma unroll
        for (int ds = 0; ds < 2; ++ds) { qa[ds][0] = *(const f32x4*)(qg + 32 * ds + 8 * g4); qa[ds][1] = *(const f32x4*)(qg + 32 * ds + 8 * g4 + 4); }
#pragma unroll 1
        for (int qh = 0; qh < 2; ++qh) {
            bf16x8 qf[2][2];
#pragma unroll
            for (int q2 = 0; q2 < 2; ++q2) { const int tok = n * 128 + th * 64 + 32 * qh + 16 * q2 + ql; const bf16* qp = QKV + ((size_t)b * S + tok) * QKVN + h * HD + 8 * g4;
                const v4u w0 = *(const GAS v4u*)qp, w1 = *(const GAS v4u*)(qp + 32);
                float f[16] = {bf_lo(w0.x), bf_hi(w0.x), bf_lo(w0.y), bf_hi(w0.y), bf_lo(w0.z), bf_hi(w0.z), bf_lo(w0.w), bf_hi(w0.w), bf_lo(w1.x), bf_hi(w1.x), bf_lo(w1.y), bf_hi(w1.y), bf_lo(w1.z), bf_hi(w1.z), bf_lo(w1.w), bf_hi(w1.w)};
                float ss = 0.f;
#pragma unroll
                for (int e = 0; e < 16; ++e) ss += f[e] * f[e];
                ss += shx(ss, 16, F.lane); ss += shx(ss, 32, F.lane);
                const float r = rsqrtf(ss * (1.0f / HD) + EPS) * (0.125f * LOG2E);
#pragma unroll
                for (int ds = 0; ds < 2; ++ds) { v4u o; o.x = pk2(f[8 * ds + 0] * r * qa[ds][0].x, f[8 * ds + 1] * r * qa[ds][0].y); o.y = pk2(f[8 * ds + 2] * r * qa[ds][0].z, f[8 * ds + 3] * r * qa[ds][0].w);
                    o.z = pk2(f[8 * ds + 4] * r * qa[ds][1].x, f[8 * ds + 5] * r * qa[ds][1].y); o.w = pk2(f[8 * ds + 6] * r * qa[ds][1].z, f[8 * ds + 7] * r * qa[ds][1].w);
                    qf[q2][ds] = __builtin_bit_cast(bf16x8, o); } }
            float mrun[2], lrun[2]; f32x4 oacc[4][2];
#pragma unroll
            for (int q2 = 0; q2 < 2; ++q2) { mrun[q2] = sk; lrun[q2] = 0.f;
#pragma unroll
                for (int db = 0; db < 4; ++db) oacc[db][q2] = (f32x4){0.f, 0.f, 0.f, 0.f}; }
#pragma unroll 1
            for (int c = th; c < th + 5; ++c) {
                bf16x8 kf[4][2];
#pragma unroll
                for (int kb = 0; kb < 4; ++kb)
#pragma unroll
                    for (int ds = 0; ds < 2; ++ds) kf[kb][ds] = *(const LAS bf16x8*)(Kimg + (64 * c + 16 * kb + ql) * AT_KP + (32 * ds + 8 * g4) * 2);
                f32x4 sacc[4][2];
#pragma unroll
                for (int kb = 0; kb < 4; ++kb)
#pragma unroll
                    for (int q2 = 0; q2 < 2; ++q2) { f32x4 a = (f32x4){0.f, 0.f, 0.f, 0.f}; a = MFMA16(kf[kb][0], qf[q2][0], a); a = MFMA16(kf[kb][1], qf[q2][1], a); sacc[kb][q2] = a; }
                bf16x8 pf[2][2];
#pragma unroll
                for (int q2 = 0; q2 < 2; ++q2) { const int qoff = th * 64 + 32 * qh + 16 * q2 + ql;
                    float mx = -1e30f;
#pragma unroll
                    for (int kb = 0; kb < 4; ++kb)
#pragma unroll
                        for (int j = 0; j < 4; ++j) { const int koff = 64 * c + 16 * kb + 4 * g4 + j - 128; const int rel = koff - qoff; const int kpos = n * 128 + koff;
                            const bool ok = ((unsigned)(rel + 128) <= 256u) && (kpos >= 0) && (kpos < S);
                            const int bi = ok ? rel + 128 : 0;
                            const float sv = ok ? sacc[kb][q2][j] + bt[bi] : -1e30f; sacc[kb][q2][j] = sv; mx = fmaxf(mx, sv); }
                    mx = fmaxf(mx, shx(mx, 16, F.lane)); mx = fmaxf(mx, shx(mx, 32, F.lane));
                    const float mnew = fmaxf(mrun[q2], mx), alpha = __builtin_amdgcn_exp2f(mrun[q2] - mnew); mrun[q2] = mnew;
                    float ps = 0.f; float pv[4][4];
#pragma unroll
                    for (int kb = 0; kb < 4; ++kb)
#pragma unroll
                        for (int j = 0; j < 4; ++j) { pv[kb][j] = __builtin_amdgcn_exp2f(sacc[kb][q2][j] - mnew); ps += pv[kb][j]; }
                    lrun[q2] = lrun[q2] * alpha + ps;
#pragma unroll
                    for (int db = 0; db < 4; ++db) oacc[db][q2] = oacc[db][q2] * alpha;
#pragma unroll
                    for (int ks2 = 0; ks2 < 2; ++ks2) { v4u o; o.x = pk2(pv[2 * ks2][0], pv[2 * ks2][1]); o.y = pk2(pv[2 * ks2][2], pv[2 * ks2][3]); o.z = pk2(pv[2 * ks2 + 1][0], pv[2 * ks2 + 1][1]); o.w = pk2(pv[2 * ks2 + 1][2], pv[2 * ks2 + 1][3]);
                        pf[q2][ks2] = __builtin_bit_cast(bf16x8, o); } }
#pragma unroll
                for (int ks2 = 0; ks2 < 2; ++ks2)
#pragma unroll
                    for (int db = 0; db < 4; ++db) { const unsigned a0 = vbase + (unsigned)((64 * c + 32 * ks2 + 4 * g4) * AT_VP + 32 * db); const bf16x8 vf = tr_frag(a0, a0 + 16u * AT_VP);
                        oacc[db][0] = MFMA16(vf, pf[0][ks2], oacc[db][0]); oacc[db][1] = MFMA16(vf, pf[1][ks2], oacc[db][1]); }
            }
#pragma unroll
            for (int q2 = 0; q2 < 2; ++q2) { float lt = lrun[q2]; lt += shx(lt, 16, F.lane); lt += shx(lt, 32, F.lane); lt += __builtin_amdgcn_exp2f(sk - mrun[q2]);
                const float inv = 1.0f / lt; const int tok = n * 128 + th * 64 + 32 * qh + 16 * q2 + ql; bf16* op = O + ((size_t)b * S + tok) * D + h * HD + 4 * g4;
#pragma unroll
                for (int db = 0; db < 4; ++db) { const f32x4 v = oacc[db][q2] * inv; v2u o; o.x = pk2(v.x, v.y); o.y = pk2(v.z, v.w); *(GAS v2u*)(op + 16 * db) = o; } }
        }
    }
}

__device__ __forceinline__ void phase_fa(const Params& p, Frame& F, int l, const float* xraw) {
    const bf16* H = (const bf16*)(p.ws + WS_H); bf16* TA = (bf16*)(p.ws + WS_TA);
    const bf16* R64B = (const bf16*)(p.ws + WS_TAB + 65536);
    const int lane = F.lane, g4 = lane >> 4, ql = lane & 15;
    for (int U = F.vcu; U < NB * 128; U += F.G) {
        const int b = U >> 7, s2 = U & 127;
        __syncthreads();
        if (xraw) {
            const float* mod = (const float*)(p.ws + WS_MOD) + (size_t)l * NB * 6 * D; const float* gain = (const float*)(p.ws + WS_PAR) + PAR_NMIX + l * D;
            f32x4 Av[4], Bv[4];
#pragma unroll
            for (int j = 0; j < 4; ++j) { const int c = 256 * j + 4 * lane; const f32x4 g = *(const f32x4*)(gain + c), sc = *(const f32x4*)(mod + b * 6 * D + 1 * D + c);
                Av[j] = g * (sc + 1.0f); Bv[j] = *(const f32x4*)(mod + b * 6 * D + 0 * D + c); }
#pragma unroll 1
            for (int r4 = 0; r4 < 2; ++r4) { f32x4 h[4][4];
#pragma unroll
                for (int r = 0; r < 4; ++r)
#pragma unroll
                    for (int j = 0; j < 4; ++j) h[r][j] = *(const GAS f32x4*)(xraw + ((size_t)b * S + 128 * (F.wave * 8 + r4 * 4 + r) + s2) * D + 256 * j + 4 * lane);
#pragma unroll
                for (int r = 0; r < 4; ++r) { const int s1 = F.wave * 8 + r4 * 4 + r; float ss = 0.f;
#pragma unroll
                    for (int j = 0; j < 4; ++j) ss += (h[r][j].x * h[r][j].x + h[r][j].y * h[r][j].y) + (h[r][j].z * h[r][j].z + h[r][j].w * h[r][j].w);
                    const float rstd = rsqrtf(wave_sum(ss, lane) * (1.0f / D) + EPS);
#pragma unroll
                    for (int j = 0; j < 4; ++j) { const f32x4 hv = h[r][j] * rstd * Av[j] + Bv[j]; const int c = 256 * j + 4 * lane;
                        v2u o; o.x = pk2(hv.x, hv.y); o.y = pk2(hv.z, hv.w); *(LAS v2u*)(F.lds + (c >> 7) * 16384 + off_b(s1, (c & 127) >> 3) + (c & 7) * 2) = o; } } }
        } else {
#pragma unroll 4
            for (int i = 0; i < 16; ++i) { const int q = F.tid + 512 * i, row = q >> 7, c128 = q & 127;
                const v4u v = *(const GAS v4u*)(H + ((size_t)b * S + 128 * row + s2) * D + c128 * 8);
                *(LAS v4u*)(F.lds + (c128 >> 4) * 16384 + off_b(row, c128 & 15)) = v; }
        }
        bf16x8 rf[4][2];
#pragma unroll
        for (int rb = 0; rb < 4; ++rb)
#pragma unroll
            for (int ks = 0; ks < 2; ++ks) rf[rb][ks] = *(const GAS bf16x8*)(R64B + (16 * rb + ql) * 64 + 32 * ks + 8 * g4);
        __syncthreads();
        const unsigned ibase = lds_addr(F.lds) + F.wave * 16384;
#pragma unroll 1
        for (int c4 = 0; c4 < 2; ++c4) {
            f32x4 acc[4][4];
#pragma unroll
            for (int cb = 0; cb < 4; ++cb)
#pragma unroll
                for (int rb = 0; rb < 4; ++rb) acc[cb][rb] = (f32x4){0.f, 0.f, 0.f, 0.f};
#pragma unroll
            for (int ks = 0; ks < 2; ++ks) { bf16x8 f0, f1, f2, f3; unsigned a[8];
#pragma unroll
                for (int i = 0; i < 4; ++i) { a[2 * i] = ibase + tr_read_addr_16(lane, 4 * c4 + i, ks, 0); a[2 * i + 1] = ibase + tr_read_addr_16(lane, 4 * c4 + i, ks, 1); }
                tr_frag4(a[0], a[1], a[2], a[3], a[4], a[5], a[6], a[7], f0, f1, f2, f3);
#pragma unroll
                for (int rb = 0; rb < 4; ++rb) { acc[0][rb] = MFMA16(f0, rf[rb][ks], acc[0][rb]); acc[1][rb] = MFMA16(f1, rf[rb][ks], acc[1][rb]);
                    acc[2][rb] = MFMA16(f2, rf[rb][ks], acc[2][rb]); acc[3][rb] = MFMA16(f3, rf[rb][ks], acc[3][rb]); } }
#pragma unroll
            for (int rb = 0; rb < 4; ++rb) { const int r = 16 * rb + ql; const int uh = (r == 0) ? 0 : (r == 32 ? 1 : (r < 32 ? 2 * r : 2 * (r - 32) + 1));
                bf16* tp = TA + (((size_t)b * 64 + uh) * 128 + s2) * 1024 + 128 * F.wave + 64 * c4 + 4 * g4;
#pragma unroll
                for (int cb = 0; cb < 4; ++cb) { const f32x4 v = acc[cb][rb]; v2u w; w.x = pk2(v.x, v.y); w.y = pk2(v.z, v.w); *(GAS v2u*)(tp + 16 * cb) = w; } }
        }
    }
}

__device__ __forceinline__ void phase_fb(const Params& p, Frame& F) {
    const bf16* TA = (const bf16*)(p.ws + WS_TA); const bf16* MBT = (const bf16*)(p.ws + WS_MBT); bf16* YF = (bf16*)(p.ws + WS_YF); float* Yr4096 = (float*)(p.ws + WS_MISC + 8192);
    const int lane = F.lane, g4 = lane >> 4, ql = lane & 15;
    for (int U = F.vcu; U < NB * 32 * 4; U += F.G) {
        const int b = U >> 7, u = (U >> 2) & 31, cq = U & 3;
        __syncthreads();
        const bf16* src = TA + ((size_t)(b * 32 + u) * 256) * 1024 + cq * 256;
#pragma unroll 4
        for (int i = 0; i < 16; ++i) { const int q = F.tid + 512 * i, row = q >> 5, c32 = q & 31;
            const v4u v = *(const GAS v4u*)(src + (size_t)row * 1024 + c32 * 8);
            *(LAS v4u*)(F.lds + (c32 >> 4) * 65536 + off_b(row, c32 & 15)) = v; }
        __syncthreads();
        f32x4 acc[16][2];
#pragma unroll
        for (int cb = 0; cb < 16; ++cb) { acc[cb][0] = (f32x4){0.f, 0.f, 0.f, 0.f}; acc[cb][1] = (f32x4){0.f, 0.f, 0.f, 0.f}; }
        const bf16* mrow = MBT + ((size_t)u * 256 + 32 * F.wave + ql) * 256 + 8 * g4;
        const unsigned lbase = lds_addr(F.lds);
#pragma unroll 1
        for (int ks = 0; ks < 8; ++ks) {
            const bf16x8 m0 = *(const GAS bf16x8*)(mrow + 32 * ks), m1 = *(const GAS bf16x8*)(mrow + 16 * 256 + 32 * ks);
#pragma unroll
            for (int c4 = 0; c4 < 4; ++c4) { bf16x8 f0, f1, f2, f3; unsigned a[8];
#pragma unroll
                for (int i = 0; i < 4; ++i) { const int cb = 4 * c4 + i; a[2 * i] = lbase + (cb >> 3) * 65536 + tr_read_addr_16(lane, cb & 7, ks, 0); a[2 * i + 1] = lbase + (cb >> 3) * 65536 + tr_read_addr_16(lane, cb & 7, ks, 1); }
                tr_frag4(a[0], a[1], a[2], a[3], a[4], a[5], a[6], a[7], f0, f1, f2, f3);
                acc[4 * c4 + 0][0] = MFMA16(f0, m0, acc[4 * c4 + 0][0]); acc[4 * c4 + 0][1] = MFMA16(f0, m1, acc[4 * c4 + 0][1]);
                acc[4 * c4 + 1][0] = MFMA16(f1, m0, acc[4 * c4 + 1][0]); acc[4 * c4 + 1][1] = MFMA16(f1, m1, acc[4 * c4 + 1][1]);
                acc[4 * c4 + 2][0] = MFMA16(f2, m0, acc[4 * c4 + 2][0]); acc[4 * c4 + 2][1] = MFMA16(f2, m1, acc[4 * c4 + 2][1]);
                acc[4 * c4 + 3][0] = MFMA16(f3, m0, acc[4 * c4 + 3][0]); acc[4 * c4 + 3][1] = MFMA16(f3, m1, acc[4 * c4 + 3][1]); }
        }
#pragma unroll
        for (int mb = 0; mb < 2; ++mb) { const int o = 32 * F.wave + 16 * mb + ql, ri = o >> 7, jj = o & 127;
            bf16* yp = YF + (((size_t)(b * 4096 + u * 128 + jj)) * 2 + ri) * 1024 + cq * 256 + 4 * g4;
#pragma unroll
            for (int cb = 0; cb < 16; ++cb) { const f32x4 v = acc[cb][mb]; v2u w; w.x = pk2(v.x, v.y); w.y = pk2(v.z, v.w); *(GAS v2u*)(yp + 16 * cb) = w; } }
        if (u == 0 && F.tid < 256) {
            const int col = F.tid; const LAS unsigned char* img = F.lds + (col >> 7) * 65536; const int cc = col & 127; float a = 0.f;
            for (int s2 = 0; s2 < 128; ++s2) { const unsigned short hv = *(const LAS unsigned short*)(img + off_b(s2, cc >> 3) + 2 * (cc & 7)); const float v = __builtin_bit_cast(float, (unsigned)hv << 16); a += (s2 & 1) ? -v : v; }
            Yr4096[b * 1024 + cq * 256 + col] = a; }
    }
}

__device__ __forceinline__ void fc_extra(const Params& p, Frame& F, int l) {
    const float* Yr = (const float*)(p.ws + WS_MISC + 8192); float* y4096 = (float*)(p.ws + WS_MISC); const bf16* W = (const bf16*)(p.ws + WS_WFF) + (size_t)(l >> 1) * 2048 * 1024;
    const int gw = F.vcu * NWAVES + F.wave, NGW = F.G * NWAVES;
    for (int o = gw; o < NB * 1024; o += NGW) { const int b = o >> 10, j = o & 1023; float a = 0.f;
#pragma unroll
        for (int i = 0; i < 2; ++i) { const int c = 512 * i + 8 * F.lane; const v4u w = *(const GAS v4u*)(W + (size_t)j * 1024 + c); const f32x4 y0 = *(const GAS f32x4*)(Yr + b * 1024 + c), y1 = *(const GAS f32x4*)(Yr + b * 1024 + c + 4);
            a += y0.x * bf_lo(w.x) + y0.y * bf_hi(w.x) + y0.z * bf_lo(w.y) + y0.w * bf_hi(w.y) + y1.x * bf_lo(w.z) + y1.y * bf_hi(w.z) + y1.z * bf_lo(w.w) + y1.w * bf_hi(w.w); }
        a = wave_sum(a, F.lane); if (F.lane == 0) y4096[o] = a; }
}

__device__ __forceinline__ void pro_small(const Params& p, Frame& F) {
    const int gt = F.vcu * NTHR + F.tid, NGT = F.G * NTHR;
    float* mod = (float*)(p.ws + WS_MOD);
    { LAS float* sc = (LAS float*)F.lds; LAS float* part = sc + 2 * D;
      for (int i = F.tid; i < 2 * D; i += NTHR) { const float cv = p.in[IN_C][i]; sc[i] = cv / (1.f + expf(-cv)); }
      __syncthreads();
      for (int cb = F.vcu; cb < DEPTH * 6 * D / 96; cb += F.G) {
          const int col0 = cb * 96, l = col0 / (6 * D), j0 = col0 - l * 6 * D;
          if (F.tid < 480) { const int cc = F.tid % 96, ks = F.tid / 96; const int k0 = ks * 205, k1 = (k0 + 205 < D) ? k0 + 205 : D;
              const float* w = p.in[IN_WADA] + (size_t)l * D * 6 * D + j0 + cc; float a0 = 0.f, a1 = 0.f;
#pragma unroll 16
              for (int i = k0; i < k1; ++i) { const float wv = w[(size_t)i * 6 * D]; a0 += sc[i] * wv; a1 += sc[D + i] * wv; }
              part[(ks * 2 + 0) * 96 + cc] = a0; part[(ks * 2 + 1) * 96 + cc] = a1; }
          __syncthreads();
          if (F.tid < 192) { const int bb = F.tid / 96, cc = F.tid % 96; float a = p.in[IN_BADA][l * 6 * D + j0 + cc];
#pragma unroll
              for (int ks = 0; ks < 5; ++ks) a += part[(ks * 2 + bb) * 96 + cc];
              mod[((size_t)l * NB + bb) * 6 * D + j0 + cc] = a; }
          __syncthreads(); } }
    { float* par = (float*)(p.ws + WS_PAR);
      for (int i = gt; i < 4096; i += NGT) { par[PAR_NMIX + i] = p.in[IN_NMIX][i]; par[PAR_NFFN + i] = p.in[IN_NFFN][i]; }
      for (int i = gt; i < 128; i += NGT) { par[PAR_QG + i] = p.in[IN_QG][i]; par[PAR_KG + i] = p.in[IN_KG][i]; }
      for (int i = gt; i < 32; i += NGT) par[PAR_SINK + i] = p.in[IN_SINK][i];
      for (int i = gt; i < DEPTH * D * NE; i += NGT) par[PAR_WR + i] = p.in[IN_WR][i]; }
    float* biasrel = (float*)(p.ws + WS_TAB); bf16* MBT = (bf16*)(p.ws + WS_MBT); bf16* CS = (bf16*)(p.ws + WS_CS);
    for (int i = gt; i < NH * 257; i += NGT) { const int h = i / 257, r = i - h * 257, rel = r - 128, n = rel < 0 ? -rel : rel;
        int bk = (n < 8) ? n : 8 + (n >= 12) + (n >= 16) + (n >= 23) + (n >= 32) + (n >= 46) + (n >= 64) + (n >= 91);
        bk += (rel > 0) ? 16 : 0; biasrel[i] = p.in[IN_RELB][bk * NH + h] * 1.44269504f; }
    { bf16* R64B = (bf16*)(p.ws + WS_TAB + 65536);
      for (int i = gt; i < 64 * 64; i += NGT) { const int r = i >> 6, s = i & 63; float sv, cv;
          if (r <= 32) { sincospif((float)((r * s) & 63) / 32.0f, &sv, &cv); R64B[i] = (bf16)f2bf(cv); } else { sincospif((float)(((r - 32) * s) & 63) / 32.0f, &sv, &cv); R64B[i] = (bf16)f2bf(-sv); } } }
    for (int i = gt; i < 512 * 256; i += NGT) { const int rr = i >> 8, m = i & 255, cs = rr >> 8, nn = rr & 255; float sv, cv; sincospif((float)((nn * m) & 255) / 128.0f, &sv, &cv); CS[i] = (bf16)f2bf(cs ? sv : cv); }
    for (int i = gt; i < 32 * 256 * 256; i += NGT) { const int u = i >> 16, o = (i >> 8) & 255, K = i & 255, ri = o >> 7, j = o & 127, half = K >> 7, s2 = K & 127; float val = 0.f;
        if (u >= 1) { const int k = u + 64 * j; float sv, cv; sincospif((float)((s2 * k) & 8191) / 4096.0f, &sv, &cv);
            val = (ri == 0) ? (half == 0 ? cv : sv) : (half == 0 ? -sv : cv); }
        else { const int blk = j >> 6, k = (blk ? 32 : 0) + 64 * (j & 63); if (half == blk) { float sv, cv; sincospif((float)((s2 * k) & 8191) / 4096.0f, &sv, &cv); val = (ri == 0) ? cv : -sv; } }
        MBT[i] = (bf16)f2bf(val); }
}
__device__ __forceinline__ CvtItem dense_item(const Params& p, int it) {
    constexpr int I_QKV = 16 * 24, I_SQ = 16 * 16; CvtItem ci; int r = it;
    if (r < 2 * I_QKV) { const int j = r / I_QKV; r -= j * I_QKV; const int kt = r / 24, ntile = r % 24;
        ci.src = p.in[IN_WQKV] + (size_t)j * D * QKVN + (size_t)kt * 64 * QKVN + ntile * 64; ci.N = QKVN; ci.dst = (bf16*)(p.ws + WS_WQKV) + ((size_t)j * QKVN + ntile * 64) * D + kt * 64; ci.ldk = D; return ci; }
    r -= 2 * I_QKV; const int which = r / (2 * I_SQ); r -= which * 2 * I_SQ; const int j = r / I_SQ; r -= j * I_SQ; const int kt = r >> 4, ntile = r & 15;
    ci.src = (which ? p.in[IN_WFO] : p.in[IN_WAO]) + (size_t)j * D * D + (size_t)kt * 64 * D + ntile * 64; ci.N = D;
    ci.dst = (bf16*)(p.ws + (which ? WS_WFO : WS_WAO)) + ((size_t)j * D + ntile * 64) * D + kt * 64; ci.ldk = D; return ci;
}
__device__ __forceinline__ void pro_cvt_dense(const Params& p, Frame& F) {
    LAS float* scr = (LAS float*)(F.lds + F.wave * 16640);
    const int gw = F.vcu * NWAVES + F.wave, NGW = F.G * NWAVES;
    constexpr int NIT = 2 * 16 * 24 + 4 * 16 * 16;
    for (int it = gw; it < NIT; it += NGW) { f32x4 v[16]; const CvtItem ci = dense_item(p, it); cvt_load(ci, v, F.lane); cvt_store(ci, v, scr, F.lane); }
}

namespace pg8 {
struct SchedFC { const char* A; const char* B; int G, c;
    __device__ __forceinline__ bool next(int i, Unit& u) const { int tm, tn; if (!tile_of(i, G, c, 32, 8, 8, tm, tn)) return false;
        u.pm = tm; u.pn = tn; u.A = A + (size_t)tm * (256 * 2048 * 2) + (tn >= 4 ? 2048 : 0); u.B = B + (size_t)tn * (256 * 1024 * 2); return true; } };
struct SchedFold { const char* A; const char* B; int G, c;
    __device__ __forceinline__ bool next(int i, Unit& u) const { const long L = (long)i * G + c; if (L >= 32) return false; const int g = (int)L & 3, tm = ((int)L >> 2) & 3, cs = (int)L >> 4;
        u.pm = tm + 4 * cs; u.pn = g; u.A = A + (size_t)tm * (256 * 1024 * 2) + g * 512; u.B = B + (size_t)cs * (256 * 256 * 2); return true; } };
}

constexpr int NPH_L = 9, NPHASE = 1 + NPH_L * DEPTH;
#ifndef PROBE_MASK
#define PROBE_MASK 0
#endif
#define DUP(bit) _Pragma("unroll 1") for (int rep_ = 0; rep_ < (((PROBE_MASK) >> (bit)) & 1) + 1; ++rep_)
__global__ void __launch_bounds__(NTHR, 2) mk_fwd(Params p) {
    extern __shared__ __attribute__((aligned(16))) unsigned char lds_raw[];
    Frame F; F.lds = (LAS unsigned char*)lds_raw;
    F.tid = threadIdx.x; F.lane = F.tid & 63; F.wave = __builtin_amdgcn_readfirstlane(F.tid >> 6);
    F.G = gridDim.x; { const int bx = blockIdx.x; F.vcu = (F.G % 8 == 0) ? (bx % 8) * (F.G / 8) + bx / 8 : bx; }
    volatile LAS unsigned* MISC = (volatile LAS unsigned*)(F.lds + MISC_OFF);
    if (F.tid < 32) MISC[F.tid] = 0u;
    __syncthreads();
    XcdBarrier bar = xcd_barrier_post((unsigned*)(p.ws + WS_CTL) + CW_BAR, MISC + 8);
    const int lo = p.ph_lo, hi = p.ph_hi;
#define IN(k) (lo <= (k) && (k) < hi)
#define SEAM(k) do { if (IN(k) && IN((k) + 1)) xcd_barrier(bar); } while (0)
#define RELAUNDER() do { int t_ = threadIdx.x; asm volatile("" : "+v"(t_)); F.tid = t_; F.lane = t_ & 63; } while (0)
#define PHASE_CTX() Params q; do { unsigned long long w_ = (unsigned long long)p.ws, o_ = (unsigned long long)p.out; asm volatile("" : "+s"(w_), "+s"(o_)); q.ws = (unsigned char*)w_; q.out = (float*)o_; RELAUNDER(); } while (0)

    if (IN(0)) DUP(0) {
        RELAUNDER(); pro_small(p, F);
        __syncthreads();
        RELAUNDER(); pro_cvt_dense(p, F);
        const int gw = F.vcu * NWAVES + F.wave, NGW = F.G * NWAVES;
        RELAUNDER(); cvt_moe_layer(p, F, 0, gw, NGW, 3 * 8192);
        if (F.vcu == 0 && F.tid == 0) { unsigned long long* pt = (unsigned long long*)(p.ws + WS_PAR + 512 * 1024); pt[0] = (unsigned long long)p.in[IN_WG]; pt[1] = (unsigned long long)p.in[IN_WU]; pt[2] = (unsigned long long)p.in[IN_WD]; pt[3] = (unsigned long long)p.in[IN_X]; }
        __syncthreads();
    }
    SEAM(0);
    for (int l = 0; l < DEPTH; ++l) {
        const int base = 1 + NPH_L * l; const bool fourier = (l & 1) == 0; const int jl = l >> 1;
        if (IN(base + 0)) DUP(1) {
            PHASE_CTX();
            if (fourier) {
                const float* xin0 = nullptr; if (l == 0) xin0 = (const float*)((const unsigned long long*)(q.ws + WS_PAR + 512 * 1024))[3];
                phase_fa(q, F, l, xin0);
                __syncthreads();
                pg8::SchedFold Sc{(const char*)(q.ws + WS_WFO + (size_t)jl * D * D * 2), (const char*)(q.ws + WS_CS), F.G, F.vcu};
                pg8::EpiBf16 E{(bf16*)(q.ws + WS_WFF + (size_t)jl * 2048 * 1024 * 2), 1024, nullptr, 1.0f / 1448.15468787f, 0};
                pg8::gemm_phase<pg8::EpiBf16, pg8::SchedFold, 256, 1024, 256>(F.lds, Sc, E);
            } else {
                pg8::SchedPlain Sc{(const char*)(q.ws + WS_H), (const char*)(q.ws + WS_WQKV + (size_t)jl * QKVN * D * 2), (size_t)256 * 1024 * 2, (size_t)256 * 1024 * 2, 64, 6, F.G, (int)blockIdx.x, 8, 0};
                pg8::EpiBf16 E{(bf16*)(q.ws + WS_QKV), QKVN, nullptr, 1.0f, 0};
                pg8::gemm_phase<pg8::EpiBf16, pg8::SchedPlain, 1024, 1024, 1024>(F.lds, Sc, E);
            }
        }
        SEAM(base + 0);
        if (IN(base + 1)) DUP(2) {
            PHASE_CTX();
            if (fourier) phase_fb(q, F); else phase_ac(q, F, l);
        }
        SEAM(base + 1);
        if (IN(base + 2)) {
            PHASE_CTX();
            if (fourier) {
                pg8::SchedFC Sc{(const char*)(q.ws + WS_YF), (const char*)(q.ws + WS_WFF + (size_t)jl * 2048 * 1024 * 2), F.G, (int)blockIdx.x};
                pg8::EpiF32 E{(float*)(q.ws + WS_PQ), 2048};
                pg8::gemm_phase<pg8::EpiF32, pg8::SchedFC, 1024, 2048, 1024>(F.lds, Sc, E);
                RELAUNDER(); fc_extra(q, F, l);
            } else {
                pg8::SchedPlain Sc{(const char*)(q.ws + WS_O), (const char*)(q.ws + WS_WAO + (size_t)jl * D * D * 2), (size_t)256 * 1024 * 2, (size_t)256 * 1024 * 2, 64, 4, F.G, (int)blockIdx.x, 8, 0};
                pg8::EpiResid E{q.out, (const float*)(q.ws + WS_MOD) + (size_t)l * NB * 6 * D + 2 * D};
                pg8::gemm_phase<pg8::EpiResid, pg8::SchedPlain, 1024, 1024, 1024>(F.lds, Sc, E);
            }
        }
        SEAM(base + 2);
        if (IN(base + 3)) { PHASE_CTX(); const float* xin = q.out; if (l == 0) xin = (const float*)((const unsigned long long*)(q.ws + WS_PAR + 512 * 1024))[3]; phase_ma(q, F, l, fourier, xin); }
        SEAM(base + 3);
        if (IN(base + 4)) { PHASE_CTX(); phase_mb(q, F); }
        SEAM(base + 4);
        if (IN(base + 5)) DUP(6) { PHASE_CTX(); phase_mc(q, F); }
        SEAM(base + 5);
        if (IN(base + 6)) DUP(7) {
            PHASE_CTX();
            const int nper = (2048 + F.G - 1) / F.G, rsplit = (l + 1 < DEPTH) ? (F.vcu & 7) * nper / 8 + 1 : nper;
#pragma unroll 1
            for (int part = 0; part < 2; ++part) {
                pg8::SchedMoE Sc{(const char*)(q.ws + WS_XIN), (const char*)(q.ws + WS_W1 + (size_t)l * NE * 4096 * 1024 * 2), (size_t)256 * 1024 * 2, (size_t)256 * 1024 * 2, 16, F.G, (int)blockIdx.x, part ? rsplit : 0, part ? nper - rsplit : rsplit, 0};
                pg8::EpiSwiGLU E{(bf16*)(q.ws + WS_ACT), 2048};
                pg8::gemm_phase<pg8::EpiSwiGLU, pg8::SchedMoE, 1024, 1024, 1024>(F.lds, Sc, E);
                if (part == 0 && l + 1 < DEPTH) { RELAUNDER();
                    const unsigned long long* pt = (const unsigned long long*)(q.ws + WS_PAR + 512 * 1024);
                    q.in[IN_WG] = (const float*)pt[0]; q.in[IN_WU] = (const float*)pt[1]; q.in[IN_WD] = (const float*)pt[2];
                    const int slot = F.vcu & 7, nslotw = (F.G >> 3) * NWAVES, per = 3 * 8192 / 8;
                    cvt_moe_layer(q, F, l + 1, slot * per + (F.vcu >> 3) * NWAVES + F.wave, nslotw, (slot + 1) * per); __syncthreads(); }
            }
        }
        SEAM(base + 6);
        if (IN(base + 7)) DUP(8) {
            PHASE_CTX();
            pg8::SchedMoE Sc{(const char*)(q.ws + WS_ACT), (const char*)(q.ws + WS_W2 + (size_t)l * NE * 1024 * 2048 * 2), (size_t)256 * 2048 * 2, (size_t)256 * 2048 * 2, 4, F.G, (int)blockIdx.x, 0, 1 << 20, 0};
            pg8::EpiBf16 E{(bf16*)(q.ws + WS_Y), 1024, (const float*)(q.ws + WS_GATE), 1.0f, 0};
            pg8::gemm_phase<pg8::EpiBf16, pg8::SchedMoE, 2048, 2048, 2048>(F.lds, Sc, E);
        }
        SEAM(base + 7);
        if (IN(base + 8)) { PHASE_CTX(); phase_mf(q, F, l); }
        SEAM(base + 8);
    }
#undef IN
#undef SEAM
}

#ifndef MK_MODE
#define MK_MODE 0
#endif
extern "C" void kernel_launch(void* const* d_in, const int* in_sizes, int n_in, void* d_out, int out_size, void* d_ws, size_t ws_size, hipStream_t stream) {
    static int grid = 0;
    if (grid == 0) {
        int dev = 0, cus = 0;
        if (n_in != 17 || ws_size < WS_END || hipGetDevice(&dev) != hipSuccess || hipDeviceGetAttribute(&cus, hipDeviceAttributeMultiprocessorCount, dev) != hipSuccess) { fprintf(stderr, "kernel_launch: bad arguments\n"); grid = -1; return; }
        if (hipFuncSetAttribute((const void*)mk_fwd, hipFuncAttributeMaxDynamicSharedMemorySize, LDS_BYTES) != hipSuccess) { fprintf(stderr, "kernel_launch: hipFuncSetAttribute failed\n"); grid = -1; return; }
        int per_cu = 0; (void)hipOccupancyMaxActiveBlocksPerMultiprocessor(&per_cu, (const void*)mk_fwd, NTHR, LDS_BYTES); (void)hipGetLastError();
        grid = cus;
    }
    if (grid < 0) return;
    Params P{}; for (int i = 0; i < 17; ++i) P.in[i] = (const float*)d_in[i]; P.out = (float*)d_out; P.ws = (unsigned char*)d_ws;
#if MK_MODE == 0
    (void)hipMemsetAsync((char*)d_ws + WS_CTL, 0, CTL_ZERO_BYTES, stream);
    P.ph_lo = 0; P.ph_hi = NPHASE; hipLaunchKernelGGL(mk_fwd, dim3(grid), dim3(NTHR), LDS_BYTES, stream, P);
#else
    for (int ph = 0; ph < NPHASE; ++ph) { (void)hipMemsetAsync((char*)d_ws + WS_CTL, 0, CTL_ZERO_BYTES, stream); P.ph_lo = ph; P.ph_hi = ph + 1; hipLaunchKernelGGL(mk_fwd, dim3(grid), dim3(NTHR), LDS_BYTES, stream, P); }
#endif
}
```

```cpp
#include <hip/hip_runtime.h>
#include <math.h>
#include <stdint.h>
#include <stdio.h>

#ifndef CVT_PRE
#define CVT_PRE 512
#endif
#ifndef DENSE_WGM
#define DENSE_WGM 8
#endif
#ifndef MOE_WGM_MD
#define MOE_WGM_MD 4
#endif
#ifndef MOE_WGM_ME
#define MOE_WGM_ME 4
#endif
namespace pg8 {
#define PG8_LAS __attribute__((address_space(3)))
typedef unsigned short bf16_t;
typedef short bf16x8 __attribute__((ext_vector_type(8)));
typedef float f32x4 __attribute__((ext_vector_type(4)));
typedef unsigned u32x4 __attribute__((ext_vector_type(4)));
constexpr int BM = 256, BK = 64, HALF = 128, HTB = HALF * BK * 2  , STAGE_BYTES = 8 * HTB, NXCD = 8;

__host__ __device__ __forceinline__ int lds_byte(int r, int c) { const int st = (r >> 4) * 2 + (c >> 5), rr = r & 15, cc = c & 31, ob = rr * 64 + cc * 2; return st * 1024 + (ob ^ (((ob >> 9) & 1) << 5)); }
__host__ __device__ __forceinline__ void stage_rc(int b, int& R, int& C) { const int st = b / 1024, sb = b % 1024, swz = sb ^ (((sb >> 9) & 1) << 5); R = (st >> 1) * 16 + swz / 64; C = (st & 1) * 32 + (swz % 64) / 2; }
__host__ __device__ __forceinline__ int perm32(int rho) { const int n = rho >> 4, i = rho & 15; return 8 * (i >> 2) + 4 * n + (i & 3); }

__device__ __forceinline__ int lane_id_asm() { int l; asm volatile("v_mbcnt_lo_u32_b32 %0, -1, 0\n\tv_mbcnt_hi_u32_b32 %0, -1, %0" : "=v"(l)); return l; }
struct Unit { const char* A; const char* B; int pm, pn; };

__device__ __forceinline__ bool tile_of(int i, int G, int c, int nM, int nN, int wgm, int& tm, int& tn) {
    const int nwg = nM * nN; const long L = (long)i * G + c; if (L >= nwg) return false;
    int wgid = (int)L; { const int q = nwg / NXCD, r = nwg % NXCD, xcd = wgid % NXCD, off = wgid / NXCD; wgid = (xcd < r ? xcd * (q + 1) : r * (q + 1) + (xcd - r) * q) + off; }
    const int nig = wgm * nN, gid = wgid / nig, fm = gid * wgm, gsz = (nM - fm) < wgm ? (nM - fm) : wgm;
    tm = fm + ((wgid % nig) % gsz); tn = (wgid % nig) / gsz; return true;
}

__device__ __forceinline__ unsigned cvt_pk_bf16(float lo, float hi) { unsigned r; asm volatile("v_cvt_pk_bf16_f32 %0, %1, %2" : "=v"(r) : "v"(lo), "v"(hi)); return r; }

template <class Epi, class Sched, int K, int lda, int ldb, bool ALIGN_EPI = true, bool SP2 = true>
__device__ __forceinline__ void gemm_phase(PG8_LAS unsigned char* lds, const Sched& S, const Epi& E, const int wave_sgpr) {
    int wid_l = wave_sgpr; asm volatile("" : "+s"(wid_l));
    const int wid = wid_l, lane = lane_id_asm(), tid = wid * 64 + lane, wr = wid >> 2, wc = wid & 3, fr = lane & 15, fq = lane >> 4;
    const int nt = K / BK;
    unsigned voffA[2], voffB[2];
#pragma unroll
    for (int i = 0; i < 2; ++i) { int R, C; stage_rc(tid * 16 + i * 8192, R, C); const int Rb = Epi::PERM ? ((R & ~31) + perm32(R & 31)) : R;
        voffA[i] = (unsigned)(R * lda + C) * 2u; voffB[i] = (unsigned)(Rb * ldb + C) * 2u; }
    const size_t kstep = (size_t)(BK * 2);
    const size_t hstepA = (size_t)HALF * lda * 2, hstepB = (size_t)HALF * ldb * 2;
    const unsigned ldsw = (unsigned)wid * 1024u;
    const int aoff = lds_byte(wr * 64 + fr, fq * 8), boff = lds_byte(wc * 32 + fr, fq * 8);
#define PG8_SA(b, h) (((b) * 2 + (h)) * HTB)
#define PG8_SB(b, h) ((4 + (b) * 2 + (h)) * HTB)
#define PG8_STAGE(bufoff, gbase, voff) do { _Pragma("unroll") for (int _i = 0; _i < 2; ++_i) \
        __builtin_amdgcn_global_load_lds((const unsigned*)((const char*)(gbase) + (voff)[_i]), (PG8_LAS unsigned*)(lds + (bufoff) + ldsw + _i * 8192), 16, 0, 0); } while (0)
#define PG8_LDA(dst, b, h) do { _Pragma("unroll") for (int m = 0; m < 4; ++m) _Pragma("unroll") for (int k = 0; k < 2; ++k) dst[m][k] = *(const PG8_LAS bf16x8*)(lds + PG8_SA(b, h) + aoff + m * 2048 + k * 1024); } while (0)
#define PG8_LDB(dst, b, h) do { _Pragma("unroll") for (int n = 0; n < 2; ++n) _Pragma("unroll") for (int k = 0; k < 2; ++k) dst[n][k] = *(const PG8_LAS bf16x8*)(lds + PG8_SB(b, h) + boff + n * 2048 + k * 1024); } while (0)
#define PG8_MMA(ai, bj, At, Bt) do { __builtin_amdgcn_s_setprio(1); _Pragma("unroll") for (int m = 0; m < 4; ++m) _Pragma("unroll") for (int n = 0; n < 2; ++n) _Pragma("unroll") for (int k = 0; k < 2; ++k) \
        acc[ai][bj][m][n] = __builtin_amdgcn_mfma_f32_16x16x32_bf16(Bt[n][k], At[m][k], acc[ai][bj][m][n], 0, 0, 0); __builtin_amdgcn_s_setprio(0); } while (0)
#define PG8_WAIT_V(n) asm volatile("s_waitcnt vmcnt(" #n ")" ::: "memory")
#define PG8_WAIT_L(n) asm volatile("s_waitcnt lgkmcnt(" #n ")" ::: "memory")
#define PG8_BAR __builtin_amdgcn_s_barrier()
#define PG8_SCHED __builtin_amdgcn_sched_barrier(0)
    Unit cur, nxt; int ui = 0;
    if (!S.next(0, cur)) return;
    f32x4 acc[2][2][4][2];
#pragma unroll
    for (int a = 0; a < 2; ++a)
#pragma unroll
        for (int b = 0; b < 2; ++b)
#pragma unroll
            for (int m = 0; m < 4; ++m)
#pragma unroll
                for (int n = 0; n < 2; ++n) acc[a][b][m][n] = (f32x4){0.f, 0.f, 0.f, 0.f};
    bf16x8 At[4][2], B0[2][2], B1[2][2];
    const char* cA = cur.A; const char* cB = cur.B;
    if constexpr (SP2) {
        PG8_STAGE(PG8_SB(0, 0), cB, voffB); PG8_STAGE(PG8_SB(0, 1), cB + hstepB, voffB); PG8_STAGE(PG8_SA(0, 0), cA, voffA); PG8_STAGE(PG8_SA(0, 1), cA + hstepA, voffA);
        if (wr == 1) PG8_BAR;
        PG8_WAIT_V(2); PG8_BAR;
        PG8_STAGE(PG8_SB(1, 0), cB + kstep, voffB); PG8_STAGE(PG8_SA(1, 0), cA + kstep, voffA); PG8_STAGE(PG8_SB(1, 1), cB + hstepB + kstep, voffB);
        PG8_WAIT_V(6); PG8_BAR;
    } else {
        PG8_STAGE(PG8_SB(0, 0), cB, voffB); PG8_STAGE(PG8_SA(0, 0), cA, voffA); PG8_STAGE(PG8_SB(0, 1), cB + hstepB, voffB); PG8_STAGE(PG8_SA(0, 1), cA + hstepA, voffA);
        if (wr == 1) PG8_BAR;
        PG8_WAIT_V(4); PG8_BAR;
        PG8_STAGE(PG8_SB(1, 0), cB + kstep, voffB); PG8_STAGE(PG8_SA(1, 0), cA + kstep, voffA); PG8_STAGE(PG8_SB(1, 1), cB + hstepB + kstep, voffB);
        PG8_WAIT_V(6); PG8_BAR;
    }
    for (;;) {
        const bool has_next = S.next(ui + 1, nxt);
        const char* nA = has_next ? nxt.A : cA; const char* nB = has_next ? nxt.B : cB;
        for (int t = 0; t < nt; t += 2) {
            const bool last = (t == nt - 2);
            const char* a1 = cA + (size_t)(t + 1) * kstep;
            const char* a2 = last ? nA : cA + (size_t)(t + 2) * kstep; const char* b2 = last ? nB : cB + (size_t)(t + 2) * kstep;
            const char* a3 = a2 + kstep; const char* b3 = b2 + kstep;
            if constexpr (SP2) {
            PG8_LDB(B0, 0, 0); PG8_LDB(B1, 0, 1); PG8_SCHED; PG8_LDA(At, 0, 0); PG8_STAGE(PG8_SA(1, 1), a1 + hstepA, voffA);
            PG8_WAIT_V(8); PG8_WAIT_L(0); PG8_BAR; PG8_MMA(0, 0, At, B0); PG8_MMA(0, 1, At, B1); PG8_BAR; PG8_SCHED;
            PG8_LDA(At, 0, 1); PG8_STAGE(PG8_SB(0, 0), b2, voffB); PG8_STAGE(PG8_SB(0, 1), b2 + hstepB, voffB); PG8_STAGE(PG8_SA(0, 0), a2, voffA);
            PG8_WAIT_V(8); PG8_WAIT_L(0); PG8_BAR; PG8_MMA(1, 0, At, B0); PG8_MMA(1, 1, At, B1); PG8_BAR; PG8_SCHED;
            PG8_LDB(B0, 1, 0); PG8_LDB(B1, 1, 1); PG8_SCHED; PG8_LDA(At, 1, 0); PG8_STAGE(PG8_SA(0, 1), a2 + hstepA, voffA);
            PG8_WAIT_V(8); PG8_WAIT_L(0); PG8_BAR; PG8_MMA(0, 0, At, B0); PG8_MMA(0, 1, At, B1); PG8_BAR; PG8_SCHED;
            PG8_LDA(At, 1, 1); PG8_STAGE(PG8_SB(1, 0), b3, voffB); PG8_STAGE(PG8_SB(1, 1), b3 + hstepB, voffB); PG8_STAGE(PG8_SA(1, 0), a3, voffA);
            PG8_WAIT_V(8); PG8_WAIT_L(0); PG8_BAR; PG8_MMA(1, 0, At, B0); PG8_MMA(1, 1, At, B1); PG8_BAR; PG8_SCHED;
            } else {
            PG8_LDB(B0, 0, 0); PG8_SCHED; PG8_LDA(At, 0, 0); PG8_STAGE(PG8_SA(1, 1), a1 + hstepA, voffA);
            PG8_WAIT_L(8); PG8_BAR; PG8_WAIT_L(0); PG8_MMA(0, 0, At, B0); PG8_BAR; PG8_SCHED;
            PG8_LDB(B1, 0, 1); PG8_STAGE(PG8_SB(0, 0), b2, voffB);
            PG8_BAR; PG8_WAIT_L(0); PG8_MMA(0, 1, At, B1); PG8_BAR;
            PG8_LDA(At, 0, 1); PG8_STAGE(PG8_SA(0, 0), a2, voffA);
            PG8_BAR; PG8_WAIT_L(0); PG8_MMA(1, 0, At, B0); PG8_BAR; PG8_SCHED;
            PG8_STAGE(PG8_SB(0, 1), b2 + hstepB, voffB);
            PG8_WAIT_V(6); PG8_BAR; PG8_MMA(1, 1, At, B1); PG8_BAR;
            PG8_LDB(B0, 1, 0); PG8_SCHED; PG8_LDA(At, 1, 0); PG8_STAGE(PG8_SA(0, 1), a2 + hstepA, voffA);
            PG8_WAIT_L(8); PG8_BAR; PG8_WAIT_L(0); PG8_MMA(0, 0, At, B0); PG8_BAR; PG8_SCHED;
            PG8_LDB(B1, 1, 1); PG8_STAGE(PG8_SB(1, 0), b3, voffB);
            PG8_BAR; PG8_WAIT_L(0); PG8_MMA(0, 1, At, B1); PG8_BAR;
            PG8_LDA(At, 1, 1); PG8_STAGE(PG8_SA(1, 0), a3, voffA);
            PG8_BAR; PG8_WAIT_L(0); PG8_MMA(1, 0, At, B0); PG8_BAR; PG8_SCHED;
            PG8_STAGE(PG8_SB(1, 1), b3 + hstepB, voffB);
            PG8_WAIT_V(6); PG8_BAR; PG8_MMA(1, 1, At, B1); PG8_BAR;
            }
        }
        if constexpr (ALIGN_EPI) { if (wr == 0) PG8_BAR; }
        { const int l2 = lane_id_asm(); E(acc, cur, wr, wc, l2 & 15, l2 >> 4); }
        if constexpr (false) { E(acc, cur, wr, wc, fr, fq); }
        if (!has_next) break;
#pragma unroll
        for (int a = 0; a < 2; ++a)
#pragma unroll
            for (int b = 0; b < 2; ++b)
#pragma unroll
                for (int m = 0; m < 4; ++m)
#pragma unroll
                    for (int n = 0; n < 2; ++n) acc[a][b][m][n] = (f32x4){0.f, 0.f, 0.f, 0.f};
        cur = nxt; cA = nA; cB = nB; ++ui;
        if constexpr (ALIGN_EPI) { if (wr == 1) PG8_BAR; }
    }
    PG8_WAIT_V(0);
    if constexpr (!ALIGN_EPI) { if (wr == 0) PG8_BAR; }
    PG8_BAR;
    #undef PG8_SA
#undef PG8_SB
#undef PG8_STAGE
#undef PG8_LDA
#undef PG8_LDB
#undef PG8_MMA
#undef PG8_WAIT_V
#undef PG8_WAIT_L
#undef PG8_BAR
#undef PG8_SCHED
}

#define PG8_GAS __attribute__((address_space(1)))
__device__ __forceinline__ float silu_f(float g) { return g * __builtin_amdgcn_rcpf(1.0f + __builtin_amdgcn_exp2f(-1.44269504f * g)); }
struct EpiSwiGLU { static constexpr bool PERM = true, AFTER_DRAIN = false; bf16_t* O; long long ldc; long long skip;
    __device__ __forceinline__ void operator()(const f32x4 (&acc)[2][2][4][2], const Unit& u, int wr, int wc, int fr, int fq) const {
        if (skip) return;
        const int row0 = u.pm * BM + wr * 64 + fr, col0 = u.pn * HALF + wc * 32 + 8 * fq;
#pragma unroll
        for (int ai = 0; ai < 2; ++ai)
#pragma unroll
            for (int m = 0; m < 4; ++m) { bf16_t* rowp = O + (size_t)(row0 + ai * HALF + m * 16) * ldc + col0;
                const f32x4 g0 = acc[ai][0][m][0], g1 = acc[ai][0][m][1], u0 = acc[ai][1][m][0], u1 = acc[ai][1][m][1];
                u32x4 w; w.x = cvt_pk_bf16(silu_f(g0[0]) * u0[0], silu_f(g0[1]) * u0[1]); w.y = cvt_pk_bf16(silu_f(g0[2]) * u0[2], silu_f(g0[3]) * u0[3]);
                w.z = cvt_pk_bf16(silu_f(g1[0]) * u1[0], silu_f(g1[1]) * u1[1]); w.w = cvt_pk_bf16(silu_f(g1[2]) * u1[2], silu_f(g1[3]) * u1[3]);
                *(PG8_GAS u32x4*)rowp = w; }
    }
};
struct EpiBf16 { static constexpr bool PERM = true, AFTER_DRAIN = false; bf16_t* O; long long ldc; const float* rs; float scale; int coff;
    __device__ __forceinline__ void operator()(const f32x4 (&acc)[2][2][4][2], const Unit& u, int wr, int wc, int fr, int fq) const {
        const int row0 = u.pm * BM + wr * 64 + fr, col0 = coff + u.pn * BM + wc * 32 + 8 * fq;
#pragma unroll
        for (int ai = 0; ai < 2; ++ai)
#pragma unroll
            for (int m = 0; m < 4; ++m) { const int row = row0 + ai * HALF + m * 16; bf16_t* rowp = O + (size_t)row * ldc + col0; const float s = rs ? *(const PG8_GAS float*)(rs + row) : scale;
#pragma unroll
                for (int bj = 0; bj < 2; ++bj) { const f32x4 v0 = acc[ai][bj][m][0] * s, v1 = acc[ai][bj][m][1] * s;
                    u32x4 w; w.x = cvt_pk_bf16(v0[0], v0[1]); w.y = cvt_pk_bf16(v0[2], v0[3]); w.z = cvt_pk_bf16(v1[0], v1[1]); w.w = cvt_pk_bf16(v1[2], v1[3]);
                    *(PG8_GAS u32x4*)(rowp + bj * HALF) = w; } }
    }
};
struct EpiResid { static constexpr bool PERM = false, AFTER_DRAIN = false; float* X; const float* g;
    __device__ __forceinline__ void operator()(const f32x4 (&acc)[2][2][4][2], const Unit& u, int wr, int wc, int fr, int fq) const {
        const int row0 = u.pm * BM + wr * 64 + fr, col0 = u.pn * BM + wc * 32 + 4 * fq;
        const float* gp = g + (size_t)((u.pm * BM) >> 13) * 6144 + col0;
        f32x4 gv[2][2];
#pragma unroll
        for (int bj = 0; bj < 2; ++bj)
#pragma unroll
            for (int n = 0; n < 2; ++n) gv[bj][n] = *(const PG8_GAS f32x4*)(gp + bj * HALF + n * 16);
#pragma unroll
        for (int ai = 0; ai < 2; ++ai)
#pragma unroll
            for (int m = 0; m < 4; ++m) { float* rowp = X + (size_t)(row0 + ai * HALF + m * 16) * 1024 + col0;
#pragma unroll
                for (int bj = 0; bj < 2; ++bj)
#pragma unroll
                    for (int n = 0; n < 2; ++n) { PG8_GAS f32x4* p = (PG8_GAS f32x4*)(rowp + bj * HALF + n * 16); *p = *p + gv[bj][n] * acc[ai][bj][m][n]; } }
    }
};
struct EpiResidB { static constexpr bool PERM = true, AFTER_DRAIN = false; bf16_t* X; const float* g;
    __device__ __forceinline__ void operator()(const f32x4 (&acc)[2][2][4][2], const Unit& u, int wr, int wc, int fr, int fq) const {
        const int row0 = u.pm * BM + wr * 64 + fr, col0 = u.pn * BM + wc * 32 + 8 * fq;
        const float* gp = g + (size_t)((u.pm * BM) >> 13) * 6144 + col0;
        f32x4 gv[2][2];
#pragma unroll
        for (int bj = 0; bj < 2; ++bj)
#pragma unroll
            for (int n = 0; n < 2; ++n) gv[bj][n] = *(const PG8_GAS f32x4*)(gp + bj * HALF + n * 4);
#pragma unroll
        for (int ai = 0; ai < 2; ++ai)
#pragma unroll
            for (int m = 0; m < 4; ++m) { bf16_t* rowp = X + (size_t)(row0 + ai * HALF + m * 16) * 1024 + col0;
#pragma unroll
                for (int bj = 0; bj < 2; ++bj) { PG8_GAS u32x4* p = (PG8_GAS u32x4*)(rowp + bj * HALF); const u32x4 xo = *p;
                    const f32x4 a0 = acc[ai][bj][m][0] * gv[bj][0], a1 = acc[ai][bj][m][1] * gv[bj][1];
                    u32x4 w; w.x = cvt_pk_bf16(__builtin_bit_cast(float, xo.x << 16) + a0[0], __builtin_bit_cast(float, xo.x & 0xffff0000u) + a0[1]);
                    w.y = cvt_pk_bf16(__builtin_bit_cast(float, xo.y << 16) + a0[2], __builtin_bit_cast(float, xo.y & 0xffff0000u) + a0[3]);
                    w.z = cvt_pk_bf16(__builtin_bit_cast(float, xo.z << 16) + a1[0], __builtin_bit_cast(float, xo.z & 0xffff0000u) + a1[1]);
                    w.w = cvt_pk_bf16(__builtin_bit_cast(float, xo.w << 16) + a1[2], __builtin_bit_cast(float, xo.w & 0xffff0000u) + a1[3]);
                    *p = w; } }
    }
};
struct EpiF32 { static constexpr bool PERM = false, AFTER_DRAIN = false; float* C; long long ldc;
    __device__ __forceinline__ void operator()(const f32x4 (&acc)[2][2][4][2], const Unit& u, int wr, int wc, int fr, int fq) const {
        const int row0 = u.pm * BM + wr * 64 + fr, col0 = u.pn * BM + wc * 32 + 4 * fq;
#pragma unroll
        for (int ai = 0; ai < 2; ++ai)
#pragma unroll
            for (int m = 0; m < 4; ++m) { float* rowp = C + (size_t)(row0 + ai * HALF + m * 16) * ldc + col0;
#pragma unroll
                for (int bj = 0; bj < 2; ++bj)
#pragma unroll
                    for (int n = 0; n < 2; ++n) *(PG8_GAS f32x4*)(rowp + bj * HALF + n * 16) = acc[ai][bj][m][n]; }
    }
};
struct SchedPlain { const char* A; const char* B; size_t a_tile, b_tile; int nM, nN, G, c, wgm, pad;
    __device__ __forceinline__ bool next(int i, Unit& u) const { int tm, tn; if (!tile_of(i, G, c, nM, nN, wgm, tm, tn)) return false;
        u.pm = tm; u.pn = tn; u.A = A + (size_t)tm * a_tile; u.B = B + (size_t)tn * b_tile; return true; } };
struct SchedMoE { const char* A; const char* B; size_t a_tile, b_tile; int nN, G, c, i0, cnt, pad;
    __device__ __forceinline__ bool next(int i, Unit& u) const { int tm, tn; if (i >= cnt || !tile_of(i + i0, G, c, 128, nN, (nN == 16) ? MOE_WGM_MD : MOE_WGM_ME, tm, tn)) return false;
        const int e = tm >> 3, b = (tm >> 2) & 1, r = tm & 3, pm = ((b * 16 + e) << 2) + r;
        u.pm = pm; u.pn = tn; u.A = A + (size_t)pm * a_tile; u.B = B + (size_t)(e * nN + tn) * b_tile; if (pad) { u.A = A; u.B = B; } return true; } };
}

constexpr int D = 1024, NB = 2, S = 8192, DEPTH = 4, T = NB * S;
constexpr int NG = 4, GD = 256, HD = 64, NH = 16, NKV = 4, WIN = 128, NE = 16, CAP = 1024, DE = 2048, QKVN = 1536;
constexpr float EPS = 1e-6f;
constexpr int NWAVES = 8, NTHR = 512;

constexpr size_t MiB = 1u << 20;
constexpr size_t WS_CTL = 0, CTL_ZERO_BYTES = 32768;
constexpr size_t WS_MOD = 1 * MiB;
constexpr size_t WS_TAB = 2 * MiB;
constexpr size_t WS_MBT = 4 * MiB;
constexpr size_t WS_WQKV = 8 * MiB;
constexpr size_t WS_WAO = 14 * MiB;
constexpr size_t WS_WFO = 18 * MiB;
constexpr size_t WS_WFF = 22 * MiB;
constexpr size_t WS_CS = 30 * MiB;
constexpr size_t WS_AFF = 32 * MiB;
constexpr size_t WS_IDX = 33 * MiB;
constexpr size_t WS_GATE = 33 * MiB + 512 * 1024;
constexpr size_t WS_SLOT = 34 * MiB;
constexpr size_t WS_MISC = 35 * MiB;
constexpr size_t WS_PAR = 36 * MiB;
constexpr int PAR_NMIX = 0, PAR_NFFN = 4096, PAR_QG = 8192, PAR_KG = 8192 + 128, PAR_SINK = 8192 + 256, PAR_WR = 16384;
constexpr size_t WS_H = 64 * MiB;
constexpr size_t WS_XIN = 96 * MiB;
constexpr size_t WS_ACT = 160 * MiB;
constexpr size_t WS_Y = 288 * MiB;
constexpr size_t WS_QKV = 352 * MiB;
constexpr size_t WS_O = 400 * MiB;
constexpr size_t WS_TA = 432 * MiB;
constexpr size_t WS_YF = 464 * MiB;
constexpr size_t WS_PQ = 496 * MiB;
constexpr size_t WS_W1 = 576 * MiB;
constexpr size_t WS_W2 = 1088 * MiB;
constexpr size_t WS_GOLD = 1344 * MiB;
constexpr size_t WS_XB = 1600 * MiB;
constexpr size_t WS_END = 1792 * MiB;
constexpr int CW_BAR = 4096;

constexpr int RING_BYTES = 133120;
constexpr int MISC_OFF = RING_BYTES;
constexpr int LDS_BYTES = 147456;

#define GAS __attribute__((address_space(1)))
#define LAS __attribute__((address_space(3)))
typedef unsigned short bf16;
typedef unsigned v4u __attribute__((ext_vector_type(4)));
typedef unsigned v2u __attribute__((ext_vector_type(2)));
typedef float f32x4 __attribute__((ext_vector_type(4)));
typedef short bf16x8 __attribute__((ext_vector_type(8)));
#define LDS_WAIT() asm volatile("s_waitcnt lgkmcnt(0)" ::: "memory")
#define VM_WAIT() asm volatile("s_waitcnt vmcnt(0)" ::: "memory")
__device__ __forceinline__ unsigned f2bf(float f) { unsigned u = __builtin_bit_cast(unsigned, f); return (u + 0x7fffu + ((u >> 16) & 1u)) >> 16; }
typedef __bf16 bf16x2_t __attribute__((ext_vector_type(2)));
typedef float f32x2_t __attribute__((ext_vector_type(2)));
__device__ __forceinline__ unsigned pk2(float lo, float hi) { const f32x2_t v = {lo, hi}; return __builtin_bit_cast(unsigned, __builtin_convertvector(v, bf16x2_t)); }
__device__ __forceinline__ float bf_lo(unsigned w) { return __builtin_bit_cast(float, w << 16); }
__device__ __forceinline__ float bf_hi(unsigned w) { return __builtin_bit_cast(float, w & 0xffff0000u); }
__device__ __forceinline__ float shx(float v, int o, int lane) { return __builtin_bit_cast(float, __builtin_amdgcn_ds_bpermute((lane ^ o) << 2, __builtin_bit_cast(int, v))); }
__device__ __forceinline__ unsigned shl_from(unsigned v, int src_lane) { return (unsigned)__builtin_amdgcn_ds_bpermute((src_lane & 63) << 2, (int)v); }
__device__ __forceinline__ float wave_sum(float v, int lane) {
#pragma unroll
    for (int o = 1; o < 64; o <<= 1) v += shx(v, o, lane);
    return v;
}

#define XB_TMO      128
#define XB_MISMAP   192
#define XB_XCNT(j)  (256  + 64 * (j))
#define XB_XSUB(j)  (1280 + 64 * (j))
#define XB_XGEN(j)  (2304 + 64 * (j))
#define XB_TOP      3328
#define XB_TOPGEN   3392
#define XCD_BAR_WORDS 3456
#define XB_SPIN_CAP (1u << 18)

__device__ __forceinline__ unsigned xb_ld(unsigned* p)              { return __hip_atomic_load(p, __ATOMIC_RELAXED, __HIP_MEMORY_SCOPE_AGENT); }
__device__ __forceinline__ unsigned xb_add(unsigned* p, unsigned v) { return __hip_atomic_fetch_add(p, v, __ATOMIC_RELAXED, __HIP_MEMORY_SCOPE_AGENT); }
__device__ __forceinline__ unsigned xb_xcc_id() { return (unsigned)__builtin_amdgcn_s_getreg((3 << 11) | 20) & 0xFu; }
#define XB_SPIN(cond, bar) do { unsigned _sp = 0; while (cond) { __builtin_amdgcn_s_sleep(1); \
    if ((++_sp & 255u) == 0u) { if (xb_ld(&(bar)[XB_TMO])) break; if (_sp > XB_SPIN_CAP) { atomicAdd(&(bar)[XB_TMO], 1u); break; } } } } while (0)

struct XcdBarrier {
    unsigned* bar; unsigned x;
    volatile LAS unsigned* st;
};

__device__ __forceinline__ XcdBarrier xcd_barrier_post(unsigned* bar, volatile LAS unsigned* st) {
    XcdBarrier b; b.bar = bar; b.x = xb_xcc_id(); b.st = st;
    if (threadIdx.x == 0) (void)xb_add(&bar[XB_XCNT(b.x)], 1u);
    return b;
}
__device__ __forceinline__ void xcd_barrier_complete(unsigned* bar, unsigned x, unsigned& nloc, unsigned& nx) {
    const unsigned G = gridDim.x * gridDim.y * gridDim.z;
    unsigned sum, cnt, mine, sp = 0u;
    for (;;) {
        sum = 0u; cnt = 0u; mine = 0u;
#pragma unroll
        for (unsigned j = 0; j < 16; ++j) { const unsigned c = xb_ld(&bar[XB_XCNT(j)]); sum += c; cnt += (c > 0u) ? 1u : 0u; mine = (j == x) ? c : mine; }
        if (sum == G) break;
        __builtin_amdgcn_s_sleep(1);
        if ((++sp & 255u) == 0u) { if (xb_ld(&bar[XB_TMO])) break; if (sp > XB_SPIN_CAP) { atomicAdd(&bar[XB_TMO], 1u); break; } }
    }
    nloc = mine > 0u ? mine : 1u; nx = cnt > 0u ? cnt : 1u;
}

__device__ __forceinline__ void xcd_barrier(const XcdBarrier& b, const bool local = false) {
    asm volatile("s_waitcnt vmcnt(0)" ::: "memory");
    __syncthreads();
    if (threadIdx.x == 0) {
        unsigned* bar = b.bar;
        __builtin_amdgcn_s_waitcnt(0);
        unsigned nloc = b.st[0], nx = b.st[1];
        if (nloc == 0u) { xcd_barrier_complete(bar, b.x, nloc, nx); b.st[0] = nloc; b.st[1] = nx; }
        const unsigned old = xb_add(&bar[XB_XSUB(b.x)], 1u);
        const unsigned gen = old / nloc;
        if (old + 1u == (gen + 1u) * nloc) {
            if (!local) {
            __builtin_amdgcn_fence(__ATOMIC_RELEASE, "agent");
            asm volatile("s_waitcnt vmcnt(0)" ::: "memory");
            const unsigned og = xb_add(&bar[XB_TOP], 1u);
            const unsigned tg = og / nx;
            if (og + 1u == (tg + 1u) * nx) xb_add(&bar[XB_TOPGEN], 1u);
            else XB_SPIN(xb_ld(&bar[XB_TOPGEN]) == tg, bar);
            }
            __builtin_amdgcn_fence(__ATOMIC_ACQUIRE, "agent");
            xb_add(&bar[XB_XGEN(b.x)], 1u);
            asm volatile("s_waitcnt vmcnt(0)" ::: "memory");
        } else {
            XB_SPIN(xb_ld(&bar[XB_XGEN(b.x)]) == gen, bar);
            __builtin_amdgcn_fence(__ATOMIC_ACQUIRE, "agent");
            asm volatile("s_waitcnt vmcnt(0)" ::: "memory");
        }
    }
    __syncthreads();
}


struct Params { const float* in[17]; float* out; unsigned char* ws; int ph_lo, ph_hi; };
enum { IN_X = 0, IN_C, IN_WADA, IN_BADA, IN_NMIX, IN_NFFN, IN_WFO, IN_WQKV, IN_WAO, IN_QG, IN_KG, IN_SINK, IN_RELB, IN_WR, IN_WG, IN_WU, IN_WD };
struct Frame { LAS unsigned char* lds; int tid, lane, wave, vcu, G; };

struct CvtItem { const float* src; bf16* dst; int N, ldk; };
__device__ __forceinline__ void cvt_load(const CvtItem& it, f32x4 (&v)[16], int lane) {
    const int kr = lane >> 4, nc = (lane & 15) * 4;
#pragma unroll
    for (int i = 0; i < 16; ++i) v[i] = __builtin_nontemporal_load((const GAS f32x4*)(it.src + (size_t)(4 * i + kr) * it.N + nc));
}
__device__ __forceinline__ void cvt_store(const CvtItem& it, const f32x4 (&v)[16], LAS float* scr, int lane) {
    const int kr = lane >> 4, nc = (lane & 15) * 4;
#pragma unroll
    for (int i = 0; i < 16; ++i) { LAS float* p = scr + (4 * i + kr) * 65 + nc; p[0] = v[i].x; p[1] = v[i].y; p[2] = v[i].z; p[3] = v[i].w; }
    LDS_WAIT(); asm volatile("" ::: "memory");
    const int c = lane & 7;
#pragma unroll
    for (int j = 0; j < 8; ++j) { const int n = (lane >> 3) + 8 * j; const LAS float* s = scr + (8 * c) * 65 + n;
        v4u o; o.x = pk2(s[0 * 65], s[1 * 65]); o.y = pk2(s[2 * 65], s[3 * 65]); o.z = pk2(s[4 * 65], s[5 * 65]); o.w = pk2(s[6 * 65], s[7 * 65]);
        __builtin_nontemporal_store(o, (GAS v4u*)(it.dst + (size_t)n * it.ldk + 8 * c)); }
    LDS_WAIT(); asm volatile("" ::: "memory");
}

__device__ __forceinline__ CvtItem moe_item(const Params& p, int l, int it) {
    bf16* W1 = (bf16*)(p.ws + WS_W1) + (size_t)l * NE * 4096 * 1024; bf16* W2 = (bf16*)(p.ws + WS_W2) + (size_t)l * NE * 1024 * 2048;
    const int kind = it >> 13, r = it & 8191; CvtItem ci;
    if (kind < 2) { const int e = r >> 9, kt = (r >> 5) & 15, ntile = r & 31; const int n0 = ntile * 64, k0 = kt * 64;
        ci.src = (kind ? p.in[IN_WU] : p.in[IN_WG]) + (size_t)l * NE * D * DE + (size_t)e * D * DE + (size_t)k0 * DE + n0; ci.N = DE;
        ci.dst = W1 + ((size_t)e * 4096 + (size_t)(n0 >> 7) * 256 + kind * 128 + (n0 & 127)) * 1024 + k0; ci.ldk = 1024;
    } else { const int e = r >> 9, kt = (r >> 4) & 31, ntile = r & 15; const int n0 = ntile * 64, k0 = kt * 64;
        ci.src = p.in[IN_WD] + (size_t)l * NE * DE * D + (size_t)e * DE * D + (size_t)k0 * D + n0; ci.N = D;
        ci.dst = W2 + ((size_t)e * 1024 + n0) * 2048 + k0; ci.ldk = 2048; }
    return ci;
}
__device__ __forceinline__ void cvt_moe_layer(const Params& p, Frame& F, int l, int w0, int nw, int iend) {
    LAS float* scr = (LAS float*)(F.lds + F.wave * 16640);
    if (w0 >= iend) return;
    f32x4 va[16], vb[16];
    CvtItem ca = moe_item(p, l, w0), cb = ca; cvt_load(ca, va, F.lane);
    for (int it = w0; it < iend; it += 2 * nw) {
        const bool hb = it + nw < iend;
        if (hb) { cb = moe_item(p, l, it + nw); cvt_load(cb, vb, F.lane); }
        cvt_store(ca, va, scr, F.lane);
        const bool ha = it + 2 * nw < iend;
        if (ha) { ca = moe_item(p, l, it + 2 * nw); cvt_load(ca, va, F.lane); }
        if (hb) cvt_store(cb, vb, scr, F.lane);
    }
}

__device__ __forceinline__ void phase_ma(const Params& p, Frame& F, int l, const bool fd, const float* xin32) {
    LAS float* wrp = (LAS float*)F.lds;
    const float* wr = (const float*)(p.ws + WS_PAR) + PAR_WR + (size_t)l * D * NE;
    for (int s = F.tid; s < D * NE; s += NTHR) { const int c = s >> 4, e = s & 15; wrp[(((e * 4 + (c >> 8)) * 4 + (c & 3)) << 6) + ((c & 255) >> 2)] = wr[s]; }
    __syncthreads();
    const float* mod = (const float*)(p.ws + WS_MOD) + (size_t)l * NB * 6 * D;
    const float* gain = (const float*)(p.ws + WS_PAR) + PAR_NFFN + l * D;
    const int gw = F.vcu * NWAVES + F.wave, NGW = F.G * NWAVES;
    const int b = (gw * 2) / NGW, wsub = gw - b * (NGW / 2), nsub = NGW / 2;
    f32x4 Av[4], Bv[4];
#pragma unroll
    for (int j = 0; j < 4; ++j) { const int c = 256 * j + 4 * F.lane; const f32x4 g = *(const f32x4*)(gain + c), sc = *(const f32x4*)(mod + b * 6 * D + 4 * D + c);
        Av[j] = g * (sc + 1.0f); Bv[j] = *(const f32x4*)(mod + b * 6 * D + 3 * D + c); }
    bf16* xb = (bf16*)(p.ws + WS_XB); bf16* H = (bf16*)(p.ws + WS_H); float* aff = (float*)(p.ws + WS_AFF);
    const bf16* PQ = (const bf16*)(p.ws + WS_PQ); const float* y4096 = (const float*)(p.ws + WS_MISC);
    f32x4 G1[4];
#pragma unroll
    for (int j = 0; j < 4; ++j) G1[j] = fd ? *(const f32x4*)(mod + b * 6 * D + 2 * D + 256 * j + 4 * F.lane) : (f32x4){0.f, 0.f, 0.f, 0.f};
    const bool xmap = (nsub == 1024);
    const int rb0 = xmap ? ((wsub >> 8) << 11) + (wsub & 255) : wsub, rstep = xmap ? 256 : nsub;
    for (int s0 = rb0; s0 < (xmap ? rb0 + 8 * rstep : S); s0 += 4 * rstep) {
        asm volatile("" ::: "memory");
        f32x4 h[4][4]; float rs[4];
        int tk[4];
        if (fd && xmap) {
            const int rrA = wsub * 4 + ((s0 != rb0) ? 2 : 0);
#pragma unroll
            for (int pr = 0; pr < 2; ++pr) { const int rr = rrA + pr, u = rr >> 7, j = rr & 127; const int kp = u ? u + 64 * j : (j < 64 ? 64 * j : 32 + 64 * (j - 64));
                tk[2 * pr] = kp; tk[2 * pr + 1] = (rr == 0) ? 4096 : S - kp; }
        } else {
#pragma unroll
            for (int r = 0; r < 4; ++r) tk[r] = s0 + r * rstep; }
#pragma unroll
        for (int r = 0; r < 4; ++r) { const int row = b * S + tk[r]; float ss = 0.f;
            if (fd) { const int k = tk[r], m = k & 63, qd = k >> 6; int rr; float sg = 1.0f; bool special = false;
                if (m >= 1 && m <= 31) { rr = m * 128 + qd; }
                else if (m >= 33) { const int kp = S - k; rr = (kp & 63) * 128 + (kp >> 6); sg = -1.0f; }
                else if (m == 0) { if (qd <= 63) rr = qd; else if (qd == 64) { rr = 0; special = true; } else { rr = 128 - qd; sg = -1.0f; } }
                else { if (qd <= 63) rr = 64 + qd; else { rr = 64 + (127 - qd); sg = -1.0f; } }
                const bf16* P = PQ + ((size_t)(b * 4096 + rr)) * 2048;
#pragma unroll
                for (int j = 0; j < 4; ++j) { const int cc = 256 * j + 4 * F.lane; f32x4 y;
                    if (special) y = *(const f32x4*)(y4096 + b * 1024 + cc); else { const v2u pw = *(const GAS v2u*)(P + cc), qw = *(const GAS v2u*)(P + 1024 + cc);
                        y.x = bf_lo(pw.x) + sg * bf_lo(qw.x); y.y = bf_hi(pw.x) + sg * bf_hi(qw.x); y.z = bf_lo(pw.y) + sg * bf_lo(qw.y); y.w = bf_hi(pw.y) + sg * bf_hi(qw.y); }
                    f32x4 xo; if (xin32) xo = *(const GAS f32x4*)(xin32 + (size_t)row * D + cc); else { const v2u xw = *(const GAS v2u*)(xb + (size_t)row * D + cc); xo = (f32x4){bf_lo(xw.x), bf_hi(xw.x), bf_lo(xw.y), bf_hi(xw.y)}; }
                    const f32x4 xn = xo + G1[j] * y; v2u ow; ow.x = pk2(xn.x, xn.y); ow.y = pk2(xn.z, xn.w); *(GAS v2u*)(xb + (size_t)row * D + cc) = ow;
                    h[r][j] = (f32x4){bf_lo(ow.x), bf_hi(ow.x), bf_lo(ow.y), bf_hi(ow.y)}; } }
#pragma unroll
            for (int j = 0; j < 4; ++j) { if (!fd) { const v2u xw = *(const GAS v2u*)(xb + (size_t)row * D + 256 * j + 4 * F.lane); h[r][j] = (f32x4){bf_lo(xw.x), bf_hi(xw.x), bf_lo(xw.y), bf_hi(xw.y)}; } ss += (h[r][j].x * h[r][j].x + h[r][j].y * h[r][j].y) + (h[r][j].z * h[r][j].z + h[r][j].w * h[r][j].w); }
            rs[r] = ss; }
#pragma unroll
        for (int r = 0; r < 4; ++r) { const int row = b * S + tk[r]; const float rstd = rsqrtf(wave_sum(rs[r], F.lane) * (1.0f / D) + EPS);
#pragma unroll
            for (int j = 0; j < 4; ++j) { h[r][j] = h[r][j] * rstd * Av[j] + Bv[j];
                v2u o; o.x = pk2(h[r][j].x, h[r][j].y); o.y = pk2(h[r][j].z, h[r][j].w); *(GAS v2u*)(H + (size_t)row * D + 256 * j + 4 * F.lane) = o; } }
        float th2[4][2];
#pragma unroll
        for (int hh = 0; hh < 2; ++hh) {
            asm volatile("" ::: "memory");
            float v[4][8];
#pragma unroll
            for (int ei = 0; ei < 8; ++ei) { const int e = 8 * hh + ei; float a0 = 0.f, a1 = 0.f, a2 = 0.f, a3 = 0.f;
#pragma unroll
                for (int j = 0; j < 4; ++j) { const LAS float* w = wrp + (((e * 4 + j) * 4) << 6) + F.lane; const float w0 = w[0], w1 = w[64], w2 = w[128], w3 = w[192];
                    a0 += h[0][j].x * w0 + h[0][j].y * w1 + h[0][j].z * w2 + h[0][j].w * w3; a1 += h[1][j].x * w0 + h[1][j].y * w1 + h[1][j].z * w2 + h[1][j].w * w3;
                    a2 += h[2][j].x * w0 + h[2][j].y * w1 + h[2][j].z * w2 + h[2][j].w * w3; a3 += h[3][j].x * w0 + h[3][j].y * w1 + h[3][j].z * w2 + h[3][j].w * w3; }
                v[0][ei] = a0; v[1][ei] = a1; v[2][ei] = a2; v[3][ei] = a3; }
#pragma unroll
            for (int r = 0; r < 4; ++r) { float t4[4], t2[2];
                { const bool hi = (F.lane & 32) != 0;
#pragma unroll
                  for (int i = 0; i < 4; ++i) { const float send = hi ? v[r][i] : v[r][i + 4], keep = hi ? v[r][i + 4] : v[r][i]; t4[i] = keep + shx(send, 32, F.lane); } }
                { const bool hi = (F.lane & 16) != 0;
#pragma unroll
                  for (int i = 0; i < 2; ++i) { const float send = hi ? t4[i] : t4[i + 2], keep = hi ? t4[i + 2] : t4[i]; t2[i] = keep + shx(send, 16, F.lane); } }
                { const bool hi = (F.lane & 8) != 0; const float send = hi ? t2[0] : t2[1], keep = hi ? t2[1] : t2[0]; th2[r][hh] = keep + shx(send, 8, F.lane); } }
        }
#pragma unroll
        for (int r = 0; r < 4; ++r) { float t1;
            { const bool hi = (F.lane & 4) != 0; const float send = hi ? th2[r][0] : th2[r][1], keep = hi ? th2[r][1] : th2[r][0]; t1 = keep + shx(send, 4, F.lane); }
            t1 += shx(t1, 1, F.lane); t1 += shx(t1, 2, F.lane);
            float mx = t1;
#pragma unroll
            for (int o = 4; o < 64; o <<= 1) mx = fmaxf(mx, shx(mx, o, F.lane));
            const float pe = expf(t1 - mx); float sum = pe;
#pragma unroll
            for (int o = 4; o < 64; o <<= 1) sum += shx(sum, o, F.lane);
            const int e = ((F.lane >> 2) & 1) * 8 + ((F.lane >> 5) & 1) * 4 + ((F.lane >> 4) & 1) * 2 + ((F.lane >> 3) & 1);
            if ((F.lane & 3) == 0) aff[((size_t)b * NE + e) * S + tk[r]] = pe / sum; }
    }
}

__device__ __forceinline__ void phase_mbc(const Params& p, Frame& F) {
    LAS unsigned* hist = (LAS unsigned*)F.lds;
    LAS unsigned* ctl = hist + 8 * 256;
    LAS unsigned* wtot = ctl + 64;
    LAS int* sel = (LAS int*)(wtot + 64);
    const float* aff = (const float*)(p.ws + WS_AFF); float* gate = (float*)(p.ws + WS_GATE); int* slotmap = (int*)(p.ws + WS_SLOT);
    const bf16* H = (const bf16*)(p.ws + WS_H); bf16* X = (bf16*)(p.ws + WS_XIN);
    const int nsub = (F.G >= 8 * NB * NE) ? 8 : 1;
    for (int zz = F.vcu; zz < NB * NE * nsub; zz += F.G) {
        int z = zz / nsub, sub = zz - z * nsub;
        if (nsub == 8 && F.G == 256) { const int xg = zz >> 5, j = (zz >> 3) & 3; z = (j & 1) * 16 + 2 * xg + (j >> 1); sub = zz & 7; }
        unsigned key[16];
#pragma unroll
        for (int q = 0; q < 4; ++q) { const v4u k4 = *(const GAS v4u*)(aff + (size_t)z * S + F.tid * 16 + 4 * q); key[4 * q] = k4.x; key[4 * q + 1] = k4.y; key[4 * q + 2] = k4.z; key[4 * q + 3] = k4.w; }
        unsigned prefix = 0u, need = CAP;
#pragma unroll
        for (int pass = 0; pass < 4; ++pass) {
            const int shift = 24 - 8 * pass;
            __syncthreads();
            for (int i = F.tid; i < 8 * 256; i += NTHR) hist[i] = 0u;
            __syncthreads();
            LAS unsigned* myh = hist + F.wave * 256;
#pragma unroll
            for (int u = 0; u < 16; ++u) { const unsigned hi = (pass == 0) ? 0u : (key[u] >> ((shift + 8) & 31)); if (hi == prefix) atomicAdd((unsigned*)&myh[(key[u] >> shift) & 255u], 1u); }
            __syncthreads();
            if (F.wave == 0) {
                unsigned h0 = 0u, h1 = 0u, h2 = 0u, h3 = 0u;
#pragma unroll
                for (int w = 0; w < 8; ++w) { const LAS unsigned* hw = hist + w * 256 + 4 * F.lane; h0 += hw[0]; h1 += hw[1]; h2 += hw[2]; h3 += hw[3]; }
                const unsigned tot = h0 + h1 + h2 + h3; unsigned suf = tot;
#pragma unroll
                for (int o = 1; o < 64; o <<= 1) { const unsigned t = shl_from(suf, F.lane + o); if (F.lane + o < 64) suf += t; }
                unsigned cum = suf - tot;
                if (cum < need && need <= cum + tot) {
                    unsigned d = 4 * F.lane + 3, c = h3;
                    if (cum + c < need) { cum += c; d = 4 * F.lane + 2; c = h2;
                        if (cum + c < need) { cum += c; d = 4 * F.lane + 1; c = h1;
                            if (cum + c < need) { cum += c; d = 4 * F.lane; c = h0; } } }
                    ctl[0] = (prefix << 8) | d; ctl[1] = need - cum; }
            }
            __syncthreads();
            prefix = ctl[0]; need = ctl[1];
        }
        unsigned cnt = 0u;
#pragma unroll
        for (int u = 0; u < 16; ++u) cnt += (key[u] > prefix ? 1u : 0u) + (key[u] == prefix ? 65536u : 0u);
        unsigned inc = cnt;
#pragma unroll
        for (int o = 1; o < 64; o <<= 1) { const unsigned t = shl_from(inc, F.lane - o); if (F.lane >= o) inc += t; }
        if (F.lane == 63) wtot[F.wave] = inc;
        __syncthreads();
        unsigned base = inc - cnt;
        for (int w = 0; w < F.wave; ++w) base += wtot[w];
        unsigned ng = base & 0xffffu, ne = base >> 16;
#pragma unroll
        for (int u = 0; u < 16; ++u) { const int i = F.tid * 16 + u; const bool gt = key[u] > prefix, eq = key[u] == prefix; const bool selq = gt || (eq && ne < need);
            const int slot = (int)(ng + (ne < need ? ne : need));
            const bool mine = (nsub == 1) || ((u & (nsub - 1)) == sub);
            if (selq) { sel[slot] = i; if (mine) gate[z * CAP + slot] = __builtin_bit_cast(float, key[u]); }
            if (mine) slotmap[((size_t)(z >> 4) * S + i) * NE + (z & 15)] = selq ? slot : -1;
            ng += gt ? 1u : 0u; ne += eq ? 1u : 0u; }
        __syncthreads();
        const int per = CAP / nsub, b = z >> 4;
        for (int s = F.wave; s < per; s += NWAVES) { const int slot = sub * per + s; const int src = b * S + sel[slot];
            const GAS v4u* sp = (const GAS v4u*)(H + (size_t)src * D) + F.lane; GAS v4u* dp = (GAS v4u*)(X + ((size_t)z * CAP + slot) * D) + F.lane;
            const v4u a = sp[0], cc = sp[64]; dp[0] = a; dp[64] = cc; }
    }
}

__device__ __forceinline__ void phase_mf(const Params& p, Frame& F, int l, const bool dry) {
    const int* slotmap = (const int*)(p.ws + WS_SLOT); const bf16* Y = (const bf16*)(p.ws + WS_Y); bf16* xb = (bf16*)(p.ws + WS_XB); bf16* xbo = (bf16*)(p.ws + (dry ? WS_GOLD : WS_XB)); float* xo32 = dry ? (float*)(p.ws + WS_GOLD) : p.out; bf16* H = (bf16*)(p.ws + (dry ? WS_GOLD + 128 * MiB : WS_H));
    const float* mod = (const float*)(p.ws + WS_MOD) + (size_t)l * NB * 6 * D;
    const bool nxt = (l + 1 < DEPTH);
    const float* modn = mod + NB * 6 * D; const float* gainn = (const float*)(p.ws + WS_PAR) + PAR_NMIX + (l + 1) * D;
    const int gw = F.vcu * NWAVES + F.wave, NGW = F.G * NWAVES;
    const int b = (gw * 2) / NGW, wsub = gw - b * (NGW / 2), nsub = NGW / 2;
    const bool xmap = (nsub == 1024); const int rb0 = xmap ? ((wsub >> 8) << 11) + (wsub & 255) : wsub, rstep = xmap ? 256 : nsub;
    for (int s4 = rb0; s4 < (xmap ? rb0 + 8 * rstep : S); s4 += 4 * rstep) {
      const int slv = slotmap[((size_t)b * S + s4 + (F.lane >> 4) * rstep) * NE + (F.lane & 15)];
      const unsigned long long selmask = __builtin_amdgcn_ballot_w64(slv >= 0);
#pragma unroll
      for (int k = 0; k < 4; ++k) { const int s = s4 + k * rstep, row = b * S + s;
        unsigned m = (unsigned)(selmask >> (16 * k)) & 0xffffu;
        f32x4 xv[4];
#pragma unroll
        for (int j = 0; j < 2; ++j) { const v4u xw = *(const GAS v4u*)(xb + (size_t)row * D + 512 * j + 8 * F.lane);
            xv[2 * j] = (f32x4){bf_lo(xw.x), bf_hi(xw.x), bf_lo(xw.y), bf_hi(xw.y)}; xv[2 * j + 1] = (f32x4){bf_lo(xw.z), bf_hi(xw.z), bf_lo(xw.w), bf_hi(xw.w)}; }
        float acc[16];
#pragma unroll
        for (int i = 0; i < 16; ++i) acc[i] = 0.f;
        while (m) {
            int ex[4]; int cnt = 0;
#pragma unroll
            for (int j = 0; j < 4; ++j) { if (m) { ex[j] = __builtin_ctz(m); m &= m - 1u; cnt = j + 1; } else ex[j] = ex[0]; }
            v4u ya[4], yc[4];
#pragma unroll
            for (int j = 0; j < 4; ++j) { const int sj = __builtin_amdgcn_readlane(slv, k * 16 + ex[j]);
                const GAS v4u* yp = (const GAS v4u*)(Y + ((size_t)(b * NE + ex[j]) * CAP + sj) * D) + F.lane; ya[j] = yp[0]; yc[j] = yp[64]; }
#pragma unroll
            for (int j = 0; j < 4; ++j) if (j < cnt) { const v4u a = ya[j], c = yc[j];
                acc[0] += bf_lo(a.x); acc[1] += bf_hi(a.x); acc[2] += bf_lo(a.y); acc[3] += bf_hi(a.y); acc[4] += bf_lo(a.z); acc[5] += bf_hi(a.z); acc[6] += bf_lo(a.w); acc[7] += bf_hi(a.w);
                acc[8] += bf_lo(c.x); acc[9] += bf_hi(c.x); acc[10] += bf_lo(c.y); acc[11] += bf_hi(c.y); acc[12] += bf_lo(c.z); acc[13] += bf_hi(c.z); acc[14] += bf_lo(c.w); acc[15] += bf_hi(c.w); } }
        float ss = 0.f;
#pragma unroll
        for (int j = 0; j < 2; ++j) { const int c0 = 512 * j + 8 * F.lane; const f32x4* gp = (const f32x4*)(mod + b * 6 * D + 5 * D + c0);
            const f32x4 g0 = gp[0], g1 = gp[1]; f32x4 x0 = xv[2 * j], x1 = xv[2 * j + 1];
            x0.x += g0.x * acc[8 * j + 0]; x0.y += g0.y * acc[8 * j + 1]; x0.z += g0.z * acc[8 * j + 2]; x0.w += g0.w * acc[8 * j + 3];
            x1.x += g1.x * acc[8 * j + 4]; x1.y += g1.y * acc[8 * j + 5]; x1.z += g1.z * acc[8 * j + 6]; x1.w += g1.w * acc[8 * j + 7];
            if (nxt) { v4u ow; ow.x = pk2(x0.x, x0.y); ow.y = pk2(x0.z, x0.w); ow.z = pk2(x1.x, x1.y); ow.w = pk2(x1.z, x1.w); *(GAS v4u*)(xbo + (size_t)row * D + c0) = ow;
                x0 = (f32x4){bf_lo(ow.x), bf_hi(ow.x), bf_lo(ow.y), bf_hi(ow.y)}; x1 = (f32x4){bf_lo(ow.z), bf_hi(ow.z), bf_lo(ow.w), bf_hi(ow.w)}; }
            else { GAS f32x4* xp = (GAS f32x4*)(xo32 + (size_t)row * D + c0); xp[0] = x0; xp[1] = x1; }
            acc[8 * j + 0] = x0.x; acc[8 * j + 1] = x0.y; acc[8 * j + 2] = x0.z; acc[8 * j + 3] = x0.w; acc[8 * j + 4] = x1.x; acc[8 * j + 5] = x1.y; acc[8 * j + 6] = x1.z; acc[8 * j + 7] = x1.w;
            ss += (x0.x * x0.x + x0.y * x0.y) + (x0.z * x0.z + x0.w * x0.w) + (x1.x * x1.x + x1.y * x1.y) + (x1.z * x1.z + x1.w * x1.w); }
        if (nxt) { const float rstd = rsqrtf(wave_sum(ss, F.lane) * (1.0f / D) + EPS);
#pragma unroll
            for (int j = 0; j < 2; ++j) { const int c0 = 512 * j + 8 * F.lane; v4u o; float hv[8];
#pragma unroll
                for (int i = 0; i < 8; ++i) hv[i] = acc[8 * j + i] * rstd * gainn[c0 + i] * (1.0f + modn[b * 6 * D + 1 * D + c0 + i]) + modn[b * 6 * D + c0 + i];
                o.x = pk2(hv[0], hv[1]); o.y = pk2(hv[2], hv[3]); o.z = pk2(hv[4], hv[5]); o.w = pk2(hv[6], hv[7]); *(GAS v4u*)(H + (size_t)row * D + c0) = o; } }
      }
    }
}


#define MFMA16(a, b, c) __builtin_amdgcn_mfma_f32_16x16x32_bf16((a), (b), (c), 0, 0, 0)
typedef short s16x4 __attribute__((ext_vector_type(4)));
__device__ __forceinline__ unsigned lds_addr(LAS void* p) { return (unsigned)(size_t)p; }
__device__ __forceinline__ bf16x8 tr_frag(unsigned a0, unsigned a1) {
    s16x4 lo, hi;
    asm volatile("ds_read_b64_tr_b16 %0, %2\n\tds_read_b64_tr_b16 %1, %3\n\ts_waitcnt lgkmcnt(0)" : "=&v"(lo), "=&v"(hi) : "v"(a0), "v"(a1) : "memory");
    return __builtin_shufflevector(lo, hi, 0, 1, 2, 3, 4, 5, 6, 7);
}
__device__ __forceinline__ void tr_frag4(unsigned a0, unsigned a1, unsigned a2, unsigned a3, unsigned a4, unsigned a5, unsigned a6, unsigned a7, bf16x8& f0, bf16x8& f1, bf16x8& f2, bf16x8& f3) {
    s16x4 r0, r1, r2, r3, r4, r5, r6, r7;
    asm volatile("ds_read_b64_tr_b16 %0, %8\n\tds_read_b64_tr_b16 %1, %9\n\tds_read_b64_tr_b16 %2, %10\n\tds_read_b64_tr_b16 %3, %11\n\t"
                 "ds_read_b64_tr_b16 %4, %12\n\tds_read_b64_tr_b16 %5, %13\n\tds_read_b64_tr_b16 %6, %14\n\tds_read_b64_tr_b16 %7, %15\n\ts_waitcnt lgkmcnt(0)"
                 : "=&v"(r0), "=&v"(r1), "=&v"(r2), "=&v"(r3), "=&v"(r4), "=&v"(r5), "=&v"(r6), "=&v"(r7)
                 : "v"(a0), "v"(a1), "v"(a2), "v"(a3), "v"(a4), "v"(a5), "v"(a6), "v"(a7) : "memory");
    f0 = __builtin_shufflevector(r0, r1, 0, 1, 2, 3, 4, 5, 6, 7); f1 = __builtin_shufflevector(r2, r3, 0, 1, 2, 3, 4, 5, 6, 7);
    f2 = __builtin_shufflevector(r4, r5, 0, 1, 2, 3, 4, 5, 6, 7); f3 = __builtin_shufflevector(r6, r7, 0, 1, 2, 3, 4, 5, 6, 7);
}
__device__ __forceinline__ unsigned off_b(unsigned row, unsigned ch) { return 256u * row + 16u * (ch ^ (((row & 3u) << 2) | ((row >> 2) & 3u))); }
__device__ __forceinline__ unsigned tr_read_addr_16(unsigned lane, unsigned c, unsigned ks, unsigned t) {
    const unsigned g = lane >> 4, q = (lane & 15) >> 2, pp = lane & 3;
    return off_b(32 * ks + 8 * g + 4 * t + q, 2 * c + (pp >> 1)) + 8 * (pp & 1);
}

__device__ __forceinline__ void phase_aa(const Params& p, Frame& F, int l, const float* x) {
    const float* mod = (const float*)(p.ws + WS_MOD) + (size_t)l * NB * 6 * D; const float* gain = (const float*)(p.ws + WS_PAR) + PAR_NMIX + l * D;
    const int gw = F.vcu * NWAVES + F.wave, NGW = F.G * NWAVES;
    const int b = (gw * 2) / NGW, wsub = gw - b * (NGW / 2), nsub = NGW / 2;
    f32x4 Av[4], Bv[4];
#pragma unroll
    for (int j = 0; j < 4; ++j) { const int c = 256 * j + 4 * F.lane; const f32x4 g = *(const f32x4*)(gain + c), sc = *(const f32x4*)(mod + b * 6 * D + 1 * D + c);
        Av[j] = g * (sc + 1.0f); Bv[j] = *(const f32x4*)(mod + b * 6 * D + 0 * D + c); }
    bf16* H = (bf16*)(p.ws + WS_H);
    for (int s = wsub; s < S; s += nsub) {
        const int row = b * S + s;
        asm volatile("" ::: "memory");
        f32x4 h[4]; float ss = 0.f;
#pragma unroll
        for (int j = 0; j < 4; ++j) { h[j] = *(const GAS f32x4*)(x + (size_t)row * D + 256 * j + 4 * F.lane); ss += (h[j].x * h[j].x + h[j].y * h[j].y) + (h[j].z * h[j].z + h[j].w * h[j].w); }
        const float rstd = rsqrtf(wave_sum(ss, F.lane) * (1.0f / D) + EPS);
#pragma unroll
        for (int j = 0; j < 4; ++j) { h[j] = h[j] * rstd * Av[j] + Bv[j];
            v2u o; o.x = pk2(h[j].x, h[j].y); o.y = pk2(h[j].z, h[j].w); *(GAS v2u*)(H + (size_t)row * D + 256 * j + 4 * F.lane) = o; }
    }
}

constexpr float ATT_COFF = 16.0f;
constexpr int AT_KP = 144, AT_VP = 160;
constexpr int AT_KOFF = 0, AT_VOFF = 384 * AT_KP, AT_BOFF = AT_VOFF + 384 * AT_VP;
__device__ __forceinline__ void phase_ac(const Params& p, Frame& F, int l) {
    const int jl = l >> 1;
    const bf16* QKV = (const bf16*)(p.ws + WS_QKV); bf16* O = (bf16*)(p.ws + WS_O);
    const float* biasrel = (const float*)(p.ws + WS_TAB);
    const float* par = (const float*)(p.ws + WS_PAR); const float* qg = par + PAR_QG + jl * HD; const float* kg = par + PAR_KG + jl * HD; const float* sink = par + PAR_SINK + jl * NH;
    LAS unsigned char* Kimg = F.lds + AT_KOFF; LAS unsigned char* Vimg = F.lds + AT_VOFF; LAS float* btab = (LAS float*)(F.lds + AT_BOFF);
    const int lane = F.lane, g4 = lane >> 4, ql = lane & 15;
    const int hq = F.wave >> 1, th = F.wave & 1;
    constexpr float LOG2E = 1.44269504f;
    for (int U = F.vcu; U < NB * 64 * NKV; U += F.G) {
        int b = U >> 8, n = (U >> 2) & 63, kvh = U & 3;
        if (F.G == 256) { const int xg = F.vcu >> 5, lu = (F.vcu & 31) + ((U >= 256) ? 32 : 0); b = xg >> 2; n = 16 * (xg & 3) + (lu >> 2); kvh = lu & 3; }
        const int h = kvh * 4 + hq;
        __syncthreads();
        { const int part = F.tid & 7; f32x4 kg0 = *(const f32x4*)(kg + part * 8), kg1 = *(const f32x4*)(kg + part * 8 + 4);
#pragma unroll
          for (int i = 0; i < 6; ++i) { const int row = (F.tid >> 3) + 64 * i; const int kpos = n * 128 - 128 + row; const bool ok = (kpos >= 0) && (kpos < S);
              v4u kq = (v4u){0u, 0u, 0u, 0u}, vq = (v4u){0u, 0u, 0u, 0u};
              if (ok) { const bf16* base = QKV + ((size_t)b * S + kpos) * QKVN + NH * HD + kvh * HD + part * 8; kq = *(const GAS v4u*)base; vq = *(const GAS v4u*)(base + NKV * HD); }
              float f[8] = {bf_lo(kq.x), bf_hi(kq.x), bf_lo(kq.y), bf_hi(kq.y), bf_lo(kq.z), bf_hi(kq.z), bf_lo(kq.w), bf_hi(kq.w)};
              float ss = 0.f;
#pragma unroll
              for (int e = 0; e < 8; ++e) ss += f[e] * f[e];
              ss += shx(ss, 1, F.lane); ss += shx(ss, 2, F.lane); ss += shx(ss, 4, F.lane);
              const float r = rsqrtf(ss * (1.0f / HD) + EPS);
              v4u ko; ko.x = pk2(f[0] * r * kg0.x, f[1] * r * kg0.y); ko.y = pk2(f[2] * r * kg0.z, f[3] * r * kg0.w); ko.z = pk2(f[4] * r * kg1.x, f[5] * r * kg1.y); ko.w = pk2(f[6] * r * kg1.z, f[7] * r * kg1.w);
              *(LAS v4u*)(Kimg + row * AT_KP + part * 16) = ko; *(LAS v4u*)(Vimg + row * AT_VP + part * 16) = vq; } }
        for (int i = F.tid; i < 4 * 257; i += NTHR) { const int gg = i / 257, r = i - gg * 257; btab[gg * 260 + r] = biasrel[(kvh * 4 + gg) * 257 + r] - ATT_COFF; }
        __syncthreads();
        const float sk = sink[h] * LOG2E - ATT_COFF;
        const LAS float* bt = btab + hq * 260;
        const unsigned vbase = lds_addr(Vimg) + (unsigned)(((lane & 15) >> 2) * AT_VP + (lane & 3) * 8);
        f32x4 qa[2][2];
#pragma unroll
        for (int ds = 0; ds < 2; ++ds) { qa[ds][0] = *(const f32x4*)(qg + 32 * ds + 8 * g4); qa[ds][1] = *(const f32x4*)(qg + 32 * ds + 8 * g4 + 4); }
#pragma unroll 1
        for (int qh = 0; qh < 2; ++qh) {
            bf16x8 qf[2][2];
#pragma unroll
            for (int q2 = 0; q2 < 2; ++q2) { const int tok = n * 128 + th * 64 + 32 * qh + 16 * q2 + ql; const bf16* qp = QKV + ((size_t)b * S + tok) * QKVN + h * HD + 8 * g4;
                const v4u w0 = *(const GAS v4u*)qp, w1 = *(const GAS v4u*)(qp + 32);
                float f[16] = {bf_lo(w0.x), bf_hi(w0.x), bf_lo(w0.y), bf_hi(w0.y), bf_lo(w0.z), bf_hi(w0.z), bf_lo(w0.w), bf_hi(w0.w), bf_lo(w1.x), bf_hi(w1.x), bf_lo(w1.y), bf_hi(w1.y), bf_lo(w1.z), bf_hi(w1.z), bf_lo(w1.w), bf_hi(w1.w)};
                float ss = 0.f;
#pragma unroll
                for (int e = 0; e < 16; ++e) ss += f[e] * f[e];
                ss += shx(ss, 16, F.lane); ss += shx(ss, 32, F.lane);
                const float r = rsqrtf(ss * (1.0f / HD) + EPS) * (0.125f * LOG2E);
#pragma unroll
                for (int ds = 0; ds < 2; ++ds) { v4u o; o.x = pk2(f[8 * ds + 0] * r * qa[ds][0].x, f[8 * ds + 1] * r * qa[ds][0].y); o.y = pk2(f[8 * ds + 2] * r * qa[ds][0].z, f[8 * ds + 3] * r * qa[ds][0].w);
                    o.z = pk2(f[8 * ds + 4] * r * qa[ds][1].x, f[8 * ds + 5] * r * qa[ds][1].y); o.w = pk2(f[8 * ds + 6] * r * qa[ds][1].z, f[8 * ds + 7] * r * qa[ds][1].w);
                    qf[q2][ds] = __builtin_bit_cast(bf16x8, o); } }
            float lrun[2]; f32x4 oacc[4][2];
#pragma unroll
            for (int q2 = 0; q2 < 2; ++q2) { lrun[q2] = 0.f;
#pragma unroll
                for (int db = 0; db < 4; ++db) oacc[db][q2] = (f32x4){0.f, 0.f, 0.f, 0.f}; }
#pragma unroll 1
            for (int c = th; c < th + 5; ++c) {
                bf16x8 kf[4][2];
#pragma unroll
                for (int kb = 0; kb < 4; ++kb)
#pragma unroll
                    for (int ds = 0; ds < 2; ++ds) kf[kb][ds] = *(const LAS bf16x8*)(Kimg + (64 * c + 16 * kb + ql) * AT_KP + (32 * ds + 8 * g4) * 2);
                bf16x8 pf[2][2];
#pragma unroll
                for (int q2 = 0; q2 < 2; ++q2) { const int q0 = th * 64 + 32 * qh + 16 * q2, qoff = q0 + ql;
                    f32x4 sacc[4];
                    const bool full = (64 * c - 143 - q0 >= -128) && (64 * c - 65 - q0 <= 128) && (n * 128 + 64 * c - 128 >= 0) && (n * 128 + 64 * c - 65 < S);
                    if (full) { const LAS float* bp = bt + (64 * c + 4 * g4 - qoff);
#pragma unroll
                        for (int kb = 0; kb < 4; ++kb) sacc[kb] = (f32x4){bp[16 * kb], bp[16 * kb + 1], bp[16 * kb + 2], bp[16 * kb + 3]};
                    } else {
#pragma unroll
                        for (int kb = 0; kb < 4; ++kb)
#pragma unroll
                            for (int j = 0; j < 4; ++j) { const int koff = 64 * c + 16 * kb + 4 * g4 + j - 128; const int rel = koff - qoff; const int kpos = n * 128 + koff;
                                const bool ok = ((unsigned)(rel + 128) <= 256u) && (kpos >= 0) && (kpos < S);
                                sacc[kb][j] = ok ? bt[ok ? rel + 128 : 0] : -1e30f; } }
                    float ps = 0.f; float pv[4][4];
#pragma unroll
                    for (int kb = 0; kb < 4; ++kb) { f32x4 a = MFMA16(kf[kb][0], qf[q2][0], sacc[kb]); a = MFMA16(kf[kb][1], qf[q2][1], a);
#pragma unroll
                        for (int j = 0; j < 4; ++j) { pv[kb][j] = __builtin_amdgcn_exp2f(a[j]); ps += pv[kb][j]; } }
                    lrun[q2] += ps;
#pragma unroll
                    for (int ks2 = 0; ks2 < 2; ++ks2) { v4u o; o.x = pk2(pv[2 * ks2][0], pv[2 * ks2][1]); o.y = pk2(pv[2 * ks2][2], pv[2 * ks2][3]); o.z = pk2(pv[2 * ks2 + 1][0], pv[2 * ks2 + 1][1]); o.w = pk2(pv[2 * ks2 + 1][2], pv[2 * ks2 + 1][3]);
                        pf[q2][ks2] = __builtin_bit_cast(bf16x8, o); } }
#pragma unroll
                for (int ks2 = 0; ks2 < 2; ++ks2) { const unsigned a0 = vbase + (unsigned)((64 * c + 32 * ks2 + 4 * g4) * AT_VP); bf16x8 v0, v1, v2, v3;
                    tr_frag4(a0, a0 + 16u * AT_VP, a0 + 32u, a0 + 32u + 16u * AT_VP, a0 + 64u, a0 + 64u + 16u * AT_VP, a0 + 96u, a0 + 96u + 16u * AT_VP, v0, v1, v2, v3);
                    oacc[0][0] = MFMA16(v0, pf[0][ks2], oacc[0][0]); oacc[0][1] = MFMA16(v0, pf[1][ks2], oacc[0][1]); oacc[1][0] = MFMA16(v1, pf[0][ks2], oacc[1][0]); oacc[1][1] = MFMA16(v1, pf[1][ks2], oacc[1][1]);
                    oacc[2][0] = MFMA16(v2, pf[0][ks2], oacc[2][0]); oacc[2][1] = MFMA16(v2, pf[1][ks2], oacc[2][1]); oacc[3][0] = MFMA16(v3, pf[0][ks2], oacc[3][0]); oacc[3][1] = MFMA16(v3, pf[1][ks2], oacc[3][1]); }
            }
#pragma unroll
            for (int q2 = 0; q2 < 2; ++q2) { float lt = lrun[q2]; lt += shx(lt, 16, F.lane); lt += shx(lt, 32, F.lane); lt += __builtin_amdgcn_exp2f(sk);
                const float inv = 1.0f / lt; const int tok = n * 128 + th * 64 + 32 * qh + 16 * q2 + ql; bf16* op = O + ((size_t)b * S + tok) * D + h * HD + 4 * g4;
#pragma unroll
                for (int db = 0; db < 4; ++db) { const f32x4 v = oacc[db][q2] * inv; v2u o; o.x = pk2(v.x, v.y); o.y = pk2(v.z, v.w); *(GAS v2u*)(op + 16 * db) = o; } }
        }
    }
}

__device__ __forceinline__ void phase_fa(const Params& p, Frame& F, int l, const float* xraw) {
    const bf16* H = (const bf16*)(p.ws + WS_H); bf16* TA = (bf16*)(p.ws + WS_TA);
    const bf16* R64B = (const bf16*)(p.ws + WS_TAB + 65536);
    const int lane = F.lane, g4 = lane >> 4, ql = lane & 15;
    for (int U = F.vcu; U < NB * 128; U += F.G) {
        const int b = U >> 7, s2 = U & 127;
        __syncthreads();
        if (xraw) {
            const float* mod = (const float*)(p.ws + WS_MOD) + (size_t)l * NB * 6 * D; const float* gain = (const float*)(p.ws + WS_PAR) + PAR_NMIX + l * D;
            f32x4 Av[4], Bv[4];
#pragma unroll
            for (int j = 0; j < 4; ++j) { const int c = 256 * j + 4 * lane; const f32x4 g = *(const f32x4*)(gain + c), sc = *(const f32x4*)(mod + b * 6 * D + 1 * D + c);
                Av[j] = g * (sc + 1.0f); Bv[j] = *(const f32x4*)(mod + b * 6 * D + 0 * D + c); }
#pragma unroll 1
            for (int r4 = 0; r4 < 2; ++r4) { f32x4 h[4][4];
#pragma unroll
                for (int r = 0; r < 4; ++r)
#pragma unroll
                    for (int j = 0; j < 4; ++j) h[r][j] = *(const GAS f32x4*)(xraw + ((size_t)b * S + 128 * (F.wave * 8 + r4 * 4 + r) + s2) * D + 256 * j + 4 * lane);
#pragma unroll
                for (int r = 0; r < 4; ++r) { const int s1 = F.wave * 8 + r4 * 4 + r; float ss = 0.f;
#pragma unroll
                    for (int j = 0; j < 4; ++j) ss += (h[r][j].x * h[r][j].x + h[r][j].y * h[r][j].y) + (h[r][j].z * h[r][j].z + h[r][j].w * h[r][j].w);
                    const float rstd = rsqrtf(wave_sum(ss, lane) * (1.0f / D) + EPS);
#pragma unroll
                    for (int j = 0; j < 4; ++j) { const f32x4 hv = h[r][j] * rstd * Av[j] + Bv[j]; const int c = 256 * j + 4 * lane;
                        v2u o; o.x = pk2(hv.x, hv.y); o.y = pk2(hv.z, hv.w); *(LAS v2u*)(F.lds + (c >> 7) * 16384 + off_b(s1, (c & 127) >> 3) + (c & 7) * 2) = o; } } }
        } else {
#pragma unroll 4
            for (int i = 0; i < 16; ++i) { const int q = F.tid + 512 * i, row = q >> 7, c128 = q & 127;
                const v4u v = *(const GAS v4u*)(H + ((size_t)b * S + 128 * row + s2) * D + c128 * 8);
                *(LAS v4u*)(F.lds + (c128 >> 4) * 16384 + off_b(row, c128 & 15)) = v; }
        }
        bf16x8 rf[4][2];
#pragma unroll
        for (int rb = 0; rb < 4; ++rb)
#pragma unroll
            for (int ks = 0; ks < 2; ++ks) rf[rb][ks] = *(const GAS bf16x8*)(R64B + (16 * rb + ql) * 64 + 32 * ks + 8 * g4);
        __syncthreads();
        const unsigned ibase = lds_addr(F.lds) + F.wave * 16384;
#pragma unroll 1
        for (int c4 = 0; c4 < 2; ++c4) {
            f32x4 acc[4][4];
#pragma unroll
            for (int cb = 0; cb < 4; ++cb)
#pragma unroll
                for (int rb = 0; rb < 4; ++rb) acc[cb][rb] = (f32x4){0.f, 0.f, 0.f, 0.f};
#pragma unroll
            for (int ks = 0; ks < 2; ++ks) { bf16x8 f0, f1, f2, f3; unsigned a[8];
#pragma unroll
                for (int i = 0; i < 4; ++i) { a[2 * i] = ibase + tr_read_addr_16(lane, 4 * c4 + i, ks, 0); a[2 * i + 1] = ibase + tr_read_addr_16(lane, 4 * c4 + i, ks, 1); }
                tr_frag4(a[0], a[1], a[2], a[3], a[4], a[5], a[6], a[7], f0, f1, f2, f3);
#pragma unroll
                for (int rb = 0; rb < 4; ++rb) { acc[0][rb] = MFMA16(f0, rf[rb][ks], acc[0][rb]); acc[1][rb] = MFMA16(f1, rf[rb][ks], acc[1][rb]);
                    acc[2][rb] = MFMA16(f2, rf[rb][ks], acc[2][rb]); acc[3][rb] = MFMA16(f3, rf[rb][ks], acc[3][rb]); } }
#pragma unroll
            for (int rb = 0; rb < 4; ++rb) { const int r = 16 * rb + ql; const int uh = (r == 0) ? 0 : (r == 32 ? 1 : (r < 32 ? 2 * r : 2 * (r - 32) + 1));
                bf16* tp = TA + (((size_t)b * 64 + uh) * 128 + s2) * 1024 + 128 * F.wave + 64 * c4 + 4 * g4;
#pragma unroll
                for (int cb = 0; cb < 4; ++cb) { const f32x4 v = acc[cb][rb]; v2u w; w.x = pk2(v.x, v.y); w.y = pk2(v.z, v.w); *(GAS v2u*)(tp + 16 * cb) = w; } }
        }
    }
}

__device__ __forceinline__ void phase_fb(const Params& p, Frame& F) {
    const bf16* TA = (const bf16*)(p.ws + WS_TA); const bf16* MBT = (const bf16*)(p.ws + WS_MBT); bf16* YF = (bf16*)(p.ws + WS_YF); float* Yr4096 = (float*)(p.ws + WS_MISC + 8192);
    const int lane = F.lane, g4 = lane >> 4, ql = lane & 15;
    for (int U = F.vcu; U < NB * 32 * 4; U += F.G) {
        const int b = U >> 7, u = (U >> 2) & 31, cq = U & 3;
        __syncthreads();
        const bf16* src = TA + ((size_t)(b * 32 + u) * 256) * 1024 + cq * 256;
#pragma unroll 4
        for (int i = 0; i < 16; ++i) { const int q = F.tid + 512 * i, row = q >> 5, c32 = q & 31;
            const v4u v = *(const GAS v4u*)(src + (size_t)row * 1024 + c32 * 8);
            *(LAS v4u*)(F.lds + (c32 >> 4) * 65536 + off_b(row, c32 & 15)) = v; }
        __syncthreads();
        f32x4 acc[16][2];
#pragma unroll
        for (int cb = 0; cb < 16; ++cb) { acc[cb][0] = (f32x4){0.f, 0.f, 0.f, 0.f}; acc[cb][1] = (f32x4){0.f, 0.f, 0.f, 0.f}; }
        const bf16* mrow = MBT + ((size_t)u * 256 + 32 * F.wave + ql) * 256 + 8 * g4;
        const unsigned lbase = lds_addr(F.lds);
#pragma unroll 1
        for (int ks = 0; ks < 8; ++ks) {
            const bf16x8 m0 = *(const GAS bf16x8*)(mrow + 32 * ks), m1 = *(const GAS bf16x8*)(mrow + 16 * 256 + 32 * ks);
#pragma unroll
            for (int c4 = 0; c4 < 4; ++c4) { bf16x8 f0, f1, f2, f3; unsigned a[8];
#pragma unroll
                for (int i = 0; i < 4; ++i) { const int cb = 4 * c4 + i; a[2 * i] = lbase + (cb >> 3) * 65536 + tr_read_addr_16(lane, cb & 7, ks, 0); a[2 * i + 1] = lbase + (cb >> 3) * 65536 + tr_read_addr_16(lane, cb & 7, ks, 1); }
                tr_frag4(a[0], a[1], a[2], a[3], a[4], a[5], a[6], a[7], f0, f1, f2, f3);
                acc[4 * c4 + 0][0] = MFMA16(f0, m0, acc[4 * c4 + 0][0]); acc[4 * c4 + 0][1] = MFMA16(f0, m1, acc[4 * c4 + 0][1]);
                acc[4 * c4 + 1][0] = MFMA16(f1, m0, acc[4 * c4 + 1][0]); acc[4 * c4 + 1][1] = MFMA16(f1, m1, acc[4 * c4 + 1][1]);
                acc[4 * c4 + 2][0] = MFMA16(f2, m0, acc[4 * c4 + 2][0]); acc[4 * c4 + 2][1] = MFMA16(f2, m1, acc[4 * c4 + 2][1]);
                acc[4 * c4 + 3][0] = MFMA16(f3, m0, acc[4 * c4 + 3][0]); acc[4 * c4 + 3][1] = MFMA16(f3, m1, acc[4 * c4 + 3][1]); }
        }
#pragma unroll
        for (int mb = 0; mb < 2; ++mb) { const int o = 32 * F.wave + 16 * mb + ql, ri = o >> 7, jj = o & 127;
            bf16* yp = YF + (((size_t)(b * 4096 + u * 128 + jj)) * 2 + ri) * 1024 + cq * 256 + 4 * g4;
#pragma unroll
            for (int cb = 0; cb < 16; ++cb) { const f32x4 v = acc[cb][mb]; v2u w; w.x = pk2(v.x, v.y); w.y = pk2(v.z, v.w); *(GAS v2u*)(yp + 16 * cb) = w; } }
        if (u == 0 && F.tid < 256) {
            const int col = F.tid; const LAS unsigned char* img = F.lds + (col >> 7) * 65536; const int cc = col & 127; float a = 0.f;
            for (int s2 = 0; s2 < 128; ++s2) { const unsigned short hv = *(const LAS unsigned short*)(img + off_b(s2, cc >> 3) + 2 * (cc & 7)); const float v = __builtin_bit_cast(float, (unsigned)hv << 16); a += (s2 & 1) ? -v : v; }
            Yr4096[b * 1024 + cq * 256 + col] = a; }
    }
}

__device__ __forceinline__ void fc_extra(const Params& p, Frame& F, int l) {
    const float* Yr = (const float*)(p.ws + WS_MISC + 8192); float* y4096 = (float*)(p.ws + WS_MISC); const bf16* W = (const bf16*)(p.ws + WS_WFF) + (size_t)(l >> 1) * 2048 * 1024;
    const int gw = F.vcu * NWAVES + F.wave, NGW = F.G * NWAVES;
    for (int o = gw; o < NB * 1024; o += NGW) { const int b = o >> 10, j = o & 1023; float a = 0.f;
#pragma unroll
        for (int i = 0; i < 2; ++i) { const int c = 512 * i + 8 * F.lane; const v4u w = *(const GAS v4u*)(W + (size_t)j * 1024 + c); const f32x4 y0 = *(const GAS f32x4*)(Yr + b * 1024 + c), y1 = *(const GAS f32x4*)(Yr + b * 1024 + c + 4);
            a += y0.x * bf_lo(w.x) + y0.y * bf_hi(w.x) + y0.z * bf_lo(w.y) + y0.w * bf_hi(w.y) + y1.x * bf_lo(w.z) + y1.y * bf_hi(w.z) + y1.z * bf_lo(w.w) + y1.w * bf_hi(w.w); }
        a = wave_sum(a, F.lane); if (F.lane == 0) y4096[o] = a; }
}

__device__ __forceinline__ void pro_small(const Params& p, Frame& F) {
    const int gt = F.vcu * NTHR + F.tid, NGT = F.G * NTHR;
    float* mod = (float*)(p.ws + WS_MOD);
    { LAS float* sc = (LAS float*)F.lds; LAS float* part = sc + 2 * D;
      for (int i = F.tid; i < 2 * D; i += NTHR) { const float cv = p.in[IN_C][i]; sc[i] = cv / (1.f + expf(-cv)); }
      __syncthreads();
      for (int cb = F.vcu; cb < DEPTH * 6 * D / 96; cb += F.G) {
          const int col0 = cb * 96, l = col0 / (6 * D), j0 = col0 - l * 6 * D;
          if (F.tid < 480) { const int cc = F.tid % 96, ks = F.tid / 96; const int k0 = ks * 205, k1 = (k0 + 205 < D) ? k0 + 205 : D;
              const float* w = p.in[IN_WADA] + (size_t)l * D * 6 * D + j0 + cc; float a0 = 0.f, a1 = 0.f;
#pragma unroll 16
              for (int i = k0; i < k1; ++i) { const float wv = w[(size_t)i * 6 * D]; a0 += sc[i] * wv; a1 += sc[D + i] * wv; }
              part[(ks * 2 + 0) * 96 + cc] = a0; part[(ks * 2 + 1) * 96 + cc] = a1; }
          __syncthreads();
          if (F.tid < 192) { const int bb = F.tid / 96, cc = F.tid % 96; float a = p.in[IN_BADA][l * 6 * D + j0 + cc];
#pragma unroll
              for (int ks = 0; ks < 5; ++ks) a += part[(ks * 2 + bb) * 96 + cc];
              mod[((size_t)l * NB + bb) * 6 * D + j0 + cc] = a; }
          __syncthreads(); } }
    { float* par = (float*)(p.ws + WS_PAR);
      for (int i = gt; i < 4096; i += NGT) { par[PAR_NMIX + i] = p.in[IN_NMIX][i]; par[PAR_NFFN + i] = p.in[IN_NFFN][i]; }
      for (int i = gt; i < 128; i += NGT) { par[PAR_QG + i] = p.in[IN_QG][i]; par[PAR_KG + i] = p.in[IN_KG][i]; }
      for (int i = gt; i < 32; i += NGT) par[PAR_SINK + i] = p.in[IN_SINK][i];
      for (int i = gt; i < DEPTH * D * NE; i += NGT) par[PAR_WR + i] = p.in[IN_WR][i]; }
    float* biasrel = (float*)(p.ws + WS_TAB); bf16* MBT = (bf16*)(p.ws + WS_MBT); bf16* CS = (bf16*)(p.ws + WS_CS);
    for (int i = gt; i < NH * 257; i += NGT) { const int h = i / 257, r = i - h * 257, rel = r - 128, n = rel < 0 ? -rel : rel;
        int bk = (n < 8) ? n : 8 + (n >= 12) + (n >= 16) + (n >= 23) + (n >= 32) + (n >= 46) + (n >= 64) + (n >= 91);
        bk += (rel > 0) ? 16 : 0; biasrel[i] = p.in[IN_RELB][bk * NH + h] * 1.44269504f; }
    { bf16* R64B = (bf16*)(p.ws + WS_TAB + 65536);
      for (int i = gt; i < 64 * 64; i += NGT) { const int r = i >> 6, s = i & 63; float sv, cv;
          if (r <= 32) { sincospif((float)((r * s) & 63) / 32.0f, &sv, &cv); R64B[i] = (bf16)f2bf(cv); } else { sincospif((float)(((r - 32) * s) & 63) / 32.0f, &sv, &cv); R64B[i] = (bf16)f2bf(-sv); } } }
    for (int i = gt; i < 512 * 256; i += NGT) { const int rr = i >> 8, m = i & 255, cs = rr >> 8, nn = rr & 255; float sv, cv; sincospif((float)((nn * m) & 255) / 128.0f, &sv, &cv); CS[i] = (bf16)f2bf(cs ? sv : cv); }
    for (int i = gt; i < 32 * 256 * 256; i += NGT) { const int u = i >> 16, o = (i >> 8) & 255, K = i & 255, ri = o >> 7, j = o & 127, half = K >> 7, s2 = K & 127; float val = 0.f;
        if (u >= 1) { const int k = u + 64 * j; float sv, cv; sincospif((float)((s2 * k) & 8191) / 4096.0f, &sv, &cv);
            val = (ri == 0) ? (half == 0 ? cv : sv) : (half == 0 ? -sv : cv); }
        else { const int blk = j >> 6, k = (blk ? 32 : 0) + 64 * (j & 63); if (half == blk) { float sv, cv; sincospif((float)((s2 * k) & 8191) / 4096.0f, &sv, &cv); val = (ri == 0) ? cv : -sv; } }
        MBT[i] = (bf16)f2bf(val); }
}
__device__ __forceinline__ CvtItem dense_item(const Params& p, int it) {
    constexpr int I_QKV = 16 * 24, I_SQ = 16 * 16; CvtItem ci; int r = it;
    if (r < 2 * I_QKV) { const int j = r / I_QKV; r -= j * I_QKV; const int kt = r / 24, ntile = r % 24;
        ci.src = p.in[IN_WQKV] + (size_t)j * D * QKVN + (size_t)kt * 64 * QKVN + ntile * 64; ci.N = QKVN; ci.dst = (bf16*)(p.ws + WS_WQKV) + ((size_t)j * QKVN + ntile * 64) * D + kt * 64; ci.ldk = D; return ci; }
    r -= 2 * I_QKV; const int which = r / (2 * I_SQ); r -= which * 2 * I_SQ; const int j = r / I_SQ; r -= j * I_SQ; const int kt = r >> 4, ntile = r & 15;
    ci.src = (which ? p.in[IN_WFO] : p.in[IN_WAO]) + (size_t)j * D * D + (size_t)kt * 64 * D + ntile * 64; ci.N = D;
    ci.dst = (bf16*)(p.ws + (which ? WS_WFO : WS_WAO)) + ((size_t)j * D + ntile * 64) * D + kt * 64; ci.ldk = D; return ci;
}
__device__ __forceinline__ void pro_cvt_dense(const Params& p, Frame& F) {
    LAS float* scr = (LAS float*)(F.lds + F.wave * 16640);
    const int gw = F.vcu * NWAVES + F.wave, NGW = F.G * NWAVES;
    constexpr int NIT = 2 * 16 * 24 + 4 * 16 * 16;
    for (int it = gw; it < NIT; it += NGW) { f32x4 v[16]; const CvtItem ci = dense_item(p, it); cvt_load(ci, v, F.lane); cvt_store(ci, v, scr, F.lane); }
}

namespace pg8 {
struct SchedFC { const char* A; const char* B; int G, c;
    __device__ __forceinline__ bool next(int i, Unit& u) const { int tm, tn; if (!tile_of(i, G, c, 32, 8, DENSE_WGM, tm, tn)) return false;
        u.pm = tm; u.pn = tn; u.A = A + (size_t)tm * (256 * 2048 * 2) + (tn >= 4 ? 2048 : 0); u.B = B + (size_t)tn * (256 * 1024 * 2); return true; } };
struct SchedFold { const char* A; const char* B; int G, c;
    __device__ __forceinline__ bool next(int i, Unit& u) const { const long L = (long)i * G + c; if (L >= 64) return false; const int g = (int)L & 3, tm = ((int)L >> 2) & 3, cs = ((int)L >> 4) & 1, jl = (int)L >> 5;
        u.pm = tm + 4 * cs + 8 * jl; u.pn = g; u.A = A + (size_t)jl * (1024 * 1024 * 2) + (size_t)tm * (256 * 1024 * 2) + g * 512; u.B = B + (size_t)cs * (256 * 256 * 2); return true; } };
}

constexpr int NPH_L = 8, NPHASE = 1 + NPH_L * DEPTH;
#ifndef PROBE_MASK
#define PROBE_MASK 0
#endif
#define DUP(bit) _Pragma("unroll 1") for (int rep_ = 0; rep_ < (((PROBE_MASK) >> (bit)) & 1) + 1; ++rep_)
__global__ void __launch_bounds__(NTHR, 2) mk_fwd(Params p) {
    extern __shared__ __attribute__((aligned(16))) unsigned char lds_raw[];
    Frame F; F.lds = (LAS unsigned char*)lds_raw;
    F.tid = threadIdx.x; F.lane = F.tid & 63; F.wave = __builtin_amdgcn_readfirstlane(F.tid >> 6); const int wave0 = F.wave;
    F.G = gridDim.x; { const int bx = blockIdx.x; F.vcu = (F.G % 8 == 0) ? (bx % 8) * (F.G / 8) + bx / 8 : bx; }
    volatile LAS unsigned* MISC = (volatile LAS unsigned*)(F.lds + MISC_OFF);
    if (F.tid < 32) MISC[F.tid] = 0u;
    __syncthreads();
    XcdBarrier bar = xcd_barrier_post((unsigned*)(p.ws + WS_CTL) + CW_BAR, MISC + 8);
#ifndef PROBE_SAMETILE
#define PROBE_SAMETILE 0
#endif
    if (F.tid == 0 && (bar.x != (blockIdx.x & 7u) || gridDim.x != 256u)) (void)xb_add(&bar.bar[XB_MISMAP], 1u);
    const int lo = p.ph_lo, hi = p.ph_hi;
#define IN(k) (lo <= (k) && (k) < hi)
#ifndef PROBE_SAMETILE
#define PROBE_SAMETILE 0
#endif
#ifndef PROBE_NOEPI
#define PROBE_NOEPI 0
#endif
#ifndef PROBE_BAR2
#define PROBE_BAR2 0
#endif
#define SEAM(k) do { if (IN(k) && IN((k) + 1)) { xcd_barrier(bar); if (PROBE_BAR2) xcd_barrier(bar); } } while (0)
#define SEAM_LC(k, c) do { if (IN(k) && IN((k) + 1)) { const bool loc_ = (c) && __builtin_amdgcn_readfirstlane((int)MISC[10]) != 0; xcd_barrier(bar, loc_); } } while (0)
#define SEAM_L(k) SEAM_LC(k, true)
#define RELAUNDER() do { int w_ = wave0; asm volatile("" : "+s"(w_)); F.wave = w_; F.lane = pg8::lane_id_asm(); F.tid = F.wave * 64 + F.lane; } while (0)
#define PHASE_CTX() Params q; do { unsigned long long w_ = (unsigned long long)p.ws, o_ = (unsigned long long)p.out; asm volatile("" : "+s"(w_), "+s"(o_)); q.ws = (unsigned char*)w_; q.out = (float*)o_; RELAUNDER(); } while (0)

    if (IN(0)) DUP(0) {
        RELAUNDER(); pro_small(p, F);
        __syncthreads();
        RELAUNDER(); pro_cvt_dense(p, F);
        const int gw = F.vcu * NWAVES + F.wave, NGW = F.G * NWAVES;
        RELAUNDER(); cvt_moe_layer(p, F, 0, gw, NGW, 3 * 8192);
        if (F.vcu == 0 && F.tid == 0) { unsigned long long* pt = (unsigned long long*)(p.ws + WS_PAR + 512 * 1024); pt[0] = (unsigned long long)p.in[IN_WG]; pt[1] = (unsigned long long)p.in[IN_WU]; pt[2] = (unsigned long long)p.in[IN_WD]; pt[3] = (unsigned long long)p.in[IN_X]; }
        __syncthreads();
    }
    SEAM(0);
    if (lo == 0 && hi == NPHASE) {
        if (F.tid == 0) MISC[10] = (xb_ld(&bar.bar[XB_MISMAP]) == 0u) ? 1u : 0u;
        __syncthreads(); }
    for (int l = 0; l < DEPTH; ++l) {
        const int base = 1 + NPH_L * l; const bool fourier = (l & 1) == 0; const int jl = l >> 1;
        if (IN(base + 0)) DUP(1) {
            PHASE_CTX();
            if (fourier) {
                const float* xin0 = nullptr; if (l == 0) xin0 = (const float*)((const unsigned long long*)(q.ws + WS_PAR + 512 * 1024))[3];
                phase_fa(q, F, l, xin0);
                __syncthreads();
                if (l == 0) {
                pg8::SchedFold Sc{(const char*)(q.ws + WS_WFO), (const char*)(q.ws + WS_CS), F.G, F.vcu};
                pg8::EpiBf16 E{(bf16*)(q.ws + WS_WFF), 1024, nullptr, 1.0f / 1448.15468787f, 0};
                pg8::gemm_phase<pg8::EpiBf16, pg8::SchedFold, 256, 1024, 256>(F.lds, Sc, E, F.wave); }
            } else {
                pg8::SchedPlain Sc{(const char*)(q.ws + WS_H), (const char*)(q.ws + WS_WQKV + (size_t)jl * QKVN * D * 2), (size_t)256 * 1024 * 2, (size_t)256 * 1024 * 2, 64, 6, F.G, (int)blockIdx.x, DENSE_WGM, 0};
                pg8::EpiBf16 E{(bf16*)(q.ws + WS_QKV), QKVN, nullptr, 1.0f, 0};
                pg8::gemm_phase<pg8::EpiBf16, pg8::SchedPlain, 1024, 1024, 1024>(F.lds, Sc, E, F.wave);
                if (CVT_PRE > 0 && F.G == 256 && blockIdx.x >= 128 && rep_ == 0) { RELAUNDER(); __syncthreads();
                    const unsigned long long* pt = (const unsigned long long*)(q.ws + WS_PAR + 512 * 1024);
                    q.in[IN_WG] = (const float*)pt[0]; q.in[IN_WU] = (const float*)pt[1]; q.in[IN_WD] = (const float*)pt[2];
                    const int xs = F.vcu >> 5, w = ((F.vcu & 31) - 16) * NWAVES + F.wave, per = 3 * 8192 / 8;
                    cvt_moe_layer(q, F, l == 1 ? 2 : 3, xs * per + w, 16 * NWAVES, xs * per + CVT_PRE); __syncthreads(); }
            }
        }
        SEAM(base + 0);
        if (IN(base + 1)) DUP(2) {
            PHASE_CTX();
            if (fourier) phase_fb(q, F); else phase_ac(q, F, l);
        }
        SEAM_LC(base + 1, !fourier);
        if (IN(base + 2)) _Pragma("unroll 1") for (int rep_ = 0; rep_ < (((((PROBE_MASK) >> 3) & 1) && fourier) || ((((PROBE_MASK) >> 10) & 1) && !fourier) ? 2 : 1); ++rep_) {
            PHASE_CTX();
            if (fourier) {
                pg8::SchedFC Sc{(const char*)(q.ws + WS_YF), (const char*)(q.ws + WS_WFF + (size_t)jl * 2048 * 1024 * 2), F.G, (int)blockIdx.x};
                pg8::EpiBf16 E{(bf16*)(q.ws + WS_PQ), 2048, nullptr, 1.0f, 0};
                pg8::gemm_phase<pg8::EpiBf16, pg8::SchedFC, 1024, 2048, 1024>(F.lds, Sc, E, F.wave);
                RELAUNDER(); fc_extra(q, F, l);
            } else {
                pg8::SchedPlain Sc{(const char*)(q.ws + WS_O), (const char*)(q.ws + WS_WAO + (size_t)jl * D * D * 2), (size_t)256 * 1024 * 2, (size_t)256 * 1024 * 2, 64, 4, F.G, (int)blockIdx.x, DENSE_WGM, 0};
                pg8::EpiResidB E{(bf16*)(q.ws + (rep_ == 1 ? WS_GOLD : WS_XB)), (const float*)(q.ws + WS_MOD) + (size_t)l * NB * 6 * D + 2 * D};
                pg8::gemm_phase<pg8::EpiResidB, pg8::SchedPlain, 1024, 1024, 1024>(F.lds, Sc, E, F.wave);
            }
        }
        SEAM_LC(base + 2, !fourier);
        if (IN(base + 3)) DUP(4) { PHASE_CTX(); const float* xin = nullptr; if (l == 0) xin = (const float*)((const unsigned long long*)(q.ws + WS_PAR + 512 * 1024))[3]; phase_ma(q, F, l, fourier && rep_ == 0, xin); }
        SEAM(base + 3);
        if (IN(base + 4)) DUP(5) { PHASE_CTX(); phase_mbc(q, F); }
        SEAM_L(base + 4);
        if (IN(base + 5)) DUP(7) {
            PHASE_CTX();
            const int nxg = F.G >> 3, xslot = F.vcu / nxg; const int nper = (2048 + F.G - 1) / F.G, rsplit = (l + 1 < DEPTH) ? xslot * nper / 8 + 1 : nper;
#ifndef MD_SKEW_TICKS
#define MD_SKEW_TICKS 0
#endif
            if (MD_SKEW_TICKS) { const unsigned long long t0 = __builtin_amdgcn_s_memrealtime(), dl = (unsigned long long)((F.vcu & 3) * MD_SKEW_TICKS);
                while (__builtin_amdgcn_s_memrealtime() - t0 < dl) __builtin_amdgcn_s_sleep(8); }
#pragma unroll 1
            for (int part = 0; part < 2; ++part) {
                pg8::SchedMoE Sc{(const char*)(q.ws + WS_XIN), (const char*)(q.ws + WS_W1 + (size_t)l * NE * 4096 * 1024 * 2), (size_t)256 * 1024 * 2, (size_t)256 * 1024 * 2, 16, F.G, (int)blockIdx.x, part ? rsplit : 0, part ? nper - rsplit : rsplit, (PROBE_SAMETILE && rep_ == 1) ? 1 : 0};
                pg8::EpiSwiGLU E{(bf16*)(q.ws + WS_ACT), 2048, (PROBE_NOEPI && rep_ == 1) ? 1 : 0};
                pg8::gemm_phase<pg8::EpiSwiGLU, pg8::SchedMoE, 1024, 1024, 1024>(F.lds, Sc, E, F.wave);
                if (part == 0 && l + 1 < DEPTH && rep_ == 0) { RELAUNDER();
                    const unsigned long long* pt = (const unsigned long long*)(q.ws + WS_PAR + 512 * 1024);
                    q.in[IN_WG] = (const float*)pt[0]; q.in[IN_WU] = (const float*)pt[1]; q.in[IN_WD] = (const float*)pt[2];
                    const int nslotw = nxg * NWAVES, per = 3 * 8192 / 8;
                    const int pre = (F.G == 256 && l + 1 >= 2) ? CVT_PRE : 0;
                    cvt_moe_layer(q, F, l + 1, xslot * per + pre + (F.vcu - xslot * nxg) * NWAVES + F.wave, nslotw, (xslot + 1) * per); __syncthreads(); }
            }
        }
        SEAM_L(base + 5);
        if (IN(base + 6)) DUP(8) {
            PHASE_CTX();
            pg8::SchedMoE Sc{(const char*)(q.ws + WS_ACT), (const char*)(q.ws + WS_W2 + (size_t)l * NE * 1024 * 2048 * 2), (size_t)256 * 2048 * 2, (size_t)256 * 2048 * 2, 4, F.G, (int)blockIdx.x, 0, 1 << 20, 0};
            pg8::EpiBf16 E{(bf16*)(q.ws + WS_Y), 1024, (const float*)(q.ws + WS_GATE), 1.0f, 0};
            pg8::gemm_phase<pg8::EpiBf16, pg8::SchedMoE, 2048, 2048, 2048>(F.lds, Sc, E, F.wave);
        }
        SEAM(base + 6);
        if (IN(base + 7)) DUP(9) { PHASE_CTX(); phase_mf(q, F, l, rep_ == 1); }
        SEAM_LC(base + 7, fourier);
    }
#undef IN
#undef SEAM
}

#ifndef MK_MODE
#define MK_MODE 0
#endif
extern "C" void kernel_launch(void* const* d_in, const int* in_sizes, int n_in, void* d_out, int out_size, void* d_ws, size_t ws_size, hipStream_t stream) {
    static int grid = 0;
    if (grid == 0) {
        int dev = 0, cus = 0;
        if (n_in != 17 || ws_size < WS_END || hipGetDevice(&dev) != hipSuccess || hipDeviceGetAttribute(&cus, hipDeviceAttributeMultiprocessorCount, dev) != hipSuccess) { fprintf(stderr, "kernel_launch: bad arguments\n"); grid = -1; return; }
        if (hipFuncSetAttribute((const void*)mk_fwd, hipFuncAttributeMaxDynamicSharedMemorySize, LDS_BYTES) != hipSuccess) { fprintf(stderr, "kernel_launch: hipFuncSetAttribute failed\n"); grid = -1; return; }
        int per_cu = 0; (void)hipOccupancyMaxActiveBlocksPerMultiprocessor(&per_cu, (const void*)mk_fwd, NTHR, LDS_BYTES); (void)hipGetLastError();
        grid = cus;
    }
    if (grid < 0) return;
    Params P{}; for (int i = 0; i < 17; ++i) P.in[i] = (const float*)d_in[i]; P.out = (float*)d_out; P.ws = (unsigned char*)d_ws;
#if MK_MODE == 0
    (void)hipMemsetAsync((char*)d_ws + WS_CTL, 0, CTL_ZERO_BYTES, stream);
    P.ph_lo = 0; P.ph_hi = NPHASE; hipLaunchKernelGGL(mk_fwd, dim3(grid), dim3(NTHR), LDS_BYTES, stream, P);
#else
    for (int ph = 0; ph < NPHASE; ++ph) { (void)hipMemsetAsync((char*)d_ws + WS_CTL, 0, CTL_ZERO_BYTES, stream); P.ph_lo = ph; P.ph_hi = ph + 1; hipLaunchKernelGGL(mk_fwd, dim3(grid), dim3(NTHR), LDS_BYTES, stream, P); }
#endif
}
```

```cpp
#include <hip/hip_runtime.h>
#include <math.h>
#include <stdint.h>
#include <stdio.h>

#ifndef CVT_PRE
#define CVT_PRE 512
#endif
#ifndef DENSE_WGM
#define DENSE_WGM 8
#endif
#ifndef MOE_WGM_MD
#define MOE_WGM_MD 4
#endif
#ifndef MOE_WGM_ME
#define MOE_WGM_ME 4
#endif
namespace pg8 {
#define PG8_LAS __attribute__((address_space(3)))
typedef unsigned short bf16_t;
typedef short bf16x8 __attribute__((ext_vector_type(8)));
typedef float f32x4 __attribute__((ext_vector_type(4)));
typedef unsigned u32x4 __attribute__((ext_vector_type(4)));
constexpr int BM = 256, BK = 64, HALF = 128, HTB = HALF * BK * 2  , STAGE_BYTES = 8 * HTB, NXCD = 8;

__host__ __device__ __forceinline__ int lds_byte(int r, int c) { const int st = (r >> 4) * 2 + (c >> 5), rr = r & 15, cc = c & 31, ob = rr * 64 + cc * 2; return st * 1024 + (ob ^ (((ob >> 9) & 1) << 5)); }
__host__ __device__ __forceinline__ void stage_rc(int b, int& R, int& C) { const int st = b / 1024, sb = b % 1024, swz = sb ^ (((sb >> 9) & 1) << 5); R = (st >> 1) * 16 + swz / 64; C = (st & 1) * 32 + (swz % 64) / 2; }
__host__ __device__ __forceinline__ int perm32(int rho) { const int n = rho >> 4, i = rho & 15; return 8 * (i >> 2) + 4 * n + (i & 3); }

__device__ __forceinline__ int lane_id_asm() { int l; asm volatile("v_mbcnt_lo_u32_b32 %0, -1, 0\n\tv_mbcnt_hi_u32_b32 %0, -1, %0" : "=v"(l)); return l; }
struct Unit { const char* A; const char* B; int pm, pn; };

__device__ __forceinline__ bool tile_of(int i, int G, int c, int nM, int nN, int wgm, int& tm, int& tn) {
    const int nwg = nM * nN; const long L = (long)i * G + c; if (L >= nwg) return false;
    int wgid = (int)L; { const int q = nwg / NXCD, r = nwg % NXCD, xcd = wgid % NXCD, off = wgid / NXCD; wgid = (xcd < r ? xcd * (q + 1) : r * (q + 1) + (xcd - r) * q) + off; }
    const int nig = wgm * nN, gid = wgid / nig, fm = gid * wgm, gsz = (nM - fm) < wgm ? (nM - fm) : wgm;
    tm = fm + ((wgid % nig) % gsz); tn = (wgid % nig) / gsz; return true;
}

__device__ __forceinline__ unsigned cvt_pk_bf16(float lo, float hi) { unsigned r; asm volatile("v_cvt_pk_bf16_f32 %0, %1, %2" : "=v"(r) : "v"(lo), "v"(hi)); return r; }

template <class Epi, class Sched, int K, int lda, int ldb, bool ALIGN_EPI = true, bool SP2 = true>
__device__ __forceinline__ void gemm_phase(PG8_LAS unsigned char* lds, const Sched& S, const Epi& E, const int wave_sgpr) {
    int wid_l = wave_sgpr; asm volatile("" : "+s"(wid_l));
    const int wid = wid_l, lane = lane_id_asm(), tid = wid * 64 + lane, wr = wid >> 2, wc = wid & 3, fr = lane & 15, fq = lane >> 4;
    const int nt = K / BK;
    unsigned voffA[2], voffB[2];
#pragma unroll
    for (int i = 0; i < 2; ++i) { int R, C; stage_rc(tid * 16 + i * 8192, R, C); const int Rb = Epi::PERM ? ((R & ~31) + perm32(R & 31)) : R;
        voffA[i] = (unsigned)(R * lda + C) * 2u; voffB[i] = (unsigned)(Rb * ldb + C) * 2u; }
    const size_t kstep = (size_t)(BK * 2);
    const size_t hstepA = (size_t)HALF * lda * 2, hstepB = (size_t)HALF * ldb * 2;
    const unsigned ldsw = (unsigned)wid * 1024u;
    const int aoff = lds_byte(wr * 64 + fr, fq * 8), boff = lds_byte(wc * 32 + fr, fq * 8);
#define PG8_SA(b, h) (((b) * 2 + (h)) * HTB)
#define PG8_SB(b, h) ((4 + (b) * 2 + (h)) * HTB)
#define PG8_STAGE(bufoff, gbase, voff) do { _Pragma("unroll") for (int _i = 0; _i < 2; ++_i) \
        __builtin_amdgcn_global_load_lds((const unsigned*)((const char*)(gbase) + (voff)[_i]), (PG8_LAS unsigned*)(lds + (bufoff) + ldsw + _i * 8192), 16, 0, 0); } while (0)
#define PG8_LDA(dst, b, h) do { _Pragma("unroll") for (int m = 0; m < 4; ++m) _Pragma("unroll") for (int k = 0; k < 2; ++k) dst[m][k] = *(const PG8_LAS bf16x8*)(lds + PG8_SA(b, h) + aoff + m * 2048 + k * 1024); } while (0)
#define PG8_LDB(dst, b, h) do { _Pragma("unroll") for (int n = 0; n < 2; ++n) _Pragma("unroll") for (int k = 0; k < 2; ++k) dst[n][k] = *(const PG8_LAS bf16x8*)(lds + PG8_SB(b, h) + boff + n * 2048 + k * 1024); } while (0)
#define PG8_MMA(ai, bj, At, Bt) do { __builtin_amdgcn_s_setprio(1); _Pragma("unroll") for (int m = 0; m < 4; ++m) _Pragma("unroll") for (int n = 0; n < 2; ++n) _Pragma("unroll") for (int k = 0; k < 2; ++k) \
        acc[ai][bj][m][n] = __builtin_amdgcn_mfma_f32_16x16x32_bf16(Bt[n][k], At[m][k], acc[ai][bj][m][n], 0, 0, 0); __builtin_amdgcn_s_setprio(0); } while (0)
#define PG8_WAIT_V(n) asm volatile("s_waitcnt vmcnt(" #n ")" ::: "memory")
#define PG8_WAIT_L(n) asm volatile("s_waitcnt lgkmcnt(" #n ")" ::: "memory")
#define PG8_BAR __builtin_amdgcn_s_barrier()
#define PG8_SCHED __builtin_amdgcn_sched_barrier(0)
    Unit cur, nxt; int ui = 0;
    if (!S.next(0, cur)) return;
    f32x4 acc[2][2][4][2];
#pragma unroll
    for (int a = 0; a < 2; ++a)
#pragma unroll
        for (int b = 0; b < 2; ++b)
#pragma unroll
            for (int m = 0; m < 4; ++m)
#pragma unroll
                for (int n = 0; n < 2; ++n) acc[a][b][m][n] = (f32x4){0.f, 0.f, 0.f, 0.f};
    bf16x8 At[4][2], B0[2][2], B1[2][2];
    const char* cA = cur.A; const char* cB = cur.B;
    if constexpr (SP2) {
        PG8_STAGE(PG8_SB(0, 0), cB, voffB); PG8_STAGE(PG8_SB(0, 1), cB + hstepB, voffB); PG8_STAGE(PG8_SA(0, 0), cA, voffA); PG8_STAGE(PG8_SA(0, 1), cA + hstepA, voffA);
        if (wr == 1) PG8_BAR;
        PG8_WAIT_V(2); PG8_BAR;
        PG8_STAGE(PG8_SB(1, 0), cB + kstep, voffB); PG8_STAGE(PG8_SA(1, 0), cA + kstep, voffA); PG8_STAGE(PG8_SB(1, 1), cB + hstepB + kstep, voffB);
        PG8_WAIT_V(6); PG8_BAR;
    } else {
        PG8_STAGE(PG8_SB(0, 0), cB, voffB); PG8_STAGE(PG8_SA(0, 0), cA, voffA); PG8_STAGE(PG8_SB(0, 1), cB + hstepB, voffB); PG8_STAGE(PG8_SA(0, 1), cA + hstepA, voffA);
        if (wr == 1) PG8_BAR;
        PG8_WAIT_V(4); PG8_BAR;
        PG8_STAGE(PG8_SB(1, 0), cB + kstep, voffB); PG8_STAGE(PG8_SA(1, 0), cA + kstep, voffA); PG8_STAGE(PG8_SB(1, 1), cB + hstepB + kstep, voffB);
        PG8_WAIT_V(6); PG8_BAR;
    }
    for (;;) {
        const bool has_next = S.next(ui + 1, nxt);
        const char* nA = has_next ? nxt.A : cA; const char* nB = has_next ? nxt.B : cB;
        for (int t = 0; t < nt; t += 2) {
            const bool last = (t == nt - 2);
            const char* a1 = cA + (size_t)(t + 1) * kstep;
            const char* a2 = last ? nA : cA + (size_t)(t + 2) * kstep; const char* b2 = last ? nB : cB + (size_t)(t + 2) * kstep;
            const char* a3 = a2 + kstep; const char* b3 = b2 + kstep;
            if constexpr (SP2) {
            PG8_LDB(B0, 0, 0); PG8_LDB(B1, 0, 1); PG8_SCHED; PG8_LDA(At, 0, 0); PG8_STAGE(PG8_SA(1, 1), a1 + hstepA, voffA);
            PG8_WAIT_V(8); PG8_WAIT_L(0); PG8_BAR; PG8_MMA(0, 0, At, B0); PG8_MMA(0, 1, At, B1); PG8_BAR; PG8_SCHED;
            PG8_LDA(At, 0, 1); PG8_STAGE(PG8_SB(0, 0), b2, voffB); PG8_STAGE(PG8_SB(0, 1), b2 + hstepB, voffB); PG8_STAGE(PG8_SA(0, 0), a2, voffA);
            PG8_WAIT_V(8); PG8_WAIT_L(0); PG8_BAR; PG8_MMA(1, 0, At, B0); PG8_MMA(1, 1, At, B1); PG8_BAR; PG8_SCHED;
            PG8_LDB(B0, 1, 0); PG8_LDB(B1, 1, 1); PG8_SCHED; PG8_LDA(At, 1, 0); PG8_STAGE(PG8_SA(0, 1), a2 + hstepA, voffA);
            PG8_WAIT_V(8); PG8_WAIT_L(0); PG8_BAR; PG8_MMA(0, 0, At, B0); PG8_MMA(0, 1, At, B1); PG8_BAR; PG8_SCHED;
            PG8_LDA(At, 1, 1); PG8_STAGE(PG8_SB(1, 0), b3, voffB); PG8_STAGE(PG8_SB(1, 1), b3 + hstepB, voffB); PG8_STAGE(PG8_SA(1, 0), a3, voffA);
            PG8_WAIT_V(8); PG8_WAIT_L(0); PG8_BAR; PG8_MMA(1, 0, At, B0); PG8_MMA(1, 1, At, B1); PG8_BAR; PG8_SCHED;
            } else {
            PG8_LDB(B0, 0, 0); PG8_SCHED; PG8_LDA(At, 0, 0); PG8_STAGE(PG8_SA(1, 1), a1 + hstepA, voffA);
            PG8_WAIT_L(8); PG8_BAR; PG8_WAIT_L(0); PG8_MMA(0, 0, At, B0); PG8_BAR; PG8_SCHED;
            PG8_LDB(B1, 0, 1); PG8_STAGE(PG8_SB(0, 0), b2, voffB);
            PG8_BAR; PG8_WAIT_L(0); PG8_MMA(0, 1, At, B1); PG8_BAR;
            PG8_LDA(At, 0, 1); PG8_STAGE(PG8_SA(0, 0), a2, voffA);
            PG8_BAR; PG8_WAIT_L(0); PG8_MMA(1, 0, At, B0); PG8_BAR; PG8_SCHED;
            PG8_STAGE(PG8_SB(0, 1), b2 + hstepB, voffB);
            PG8_WAIT_V(6); PG8_BAR; PG8_MMA(1, 1, At, B1); PG8_BAR;
            PG8_LDB(B0, 1, 0); PG8_SCHED; PG8_LDA(At, 1, 0); PG8_STAGE(PG8_SA(0, 1), a2 + hstepA, voffA);
            PG8_WAIT_L(8); PG8_BAR; PG8_WAIT_L(0); PG8_MMA(0, 0, At, B0); PG8_BAR; PG8_SCHED;
            PG8_LDB(B1, 1, 1); PG8_STAGE(PG8_SB(1, 0), b3, voffB);
            PG8_BAR; PG8_WAIT_L(0); PG8_MMA(0, 1, At, B1); PG8_BAR;
            PG8_LDA(At, 1, 1); PG8_STAGE(PG8_SA(1, 0), a3, voffA);
            PG8_BAR; PG8_WAIT_L(0); PG8_MMA(1, 0, At, B0); PG8_BAR; PG8_SCHED;
            PG8_STAGE(PG8_SB(1, 1), b3 + hstepB, voffB);
            PG8_WAIT_V(6); PG8_BAR; PG8_MMA(1, 1, At, B1); PG8_BAR;
            }
        }
        if constexpr (ALIGN_EPI) { if (wr == 0) PG8_BAR; }
        { const int l2 = lane_id_asm(); E(acc, cur, wr, wc, l2 & 15, l2 >> 4); }
        if constexpr (false) { E(acc, cur, wr, wc, fr, fq); }
        if (!has_next) break;
#pragma unroll
        for (int a = 0; a < 2; ++a)
#pragma unroll
            for (int b = 0; b < 2; ++b)
#pragma unroll
                for (int m = 0; m < 4; ++m)
#pragma unroll
                    for (int n = 0; n < 2; ++n) acc[a][b][m][n] = (f32x4){0.f, 0.f, 0.f, 0.f};
        cur = nxt; cA = nA; cB = nB; ++ui;
        if constexpr (ALIGN_EPI) { if (wr == 1) PG8_BAR; }
    }
    PG8_WAIT_V(0);
    if constexpr (!ALIGN_EPI) { if (wr == 0) PG8_BAR; }
    PG8_BAR;
    #undef PG8_SA
#undef PG8_SB
#undef PG8_STAGE
#undef PG8_LDA
#undef PG8_LDB
#undef PG8_MMA
#undef PG8_WAIT_V
#undef PG8_WAIT_L
#undef PG8_BAR
#undef PG8_SCHED
}

#define PG8_GAS __attribute__((address_space(1)))
__device__ __forceinline__ float silu_f(float g) { return g * __builtin_amdgcn_rcpf(1.0f + __builtin_amdgcn_exp2f(-1.44269504f * g)); }
struct EpiSwiGLU { static constexpr bool PERM = true, AFTER_DRAIN = false; bf16_t* O; long long ldc; long long skip;
    __device__ __forceinline__ void operator()(const f32x4 (&acc)[2][2][4][2], const Unit& u, int wr, int wc, int fr, int fq) const {
        if (skip) return;
        const int row0 = u.pm * BM + wr * 64 + fr, col0 = u.pn * HALF + wc * 32 + 8 * fq;
#pragma unroll
        for (int ai = 0; ai < 2; ++ai)
#pragma unroll
            for (int m = 0; m < 4; ++m) { bf16_t* rowp = O + (size_t)(row0 + ai * HALF + m * 16) * ldc + col0;
                const f32x4 g0 = acc[ai][0][m][0], g1 = acc[ai][0][m][1], u0 = acc[ai][1][m][0], u1 = acc[ai][1][m][1];
                u32x4 w; w.x = cvt_pk_bf16(silu_f(g0[0]) * u0[0], silu_f(g0[1]) * u0[1]); w.y = cvt_pk_bf16(silu_f(g0[2]) * u0[2], silu_f(g0[3]) * u0[3]);
                w.z = cvt_pk_bf16(silu_f(g1[0]) * u1[0], silu_f(g1[1]) * u1[1]); w.w = cvt_pk_bf16(silu_f(g1[2]) * u1[2], silu_f(g1[3]) * u1[3]);
                *(PG8_GAS u32x4*)rowp = w; }
    }
};
struct EpiBf16 { static constexpr bool PERM = true, AFTER_DRAIN = false; bf16_t* O; long long ldc; const float* rs; float scale; int coff;
    __device__ __forceinline__ void operator()(const f32x4 (&acc)[2][2][4][2], const Unit& u, int wr, int wc, int fr, int fq) const {
        const int row0 = u.pm * BM + wr * 64 + fr, col0 = coff + u.pn * BM + wc * 32 + 8 * fq;
#pragma unroll
        for (int ai = 0; ai < 2; ++ai)
#pragma unroll
            for (int m = 0; m < 4; ++m) { const int row = row0 + ai * HALF + m * 16; bf16_t* rowp = O + (size_t)row * ldc + col0; const float s = rs ? *(const PG8_GAS float*)(rs + row) : scale;
#pragma unroll
                for (int bj = 0; bj < 2; ++bj) { const f32x4 v0 = acc[ai][bj][m][0] * s, v1 = acc[ai][bj][m][1] * s;
                    u32x4 w; w.x = cvt_pk_bf16(v0[0], v0[1]); w.y = cvt_pk_bf16(v0[2], v0[3]); w.z = cvt_pk_bf16(v1[0], v1[1]); w.w = cvt_pk_bf16(v1[2], v1[3]);
                    *(PG8_GAS u32x4*)(rowp + bj * HALF) = w; } }
    }
};
struct EpiResid { static constexpr bool PERM = false, AFTER_DRAIN = false; float* X; const float* g;
    __device__ __forceinline__ void operator()(const f32x4 (&acc)[2][2][4][2], const Unit& u, int wr, int wc, int fr, int fq) const {
        const int row0 = u.pm * BM + wr * 64 + fr, col0 = u.pn * BM + wc * 32 + 4 * fq;
        const float* gp = g + (size_t)((u.pm * BM) >> 13) * 6144 + col0;
        f32x4 gv[2][2];
#pragma unroll
        for (int bj = 0; bj < 2; ++bj)
#pragma unroll
            for (int n = 0; n < 2; ++n) gv[bj][n] = *(const PG8_GAS f32x4*)(gp + bj * HALF + n * 16);
#pragma unroll
        for (int ai = 0; ai < 2; ++ai)
#pragma unroll
            for (int m = 0; m < 4; ++m) { float* rowp = X + (size_t)(row0 + ai * HALF + m * 16) * 1024 + col0;
#pragma unroll
                for (int bj = 0; bj < 2; ++bj)
#pragma unroll
                    for (int n = 0; n < 2; ++n) { PG8_GAS f32x4* p = (PG8_GAS f32x4*)(rowp + bj * HALF + n * 16); *p = *p + gv[bj][n] * acc[ai][bj][m][n]; } }
    }
};
struct EpiResidB { static constexpr bool PERM = true, AFTER_DRAIN = false; bf16_t* X; const float* g;
    __device__ __forceinline__ void operator()(const f32x4 (&acc)[2][2][4][2], const Unit& u, int wr, int wc, int fr, int fq) const {
        const int row0 = u.pm * BM + wr * 64 + fr, col0 = u.pn * BM + wc * 32 + 8 * fq;
        const float* gp = g + (size_t)((u.pm * BM) >> 13) * 6144 + col0;
        f32x4 gv[2][2];
#pragma unroll
        for (int bj = 0; bj < 2; ++bj)
#pragma unroll
            for (int n = 0; n < 2; ++n) gv[bj][n] = *(const PG8_GAS f32x4*)(gp + bj * HALF + n * 4);
#pragma unroll
        for (int ai = 0; ai < 2; ++ai)
#pragma unroll
            for (int m = 0; m < 4; ++m) { bf16_t* rowp = X + (size_t)(row0 + ai * HALF + m * 16) * 1024 + col0;
#pragma unroll
                for (int bj = 0; bj < 2; ++bj) { PG8_GAS u32x4* p = (PG8_GAS u32x4*)(rowp + bj * HALF); const u32x4 xo = *p;
                    const f32x4 a0 = acc[ai][bj][m][0] * gv[bj][0], a1 = acc[ai][bj][m][1] * gv[bj][1];
                    u32x4 w; w.x = cvt_pk_bf16(__builtin_bit_cast(float, xo.x << 16) + a0[0], __builtin_bit_cast(float, xo.x & 0xffff0000u) + a0[1]);
                    w.y = cvt_pk_bf16(__builtin_bit_cast(float, xo.y << 16) + a0[2], __builtin_bit_cast(float, xo.y & 0xffff0000u) + a0[3]);
                    w.z = cvt_pk_bf16(__builtin_bit_cast(float, xo.z << 16) + a1[0], __builtin_bit_cast(float, xo.z & 0xffff0000u) + a1[1]);
                    w.w = cvt_pk_bf16(__builtin_bit_cast(float, xo.w << 16) + a1[2], __builtin_bit_cast(float, xo.w & 0xffff0000u) + a1[3]);
                    *p = w; } }
    }
};
struct EpiF32 { static constexpr bool PERM = false, AFTER_DRAIN = false; float* C; long long ldc;
    __device__ __forceinline__ void operator()(const f32x4 (&acc)[2][2][4][2], const Unit& u, int wr, int wc, int fr, int fq) const {
        const int row0 = u.pm * BM + wr * 64 + fr, col0 = u.pn * BM + wc * 32 + 4 * fq;
#pragma unroll
        for (int ai = 0; ai < 2; ++ai)
#pragma unroll
            for (int m = 0; m < 4; ++m) { float* rowp = C + (size_t)(row0 + ai * HALF + m * 16) * ldc + col0;
#pragma unroll
                for (int bj = 0; bj < 2; ++bj)
#pragma unroll
                    for (int n = 0; n < 2; ++n) *(PG8_GAS f32x4*)(rowp + bj * HALF + n * 16) = acc[ai][bj][m][n]; }
    }
};
struct SchedPlain { const char* A; const char* B; size_t a_tile, b_tile; int nM, nN, G, c, wgm, pad;
    __device__ __forceinline__ bool next(int i, Unit& u) const { int tm, tn; if (!tile_of(i, G, c, nM, nN, wgm, tm, tn)) return false;
        u.pm = tm; u.pn = tn; u.A = A + (size_t)tm * a_tile; u.B = B + (size_t)tn * b_tile; return true; } };
struct SchedMoE { const char* A; const char* B; size_t a_tile, b_tile; int nN, G, c, i0, cnt, pad;
    __device__ __forceinline__ bool next(int i, Unit& u) const { int tm, tn; if (i >= cnt || !tile_of(i + i0, G, c, 128, nN, (nN == 16) ? MOE_WGM_MD : MOE_WGM_ME, tm, tn)) return false;
        const int e = tm >> 3, b = (tm >> 2) & 1, r = tm & 3, pm = ((b * 16 + e) << 2) + r;
        u.pm = pm; u.pn = tn; u.A = A + (size_t)pm * a_tile; u.B = B + (size_t)(e * nN + tn) * b_tile; if (pad) { u.A = A; u.B = B; } return true; } };
}

constexpr int D = 1024, NB = 2, S = 8192, DEPTH = 4, T = NB * S;
constexpr int NG = 4, GD = 256, HD = 64, NH = 16, NKV = 4, WIN = 128, NE = 16, CAP = 1024, DE = 2048, QKVN = 1536;
constexpr float EPS = 1e-6f;
constexpr int NWAVES = 8, NTHR = 512;

constexpr size_t MiB = 1u << 20;
constexpr size_t WS_CTL = 0, CTL_ZERO_BYTES = 32768;
constexpr size_t WS_MOD = 1 * MiB;
constexpr size_t WS_TAB = 2 * MiB;
constexpr size_t WS_MBT = 4 * MiB;
constexpr size_t WS_WQKV = 8 * MiB;
constexpr size_t WS_WAO = 14 * MiB;
constexpr size_t WS_WFO = 18 * MiB;
constexpr size_t WS_WFF = 22 * MiB;
constexpr size_t WS_CS = 30 * MiB;
constexpr size_t WS_AFF = 32 * MiB;
constexpr size_t WS_IDX = 33 * MiB;
constexpr size_t WS_GATE = 33 * MiB + 512 * 1024;
constexpr size_t WS_SLOT = 34 * MiB;
constexpr size_t WS_MISC = 35 * MiB;
constexpr size_t WS_PAR = 36 * MiB;
constexpr int PAR_NMIX = 0, PAR_NFFN = 4096, PAR_QG = 8192, PAR_KG = 8192 + 128, PAR_SINK = 8192 + 256, PAR_WR = 16384;
constexpr size_t WS_H = 64 * MiB;
constexpr size_t WS_XIN = 96 * MiB;
constexpr size_t WS_ACT = 160 * MiB;
constexpr size_t WS_Y = 288 * MiB;
constexpr size_t WS_QKV = 352 * MiB;
constexpr size_t WS_O = 400 * MiB;
constexpr size_t WS_TA = 432 * MiB;
constexpr size_t WS_YF = 464 * MiB;
constexpr size_t WS_PQ = 496 * MiB;
constexpr size_t WS_W1 = 576 * MiB;
constexpr size_t WS_W2 = 1088 * MiB;
constexpr size_t WS_GOLD = 1344 * MiB;
constexpr size_t WS_XB = 1600 * MiB;
constexpr size_t WS_END = 1792 * MiB;
constexpr int CW_BAR = 4096;

constexpr int RING_BYTES = 133120;
constexpr int MISC_OFF = RING_BYTES;
constexpr int LDS_BYTES = 147456;

#define GAS __attribute__((address_space(1)))
#define LAS __attribute__((address_space(3)))
typedef unsigned short bf16;
typedef unsigned v4u __attribute__((ext_vector_type(4)));
typedef unsigned v2u __attribute__((ext_vector_type(2)));
typedef float f32x4 __attribute__((ext_vector_type(4)));
typedef short bf16x8 __attribute__((ext_vector_type(8)));
#define LDS_WAIT() asm volatile("s_waitcnt lgkmcnt(0)" ::: "memory")
#define VM_WAIT() asm volatile("s_waitcnt vmcnt(0)" ::: "memory")
__device__ __forceinline__ unsigned f2bf(float f) { unsigned u = __builtin_bit_cast(unsigned, f); return (u + 0x7fffu + ((u >> 16) & 1u)) >> 16; }
typedef __bf16 bf16x2_t __attribute__((ext_vector_type(2)));
typedef float f32x2_t __attribute__((ext_vector_type(2)));
__device__ __forceinline__ unsigned pk2(float lo, float hi) { const f32x2_t v = {lo, hi}; return __builtin_bit_cast(unsigned, __builtin_convertvector(v, bf16x2_t)); }
__device__ __forceinline__ float bf_lo(unsigned w) { return __builtin_bit_cast(float, w << 16); }
__device__ __forceinline__ float bf_hi(unsigned w) { return __builtin_bit_cast(float, w & 0xffff0000u); }
__device__ __forceinline__ float shx(float v, int o, int lane) { return __builtin_bit_cast(float, __builtin_amdgcn_ds_bpermute((lane ^ o) << 2, __builtin_bit_cast(int, v))); }
__device__ __forceinline__ unsigned shl_from(unsigned v, int src_lane) { return (unsigned)__builtin_amdgcn_ds_bpermute((src_lane & 63) << 2, (int)v); }
__device__ __forceinline__ float wave_sum(float v, int lane) {
#pragma unroll
    for (int o = 1; o < 64; o <<= 1) v += shx(v, o, lane);
    return v;
}

#define XB_TMO      128
#define XB_MISMAP   192
#define XB_XCNT(j)  (256  + 64 * (j))
#define XB_XSUB(j)  (1280 + 64 * (j))
#define XB_XGEN(j)  (2304 + 64 * (j))
#define XB_TOP      3328
#define XB_TOPGEN   3392
#define XCD_BAR_WORDS 3456
#define XB_SPIN_CAP (1u << 18)

__device__ __forceinline__ unsigned xb_ld(unsigned* p)              { return __hip_atomic_load(p, __ATOMIC_RELAXED, __HIP_MEMORY_SCOPE_AGENT); }
__device__ __forceinline__ unsigned xb_add(unsigned* p, unsigned v) { return __hip_atomic_fetch_add(p, v, __ATOMIC_RELAXED, __HIP_MEMORY_SCOPE_AGENT); }
__device__ __forceinline__ unsigned xb_xcc_id() { return (unsigned)__builtin_amdgcn_s_getreg((3 << 11) | 20) & 0xFu; }
#define XB_SPIN(cond, bar) do { unsigned _sp = 0; while (cond) { __builtin_amdgcn_s_sleep(1); \
    if ((++_sp & 255u) == 0u) { if (xb_ld(&(bar)[XB_TMO])) break; if (_sp > XB_SPIN_CAP) { atomicAdd(&(bar)[XB_TMO], 1u); break; } } } } while (0)

struct XcdBarrier {
    unsigned* bar; unsigned x;
    volatile LAS unsigned* st;
};

__device__ __forceinline__ XcdBarrier xcd_barrier_post(unsigned* bar, volatile LAS unsigned* st) {
    XcdBarrier b; b.bar = bar; b.x = xb_xcc_id(); b.st = st;
    if (threadIdx.x == 0) (void)xb_add(&bar[XB_XCNT(b.x)], 1u);
    return b;
}
__device__ __forceinline__ void xcd_barrier_complete(unsigned* bar, unsigned x, unsigned& nloc, unsigned& nx) {
    const unsigned G = gridDim.x * gridDim.y * gridDim.z;
    unsigned sum, cnt, mine, sp = 0u;
    for (;;) {
        sum = 0u; cnt = 0u; mine = 0u;
#pragma unroll
        for (unsigned j = 0; j < 16; ++j) { const unsigned c = xb_ld(&bar[XB_XCNT(j)]); sum += c; cnt += (c > 0u) ? 1u : 0u; mine = (j == x) ? c : mine; }
        if (sum == G) break;
        __builtin_amdgcn_s_sleep(1);
        if ((++sp & 255u) == 0u) { if (xb_ld(&bar[XB_TMO])) break; if (sp > XB_SPIN_CAP) { atomicAdd(&bar[XB_TMO], 1u); break; } }
    }
    nloc = mine > 0u ? mine : 1u; nx = cnt > 0u ? cnt : 1u;
}

__device__ __forceinline__ void xcd_barrier(const XcdBarrier& b, const bool local = false) {
    asm volatile("s_waitcnt vmcnt(0)" ::: "memory");
    __syncthreads();
    if (threadIdx.x == 0) {
        unsigned* bar = b.bar;
        __builtin_amdgcn_s_waitcnt(0);
        unsigned nloc = b.st[0], nx = b.st[1];
        if (nloc == 0u) { xcd_barrier_complete(bar, b.x, nloc, nx); b.st[0] = nloc; b.st[1] = nx; }
        const unsigned old = xb_add(&bar[XB_XSUB(b.x)], 1u);
        const unsigned gen = old / nloc;
        if (old + 1u == (gen + 1u) * nloc) {
            if (!local) {
            __builtin_amdgcn_fence(__ATOMIC_RELEASE, "agent");
            asm volatile("s_waitcnt vmcnt(0)" ::: "memory");
            const unsigned og = xb_add(&bar[XB_TOP], 1u);
            const unsigned tg = og / nx;
            if (og + 1u == (tg + 1u) * nx) xb_add(&bar[XB_TOPGEN], 1u);
            else XB_SPIN(xb_ld(&bar[XB_TOPGEN]) == tg, bar);
            }
            __builtin_amdgcn_fence(__ATOMIC_ACQUIRE, "agent");
            xb_add(&bar[XB_XGEN(b.x)], 1u);
            asm volatile("s_waitcnt vmcnt(0)" ::: "memory");
        } else {
            XB_SPIN(xb_ld(&bar[XB_XGEN(b.x)]) == gen, bar);
            __builtin_amdgcn_fence(__ATOMIC_ACQUIRE, "agent");
            asm volatile("s_waitcnt vmcnt(0)" ::: "memory");
        }
    }
    __syncthreads();
}


struct Params { const float* in[17]; float* out; unsigned char* ws; int ph_lo, ph_hi; };
enum { IN_X = 0, IN_C, IN_WADA, IN_BADA, IN_NMIX, IN_NFFN, IN_WFO, IN_WQKV, IN_WAO, IN_QG, IN_KG, IN_SINK, IN_RELB, IN_WR, IN_WG, IN_WU, IN_WD };
struct Frame { LAS unsigned char* lds; int tid, lane, wave, vcu, G; };

struct CvtItem { const float* src; bf16* dst; int N, ldk; };
__device__ __forceinline__ void cvt_load(const CvtItem& it, f32x4 (&v)[16], int lane) {
    const int kr = lane >> 4, nc = (lane & 15) * 4;
#pragma unroll
    for (int i = 0; i < 16; ++i) v[i] = __builtin_nontemporal_load((const GAS f32x4*)(it.src + (size_t)(4 * i + kr) * it.N + nc));
}
__device__ __forceinline__ void cvt_store(const CvtItem& it, const f32x4 (&v)[16], LAS float* scr, int lane) {
    const int kr = lane >> 4, nc = (lane & 15) * 4;
#pragma unroll
    for (int i = 0; i < 16; ++i) { LAS float* p = scr + (4 * i + kr) * 65 + nc; p[0] = v[i].x; p[1] = v[i].y; p[2] = v[i].z; p[3] = v[i].w; }
    LDS_WAIT(); asm volatile("" ::: "memory");
    const int c = lane & 7;
#pragma unroll
    for (int j = 0; j < 8; ++j) { const int n = (lane >> 3) + 8 * j; const LAS float* s = scr + (8 * c) * 65 + n;
        v4u o; o.x = pk2(s[0 * 65], s[1 * 65]); o.y = pk2(s[2 * 65], s[3 * 65]); o.z = pk2(s[4 * 65], s[5 * 65]); o.w = pk2(s[6 * 65], s[7 * 65]);
        __builtin_nontemporal_store(o, (GAS v4u*)(it.dst + (size_t)n * it.ldk + 8 * c)); }
    LDS_WAIT(); asm volatile("" ::: "memory");
}

__device__ __forceinline__ CvtItem moe_item(const Params& p, int l, int it) {
    bf16* W1 = (bf16*)(p.ws + WS_W1) + (size_t)l * NE * 4096 * 1024; bf16* W2 = (bf16*)(p.ws + WS_W2) + (size_t)l * NE * 1024 * 2048;
    const int kind = it >> 13, r = it & 8191; CvtItem ci;
    if (kind < 2) { const int e = r >> 9, kt = (r >> 5) & 15, ntile = r & 31; const int n0 = ntile * 64, k0 = kt * 64;
        ci.src = (kind ? p.in[IN_WU] : p.in[IN_WG]) + (size_t)l * NE * D * DE + (size_t)e * D * DE + (size_t)k0 * DE + n0; ci.N = DE;
        ci.dst = W1 + ((size_t)e * 4096 + (size_t)(n0 >> 7) * 256 + kind * 128 + (n0 & 127)) * 1024 + k0; ci.ldk = 1024;
    } else { const int e = r >> 9, kt = (r >> 4) & 31, ntile = r & 15; const int n0 = ntile * 64, k0 = kt * 64;
        ci.src = p.in[IN_WD] + (size_t)l * NE * DE * D + (size_t)e * DE * D + (size_t)k0 * D + n0; ci.N = D;
        ci.dst = W2 + ((size_t)e * 1024 + n0) * 2048 + k0; ci.ldk = 2048; }
    return ci;
}
__device__ __forceinline__ void cvt_moe_layer(const Params& p, Frame& F, int l, int w0, int nw, int iend) {
    LAS float* scr = (LAS float*)(F.lds + F.wave * 16640);
    if (w0 >= iend) return;
    f32x4 va[16], vb[16];
    CvtItem ca = moe_item(p, l, w0), cb = ca; cvt_load(ca, va, F.lane);
    for (int it = w0; it < iend; it += 2 * nw) {
        const bool hb = it + nw < iend;
        if (hb) { cb = moe_item(p, l, it + nw); cvt_load(cb, vb, F.lane); }
        cvt_store(ca, va, scr, F.lane);
        const bool ha = it + 2 * nw < iend;
        if (ha) { ca = moe_item(p, l, it + 2 * nw); cvt_load(ca, va, F.lane); }
        if (hb) cvt_store(cb, vb, scr, F.lane);
    }
}

__device__ __forceinline__ void phase_ma(const Params& p, Frame& F, int l, const bool fd, const float* xin32) {
    LAS float* wrp = (LAS float*)F.lds;
    const float* wr = (const float*)(p.ws + WS_PAR) + PAR_WR + (size_t)l * D * NE;
    for (int s = F.tid; s < D * NE; s += NTHR) { const int c = s >> 4, e = s & 15; wrp[(((e * 4 + (c >> 8)) * 4 + (c & 3)) << 6) + ((c & 255) >> 2)] = wr[s]; }
    __syncthreads();
    const float* mod = (const float*)(p.ws + WS_MOD) + (size_t)l * NB * 6 * D;
    const float* gain = (const float*)(p.ws + WS_PAR) + PAR_NFFN + l * D;
    const int gw = F.vcu * NWAVES + F.wave, NGW = F.G * NWAVES;
    const int b = (gw * 2) / NGW, wsub = gw - b * (NGW / 2), nsub = NGW / 2;
    f32x4 Av[4], Bv[4];
#pragma unroll
    for (int j = 0; j < 4; ++j) { const int c = 256 * j + 4 * F.lane; const f32x4 g = *(const f32x4*)(gain + c), sc = *(const f32x4*)(mod + b * 6 * D + 4 * D + c);
        Av[j] = g * (sc + 1.0f); Bv[j] = *(const f32x4*)(mod + b * 6 * D + 3 * D + c); }
    bf16* xb = (bf16*)(p.ws + WS_XB); bf16* H = (bf16*)(p.ws + WS_H); float* aff = (float*)(p.ws + WS_AFF);
    const bf16* PQ = (const bf16*)(p.ws + WS_PQ); const float* y4096 = (const float*)(p.ws + WS_MISC);
    f32x4 G1[4];
#pragma unroll
    for (int j = 0; j < 4; ++j) G1[j] = fd ? *(const f32x4*)(mod + b * 6 * D + 2 * D + 256 * j + 4 * F.lane) : (f32x4){0.f, 0.f, 0.f, 0.f};
    const bool xmap = (nsub == 1024);
    const int rb0 = xmap ? ((wsub >> 8) << 11) + (wsub & 255) : wsub, rstep = xmap ? 256 : nsub;
    for (int s0 = rb0; s0 < (xmap ? rb0 + 8 * rstep : S); s0 += 4 * rstep) {
        asm volatile("" ::: "memory");
        f32x4 h[4][4]; float rs[4];
#pragma unroll
        for (int r = 0; r < 4; ++r) { const int row = b * S + s0 + r * rstep; float ss = 0.f;
            if (fd) { const int k = s0 + r * rstep, m = k & 63, qd = k >> 6; int rr; float sg = 1.0f; bool special = false;
                if (m >= 1 && m <= 31) { rr = m * 128 + qd; }
                else if (m >= 33) { const int kp = S - k; rr = (kp & 63) * 128 + (kp >> 6); sg = -1.0f; }
                else if (m == 0) { if (qd <= 63) rr = qd; else if (qd == 64) { rr = 0; special = true; } else { rr = 128 - qd; sg = -1.0f; } }
                else { if (qd <= 63) rr = 64 + qd; else { rr = 64 + (127 - qd); sg = -1.0f; } }
                const bf16* P = PQ + ((size_t)(b * 4096 + rr)) * 2048;
#pragma unroll
                for (int j = 0; j < 4; ++j) { const int cc = 256 * j + 4 * F.lane; f32x4 y;
                    if (special) y = *(const f32x4*)(y4096 + b * 1024 + cc); else { const v2u pw = *(const GAS v2u*)(P + cc), qw = *(const GAS v2u*)(P + 1024 + cc);
                        y.x = bf_lo(pw.x) + sg * bf_lo(qw.x); y.y = bf_hi(pw.x) + sg * bf_hi(qw.x); y.z = bf_lo(pw.y) + sg * bf_lo(qw.y); y.w = bf_hi(pw.y) + sg * bf_hi(qw.y); }
                    f32x4 xo; if (xin32) xo = *(const GAS f32x4*)(xin32 + (size_t)row * D + cc); else { const v2u xw = *(const GAS v2u*)(xb + (size_t)row * D + cc); xo = (f32x4){bf_lo(xw.x), bf_hi(xw.x), bf_lo(xw.y), bf_hi(xw.y)}; }
                    const f32x4 xn = xo + G1[j] * y; v2u ow; ow.x = pk2(xn.x, xn.y); ow.y = pk2(xn.z, xn.w); *(GAS v2u*)(xb + (size_t)row * D + cc) = ow;
                    h[r][j] = (f32x4){bf_lo(ow.x), bf_hi(ow.x), bf_lo(ow.y), bf_hi(ow.y)}; } }
#pragma unroll
            for (int j = 0; j < 4; ++j) { if (!fd) { const v2u xw = *(const GAS v2u*)(xb + (size_t)row * D + 256 * j + 4 * F.lane); h[r][j] = (f32x4){bf_lo(xw.x), bf_hi(xw.x), bf_lo(xw.y), bf_hi(xw.y)}; } ss += (h[r][j].x * h[r][j].x + h[r][j].y * h[r][j].y) + (h[r][j].z * h[r][j].z + h[r][j].w * h[r][j].w); }
            rs[r] = ss; }
#pragma unroll
        for (int r = 0; r < 4; ++r) { const int row = b * S + s0 + r * rstep; const float rstd = rsqrtf(wave_sum(rs[r], F.lane) * (1.0f / D) + EPS);
#pragma unroll
            for (int j = 0; j < 4; ++j) { h[r][j] = h[r][j] * rstd * Av[j] + Bv[j];
                v2u o; o.x = pk2(h[r][j].x, h[r][j].y); o.y = pk2(h[r][j].z, h[r][j].w); *(GAS v2u*)(H + (size_t)row * D + 256 * j + 4 * F.lane) = o; } }
        float th2[4][2];
#pragma unroll
        for (int hh = 0; hh < 2; ++hh) {
            asm volatile("" ::: "memory");
            float v[4][8];
#pragma unroll
            for (int ei = 0; ei < 8; ++ei) { const int e = 8 * hh + ei; float a0 = 0.f, a1 = 0.f, a2 = 0.f, a3 = 0.f;
#pragma unroll
                for (int j = 0; j < 4; ++j) { const LAS float* w = wrp + (((e * 4 + j) * 4) << 6) + F.lane; const float w0 = w[0], w1 = w[64], w2 = w[128], w3 = w[192];
                    a0 += h[0][j].x * w0 + h[0][j].y * w1 + h[0][j].z * w2 + h[0][j].w * w3; a1 += h[1][j].x * w0 + h[1][j].y * w1 + h[1][j].z * w2 + h[1][j].w * w3;
                    a2 += h[2][j].x * w0 + h[2][j].y * w1 + h[2][j].z * w2 + h[2][j].w * w3; a3 += h[3][j].x * w0 + h[3][j].y * w1 + h[3][j].z * w2 + h[3][j].w * w3; }
                v[0][ei] = a0; v[1][ei] = a1; v[2][ei] = a2; v[3][ei] = a3; }
#pragma unroll
            for (int r = 0; r < 4; ++r) { float t4[4], t2[2];
                { const bool hi = (F.lane & 32) != 0;
#pragma unroll
                  for (int i = 0; i < 4; ++i) { const float send = hi ? v[r][i] : v[r][i + 4], keep = hi ? v[r][i + 4] : v[r][i]; t4[i] = keep + shx(send, 32, F.lane); } }
                { const bool hi = (F.lane & 16) != 0;
#pragma unroll
                  for (int i = 0; i < 2; ++i) { const float send = hi ? t4[i] : t4[i + 2], keep = hi ? t4[i + 2] : t4[i]; t2[i] = keep + shx(send, 16, F.lane); } }
                { const bool hi = (F.lane & 8) != 0; const float send = hi ? t2[0] : t2[1], keep = hi ? t2[1] : t2[0]; th2[r][hh] = keep + shx(send, 8, F.lane); } }
        }
#pragma unroll
        for (int r = 0; r < 4; ++r) { float t1;
            { const bool hi = (F.lane & 4) != 0; const float send = hi ? th2[r][0] : th2[r][1], keep = hi ? th2[r][1] : th2[r][0]; t1 = keep + shx(send, 4, F.lane); }
            t1 += shx(t1, 1, F.lane); t1 += shx(t1, 2, F.lane);
            float mx = t1;
#pragma unroll
            for (int o = 4; o < 64; o <<= 1) mx = fmaxf(mx, shx(mx, o, F.lane));
            const float pe = expf(t1 - mx); float sum = pe;
#pragma unroll
            for (int o = 4; o < 64; o <<= 1) sum += shx(sum, o, F.lane);
            const int e = ((F.lane >> 2) & 1) * 8 + ((F.lane >> 5) & 1) * 4 + ((F.lane >> 4) & 1) * 2 + ((F.lane >> 3) & 1);
            if ((F.lane & 3) == 0) aff[((size_t)b * NE + e) * S + s0 + r * rstep] = pe / sum; }
    }
}

__device__ __forceinline__ void phase_mbc(const Params& p, Frame& F) {
    LAS unsigned* hist = (LAS unsigned*)F.lds;
    LAS unsigned* ctl = hist + 8 * 256;
    LAS unsigned* wtot = ctl + 64;
    LAS int* sel = (LAS int*)(wtot + 64);
    const float* aff = (const float*)(p.ws + WS_AFF); float* gate = (float*)(p.ws + WS_GATE); int* slotmap = (int*)(p.ws + WS_SLOT);
    const bf16* H = (const bf16*)(p.ws + WS_H); bf16* X = (bf16*)(p.ws + WS_XIN);
    const int nsub = (F.G >= 8 * NB * NE) ? 8 : 1;
    for (int zz = F.vcu; zz < NB * NE * nsub; zz += F.G) {
        int z = zz / nsub, sub = zz - z * nsub;
        if (nsub == 8 && F.G == 256) { const int xg = zz >> 5, j = (zz >> 3) & 3; z = (j & 1) * 16 + 2 * xg + (j >> 1); sub = zz & 7; }
        unsigned key[16];
#pragma unroll
        for (int q = 0; q < 4; ++q) { const v4u k4 = *(const GAS v4u*)(aff + (size_t)z * S + F.tid * 16 + 4 * q); key[4 * q] = k4.x; key[4 * q + 1] = k4.y; key[4 * q + 2] = k4.z; key[4 * q + 3] = k4.w; }
        unsigned prefix = 0u, need = CAP;
#pragma unroll
        for (int pass = 0; pass < 4; ++pass) {
            const int shift = 24 - 8 * pass;
            __syncthreads();
            for (int i = F.tid; i < 8 * 256; i += NTHR) hist[i] = 0u;
            __syncthreads();
            LAS unsigned* myh = hist + F.wave * 256;
#pragma unroll
            for (int u = 0; u < 16; ++u) { const unsigned hi = (pass == 0) ? 0u : (key[u] >> ((shift + 8) & 31)); if (hi == prefix) atomicAdd((unsigned*)&myh[(key[u] >> shift) & 255u], 1u); }
            __syncthreads();
            if (F.wave == 0) {
                unsigned h0 = 0u, h1 = 0u, h2 = 0u, h3 = 0u;
#pragma unroll
                for (int w = 0; w < 8; ++w) { const LAS unsigned* hw = hist + w * 256 + 4 * F.lane; h0 += hw[0]; h1 += hw[1]; h2 += hw[2]; h3 += hw[3]; }
                const unsigned tot = h0 + h1 + h2 + h3; unsigned suf = tot;
#pragma unroll
                for (int o = 1; o < 64; o <<= 1) { const unsigned t = shl_from(suf, F.lane + o); if (F.lane + o < 64) suf += t; }
                unsigned cum = suf - tot;
                if (cum < need && need <= cum + tot) {
                    unsigned d = 4 * F.lane + 3, c = h3;
                    if (cum + c < need) { cum += c; d = 4 * F.lane + 2; c = h2;
                        if (cum + c < need) { cum += c; d = 4 * F.lane + 1; c = h1;
                            if (cum + c < need) { cum += c; d = 4 * F.lane; c = h0; } } }
                    ctl[0] = (prefix << 8) | d; ctl[1] = need - cum; }
            }
            __syncthreads();
            prefix = ctl[0]; need = ctl[1];
        }
        unsigned cnt = 0u;
#pragma unroll
        for (int u = 0; u < 16; ++u) cnt += (key[u] > prefix ? 1u : 0u) + (key[u] == prefix ? 65536u : 0u);
        unsigned inc = cnt;
#pragma unroll
        for (int o = 1; o < 64; o <<= 1) { const unsigned t = shl_from(inc, F.lane - o); if (F.lane >= o) inc += t; }
        if (F.lane == 63) wtot[F.wave] = inc;
        __syncthreads();
        unsigned base = inc - cnt;
        for (int w = 0; w < F.wave; ++w) base += wtot[w];
        unsigned ng = base & 0xffffu, ne = base >> 16;
#pragma unroll
        for (int u = 0; u < 16; ++u) { const int i = F.tid * 16 + u; const bool gt = key[u] > prefix, eq = key[u] == prefix; const bool selq = gt || (eq && ne < need);
            const int slot = (int)(ng + (ne < need ? ne : need));
            const bool mine = (nsub == 1) || ((u & (nsub - 1)) == sub);
            if (selq) { sel[slot] = i; if (mine) gate[z * CAP + slot] = __builtin_bit_cast(float, key[u]); }
            if (mine) slotmap[((size_t)(z >> 4) * S + i) * NE + (z & 15)] = selq ? slot : -1;
            ng += gt ? 1u : 0u; ne += eq ? 1u : 0u; }
        __syncthreads();
        const int per = CAP / nsub, b = z >> 4;
        for (int s = F.wave; s < per; s += NWAVES) { const int slot = sub * per + s; const int src = b * S + sel[slot];
            const GAS v4u* sp = (const GAS v4u*)(H + (size_t)src * D) + F.lane; GAS v4u* dp = (GAS v4u*)(X + ((size_t)z * CAP + slot) * D) + F.lane;
            const v4u a = sp[0], cc = sp[64]; dp[0] = a; dp[64] = cc; }
    }
}

__device__ __forceinline__ void phase_mf(const Params& p, Frame& F, int l, const bool dry) {
    const int* slotmap = (const int*)(p.ws + WS_SLOT); const bf16* Y = (const bf16*)(p.ws + WS_Y); bf16* xb = (bf16*)(p.ws + WS_XB); bf16* xbo = (bf16*)(p.ws + (dry ? WS_GOLD : WS_XB)); float* xo32 = dry ? (float*)(p.ws + WS_GOLD) : p.out; bf16* H = (bf16*)(p.ws + (dry ? WS_GOLD + 128 * MiB : WS_H));
    const float* mod = (const float*)(p.ws + WS_MOD) + (size_t)l * NB * 6 * D;
    const bool nxt = (l + 1 < DEPTH);
    const float* modn = mod + NB * 6 * D; const float* gainn = (const float*)(p.ws + WS_PAR) + PAR_NMIX + (l + 1) * D;
    const int gw = F.vcu * NWAVES + F.wave, NGW = F.G * NWAVES;
    const int b = (gw * 2) / NGW, wsub = gw - b * (NGW / 2), nsub = NGW / 2;
    const bool xmap = (nsub == 1024); const int rb0 = xmap ? ((wsub >> 8) << 11) + (wsub & 255) : wsub, rstep = xmap ? 256 : nsub;
    for (int s4 = rb0; s4 < (xmap ? rb0 + 8 * rstep : S); s4 += 4 * rstep) {
      const int slv = slotmap[((size_t)b * S + s4 + (F.lane >> 4) * rstep) * NE + (F.lane & 15)];
      const unsigned long long selmask = __builtin_amdgcn_ballot_w64(slv >= 0);
#pragma unroll
      for (int k = 0; k < 4; ++k) { const int s = s4 + k * rstep, row = b * S + s;
        unsigned m = (unsigned)(selmask >> (16 * k)) & 0xffffu;
        f32x4 xv[4];
#pragma unroll
        for (int j = 0; j < 2; ++j) { const v4u xw = *(const GAS v4u*)(xb + (size_t)row * D + 512 * j + 8 * F.lane);
            xv[2 * j] = (f32x4){bf_lo(xw.x), bf_hi(xw.x), bf_lo(xw.y), bf_hi(xw.y)}; xv[2 * j + 1] = (f32x4){bf_lo(xw.z), bf_hi(xw.z), bf_lo(xw.w), bf_hi(xw.w)}; }
        float acc[16];
#pragma unroll
        for (int i = 0; i < 16; ++i) acc[i] = 0.f;
        while (m) {
            int ex[4]; int cnt = 0;
#pragma unroll
            for (int j = 0; j < 4; ++j) { if (m) { ex[j] = __builtin_ctz(m); m &= m - 1u; cnt = j + 1; } else ex[j] = ex[0]; }
            v4u ya[4], yc[4];
#pragma unroll
            for (int j = 0; j < 4; ++j) { const int sj = __builtin_amdgcn_readlane(slv, k * 16 + ex[j]);
                const GAS v4u* yp = (const GAS v4u*)(Y + ((size_t)(b * NE + ex[j]) * CAP + sj) * D) + F.lane; ya[j] = yp[0]; yc[j] = yp[64]; }
#pragma unroll
            for (int j = 0; j < 4; ++j) if (j < cnt) { const v4u a = ya[j], c = yc[j];
                acc[0] += bf_lo(a.x); acc[1] += bf_hi(a.x); acc[2] += bf_lo(a.y); acc[3] += bf_hi(a.y); acc[4] += bf_lo(a.z); acc[5] += bf_hi(a.z); acc[6] += bf_lo(a.w); acc[7] += bf_hi(a.w);
                acc[8] += bf_lo(c.x); acc[9] += bf_hi(c.x); acc[10] += bf_lo(c.y); acc[11] += bf_hi(c.y); acc[12] += bf_lo(c.z); acc[13] += bf_hi(c.z); acc[14] += bf_lo(c.w); acc[15] += bf_hi(c.w); } }
        float ss = 0.f;
#pragma unroll
        for (int j = 0; j < 2; ++j) { const int c0 = 512 * j + 8 * F.lane; const f32x4* gp = (const f32x4*)(mod + b * 6 * D + 5 * D + c0);
            const f32x4 g0 = gp[0], g1 = gp[1]; f32x4 x0 = xv[2 * j], x1 = xv[2 * j + 1];
            x0.x += g0.x * acc[8 * j + 0]; x0.y += g0.y * acc[8 * j + 1]; x0.z += g0.z * acc[8 * j + 2]; x0.w += g0.w * acc[8 * j + 3];
            x1.x += g1.x * acc[8 * j + 4]; x1.y += g1.y * acc[8 * j + 5]; x1.z += g1.z * acc[8 * j + 6]; x1.w += g1.w * acc[8 * j + 7];
            if (nxt) { v4u ow; ow.x = pk2(x0.x, x0.y); ow.y = pk2(x0.z, x0.w); ow.z = pk2(x1.x, x1.y); ow.w = pk2(x1.z, x1.w); *(GAS v4u*)(xbo + (size_t)row * D + c0) = ow;
                x0 = (f32x4){bf_lo(ow.x), bf_hi(ow.x), bf_lo(ow.y), bf_hi(ow.y)}; x1 = (f32x4){bf_lo(ow.z), bf_hi(ow.z), bf_lo(ow.w), bf_hi(ow.w)}; }
            else { GAS f32x4* xp = (GAS f32x4*)(xo32 + (size_t)row * D + c0); xp[0] = x0; xp[1] = x1; }
            acc[8 * j + 0] = x0.x; acc[8 * j + 1] = x0.y; acc[8 * j + 2] = x0.z; acc[8 * j + 3] = x0.w; acc[8 * j + 4] = x1.x; acc[8 * j + 5] = x1.y; acc[8 * j + 6] = x1.z; acc[8 * j + 7] = x1.w;
            ss += (x0.x * x0.x + x0.y * x0.y) + (x0.z * x0.z + x0.w * x0.w) + (x1.x * x1.x + x1.y * x1.y) + (x1.z * x1.z + x1.w * x1.w); }
        if (nxt) { const float rstd = rsqrtf(wave_sum(ss, F.lane) * (1.0f / D) + EPS);
#pragma unroll
            for (int j = 0; j < 2; ++j) { const int c0 = 512 * j + 8 * F.lane; v4u o; float hv[8];
#pragma unroll
                for (int i = 0; i < 8; ++i) hv[i] = acc[8 * j + i] * rstd * gainn[c0 + i] * (1.0f + modn[b * 6 * D + 1 * D + c0 + i]) + modn[b * 6 * D + c0 + i];
                o.x = pk2(hv[0], hv[1]); o.y = pk2(hv[2], hv[3]); o.z = pk2(hv[4], hv[5]); o.w = pk2(hv[6], hv[7]); *(GAS v4u*)(H + (size_t)row * D + c0) = o; } }
      }
    }
}


#define MFMA16(a, b, c) __builtin_amdgcn_mfma_f32_16x16x32_bf16((a), (b), (c), 0, 0, 0)
typedef short s16x4 __attribute__((ext_vector_type(4)));
__device__ __forceinline__ unsigned lds_addr(LAS void* p) { return (unsigned)(size_t)p; }
__device__ __forceinline__ bf16x8 tr_frag(unsigned a0, unsigned a1) {
    s16x4 lo, hi;
    asm volatile("ds_read_b64_tr_b16 %0, %2\n\tds_read_b64_tr_b16 %1, %3\n\ts_waitcnt lgkmcnt(0)" : "=&v"(lo), "=&v"(hi) : "v"(a0), "v"(a1) : "memory");
    return __builtin_shufflevector(lo, hi, 0, 1, 2, 3, 4, 5, 6, 7);
}
__device__ __forceinline__ void tr_frag4(unsigned a0, unsigned a1, unsigned a2, unsigned a3, unsigned a4, unsigned a5, unsigned a6, unsigned a7, bf16x8& f0, bf16x8& f1, bf16x8& f2, bf16x8& f3) {
    s16x4 r0, r1, r2, r3, r4, r5, r6, r7;
    asm volatile("ds_read_b64_tr_b16 %0, %8\n\tds_read_b64_tr_b16 %1, %9\n\tds_read_b64_tr_b16 %2, %10\n\tds_read_b64_tr_b16 %3, %11\n\t"
                 "ds_read_b64_tr_b16 %4, %12\n\tds_read_b64_tr_b16 %5, %13\n\tds_read_b64_tr_b16 %6, %14\n\tds_read_b64_tr_b16 %7, %15\n\ts_waitcnt lgkmcnt(0)"
                 : "=&v"(r0), "=&v"(r1), "=&v"(r2), "=&v"(r3), "=&v"(r4), "=&v"(r5), "=&v"(r6), "=&v"(r7)
                 : "v"(a0), "v"(a1), "v"(a2), "v"(a3), "v"(a4), "v"(a5), "v"(a6), "v"(a7) : "memory");
    f0 = __builtin_shufflevector(r0, r1, 0, 1, 2, 3, 4, 5, 6, 7); f1 = __builtin_shufflevector(r2, r3, 0, 1, 2, 3, 4, 5, 6, 7);
    f2 = __builtin_shufflevector(r4, r5, 0, 1, 2, 3, 4, 5, 6, 7); f3 = __builtin_shufflevector(r6, r7, 0, 1, 2, 3, 4, 5, 6, 7);
}
__device__ __forceinline__ unsigned off_b(unsigned row, unsigned ch) { return 256u * row + 16u * (ch ^ (((row & 3u) << 2) | ((row >> 2) & 3u))); }
__device__ __forceinline__ unsigned tr_read_addr_16(unsigned lane, unsigned c, unsigned ks, unsigned t) {
    const unsigned g = lane >> 4, q = (lane & 15) >> 2, pp = lane & 3;
    return off_b(32 * ks + 8 * g + 4 * t + q, 2 * c + (pp >> 1)) + 8 * (pp & 1);
}

__device__ __forceinline__ void phase_aa(const Params& p, Frame& F, int l, const float* x) {
    const float* mod = (const float*)(p.ws + WS_MOD) + (size_t)l * NB * 6 * D; const float* gain = (const float*)(p.ws + WS_PAR) + PAR_NMIX + l * D;
    const int gw = F.vcu * NWAVES + F.wave, NGW = F.G * NWAVES;
    const int b = (gw * 2) / NGW, wsub = gw - b * (NGW / 2), nsub = NGW / 2;
    f32x4 Av[4], Bv[4];
#pragma unroll
    for (int j = 0; j < 4; ++j) { const int c = 256 * j + 4 * F.lane; const f32x4 g = *(const f32x4*)(gain + c), sc = *(const f32x4*)(mod + b * 6 * D + 1 * D + c);
        Av[j] = g * (sc + 1.0f); Bv[j] = *(const f32x4*)(mod + b * 6 * D + 0 * D + c); }
    bf16* H = (bf16*)(p.ws + WS_H);
    for (int s = wsub; s < S; s += nsub) {
        const int row = b * S + s;
        asm volatile("" ::: "memory");
        f32x4 h[4]; float ss = 0.f;
#pragma unroll
        for (int j = 0; j < 4; ++j) { h[j] = *(const GAS f32x4*)(x + (size_t)row * D + 256 * j + 4 * F.lane); ss += (h[j].x * h[j].x + h[j].y * h[j].y) + (h[j].z * h[j].z + h[j].w * h[j].w); }
        const float rstd = rsqrtf(wave_sum(ss, F.lane) * (1.0f / D) + EPS);
#pragma unroll
        for (int j = 0; j < 4; ++j) { h[j] = h[j] * rstd * Av[j] + Bv[j];
            v2u o; o.x = pk2(h[j].x, h[j].y); o.y = pk2(h[j].z, h[j].w); *(GAS v2u*)(H + (size_t)row * D + 256 * j + 4 * F.lane) = o; }
    }
}

constexpr float ATT_COFF = 16.0f;
constexpr int AT_KP = 144, AT_VP = 160;
constexpr int AT_KOFF = 0, AT_VOFF = 384 * AT_KP, AT_BOFF = AT_VOFF + 384 * AT_VP;
__device__ __forceinline__ void phase_ac(const Params& p, Frame& F, int l) {
    const int jl = l >> 1;
    const bf16* QKV = (const bf16*)(p.ws + WS_QKV); bf16* O = (bf16*)(p.ws + WS_O);
    const float* biasrel = (const float*)(p.ws + WS_TAB);
    const float* par = (const float*)(p.ws + WS_PAR); const float* qg = par + PAR_QG + jl * HD; const float* kg = par + PAR_KG + jl * HD; const float* sink = par + PAR_SINK + jl * NH;
    LAS unsigned char* Kimg = F.lds + AT_KOFF; LAS unsigned char* Vimg = F.lds + AT_VOFF; LAS float* btab = (LAS float*)(F.lds + AT_BOFF);
    const int lane = F.lane, g4 = lane >> 4, ql = lane & 15;
    const int hq = F.wave >> 1, th = F.wave & 1;
    constexpr float LOG2E = 1.44269504f;
    for (int U = F.vcu; U < NB * 64 * NKV; U += F.G) {
        int b = U >> 8, n = (U >> 2) & 63, kvh = U & 3;
        if (F.G == 256) { const int xg = F.vcu >> 5, lu = (F.vcu & 31) + ((U >= 256) ? 32 : 0); b = xg >> 2; n = 16 * (xg & 3) + (lu >> 2); kvh = lu & 3; }
        const int h = kvh * 4 + hq;
        __syncthreads();
        { const int part = F.tid & 7; f32x4 kg0 = *(const f32x4*)(kg + part * 8), kg1 = *(const f32x4*)(kg + part * 8 + 4);
#pragma unroll
          for (int i = 0; i < 6; ++i) { const int row = (F.tid >> 3) + 64 * i; const int kpos = n * 128 - 128 + row; const bool ok = (kpos >= 0) && (kpos < S);
              v4u kq = (v4u){0u, 0u, 0u, 0u}, vq = (v4u){0u, 0u, 0u, 0u};
              if (ok) { const bf16* base = QKV + ((size_t)b * S + kpos) * QKVN + NH * HD + kvh * HD + part * 8; kq = *(const GAS v4u*)base; vq = *(const GAS v4u*)(base + NKV * HD); }
              float f[8] = {bf_lo(kq.x), bf_hi(kq.x), bf_lo(kq.y), bf_hi(kq.y), bf_lo(kq.z), bf_hi(kq.z), bf_lo(kq.w), bf_hi(kq.w)};
              float ss = 0.f;
#pragma unroll
              for (int e = 0; e < 8; ++e) ss += f[e] * f[e];
              ss += shx(ss, 1, F.lane); ss += shx(ss, 2, F.lane); ss += shx(ss, 4, F.lane);
              const float r = rsqrtf(ss * (1.0f / HD) + EPS);
              v4u ko; ko.x = pk2(f[0] * r * kg0.x, f[1] * r * kg0.y); ko.y = pk2(f[2] * r * kg0.z, f[3] * r * kg0.w); ko.z = pk2(f[4] * r * kg1.x, f[5] * r * kg1.y); ko.w = pk2(f[6] * r * kg1.z, f[7] * r * kg1.w);
              *(LAS v4u*)(Kimg + row * AT_KP + part * 16) = ko; *(LAS v4u*)(Vimg + row * AT_VP + part * 16) = vq; } }
        for (int i = F.tid; i < 4 * 257; i += NTHR) { const int gg = i / 257, r = i - gg * 257; btab[gg * 260 + r] = biasrel[(kvh * 4 + gg) * 257 + r] - ATT_COFF; }
        __syncthreads();
        const float sk = sink[h] * LOG2E - ATT_COFF;
        const LAS float* bt = btab + hq * 260;
        const unsigned vbase = lds_addr(Vimg) + (unsigned)(((lane & 15) >> 2) * AT_VP + (lane & 3) * 8);
        f32x4 qa[2][2];
#pragma unroll
        for (int ds = 0; ds < 2; ++ds) { qa[ds][0] = *(const f32x4*)(qg + 32 * ds + 8 * g4); qa[ds][1] = *(const f32x4*)(qg + 32 * ds + 8 * g4 + 4); }
#pragma unroll 1
        for (int qh = 0; qh < 2; ++qh) {
            bf16x8 qf[2][2];
#pragma unroll
            for (int q2 = 0; q2 < 2; ++q2) { const int tok = n * 128 + th * 64 + 32 * qh + 16 * q2 + ql; const bf16* qp = QKV + ((size_t)b * S + tok) * QKVN + h * HD + 8 * g4;
                const v4u w0 = *(const GAS v4u*)qp, w1 = *(const GAS v4u*)(qp + 32);
                float f[16] = {bf_lo(w0.x), bf_hi(w0.x), bf_lo(w0.y), bf_hi(w0.y), bf_lo(w0.z), bf_hi(w0.z), bf_lo(w0.w), bf_hi(w0.w), bf_lo(w1.x), bf_hi(w1.x), bf_lo(w1.y), bf_hi(w1.y), bf_lo(w1.z), bf_hi(w1.z), bf_lo(w1.w), bf_hi(w1.w)};
                float ss = 0.f;
#pragma unroll
                for (int e = 0; e < 16; ++e) ss += f[e] * f[e];
                ss += shx(ss, 16, F.lane); ss += shx(ss, 32, F.lane);
                const float r = rsqrtf(ss * (1.0f / HD) + EPS) * (0.125f * LOG2E);
#pragma unroll
                for (int ds = 0; ds < 2; ++ds) { v4u o; o.x = pk2(f[8 * ds + 0] * r * qa[ds][0].x, f[8 * ds + 1] * r * qa[ds][0].y); o.y = pk2(f[8 * ds + 2] * r * qa[ds][0].z, f[8 * ds + 3] * r * qa[ds][0].w);
                    o.z = pk2(f[8 * ds + 4] * r * qa[ds][1].x, f[8 * ds + 5] * r * qa[ds][1].y); o.w = pk2(f[8 * ds + 6] * r * qa[ds][1].z, f[8 * ds + 7] * r * qa[ds][1].w);
                    qf[q2][ds] = __builtin_bit_cast(bf16x8, o); } }
            float lrun[2]; f32x4 oacc[4][2];
#pragma unroll
            for (int q2 = 0; q2 < 2; ++q2) { lrun[q2] = 0.f;
#pragma unroll
                for (int db = 0; db < 4; ++db) oacc[db][q2] = (f32x4){0.f, 0.f, 0.f, 0.f}; }
#pragma unroll 1
            for (int c = th; c < th + 5; ++c) {
                bf16x8 kf[4][2];
#pragma unroll
                for (int kb = 0; kb < 4; ++kb)
#pragma unroll
                    for (int ds = 0; ds < 2; ++ds) kf[kb][ds] = *(const LAS bf16x8*)(Kimg + (64 * c + 16 * kb + ql) * AT_KP + (32 * ds + 8 * g4) * 2);
                bf16x8 pf[2][2];
#pragma unroll
                for (int q2 = 0; q2 < 2; ++q2) { const int q0 = th * 64 + 32 * qh + 16 * q2, qoff = q0 + ql;
                    f32x4 sacc[4];
                    const bool full = (64 * c - 143 - q0 >= -128) && (64 * c - 65 - q0 <= 128) && (n * 128 + 64 * c - 128 >= 0) && (n * 128 + 64 * c - 65 < S);
                    if (full) { const LAS float* bp = bt + (64 * c + 4 * g4 - qoff);
#pragma unroll
                        for (int kb = 0; kb < 4; ++kb) sacc[kb] = (f32x4){bp[16 * kb], bp[16 * kb + 1], bp[16 * kb + 2], bp[16 * kb + 3]};
                    } else {
#pragma unroll
                        for (int kb = 0; kb < 4; ++kb)
#pragma unroll
                            for (int j = 0; j < 4; ++j) { const int koff = 64 * c + 16 * kb + 4 * g4 + j - 128; const int rel = koff - qoff; const int kpos = n * 128 + koff;
                                const bool ok = ((unsigned)(rel + 128) <= 256u) && (kpos >= 0) && (kpos < S);
                                sacc[kb][j] = ok ? bt[ok ? rel + 128 : 0] : -1e30f; } }
                    float ps = 0.f; float pv[4][4];
#pragma unroll
                    for (int kb = 0; kb < 4; ++kb) { f32x4 a = MFMA16(kf[kb][0], qf[q2][0], sacc[kb]); a = MFMA16(kf[kb][1], qf[q2][1], a);
#pragma unroll
                        for (int j = 0; j < 4; ++j) { pv[kb][j] = __builtin_amdgcn_exp2f(a[j]); ps += pv[kb][j]; } }
                    lrun[q2] += ps;
#pragma unroll
                    for (int ks2 = 0; ks2 < 2; ++ks2) { v4u o; o.x = pk2(pv[2 * ks2][0], pv[2 * ks2][1]); o.y = pk2(pv[2 * ks2][2], pv[2 * ks2][3]); o.z = pk2(pv[2 * ks2 + 1][0], pv[2 * ks2 + 1][1]); o.w = pk2(pv[2 * ks2 + 1][2], pv[2 * ks2 + 1][3]);
                        pf[q2][ks2] = __builtin_bit_cast(bf16x8, o); } }
#pragma unroll
                for (int ks2 = 0; ks2 < 2; ++ks2) { const unsigned a0 = vbase + (unsigned)((64 * c + 32 * ks2 + 4 * g4) * AT_VP); bf16x8 v0, v1, v2, v3;
                    tr_frag4(a0, a0 + 16u * AT_VP, a0 + 32u, a0 + 32u + 16u * AT_VP, a0 + 64u, a0 + 64u + 16u * AT_VP, a0 + 96u, a0 + 96u + 16u * AT_VP, v0, v1, v2, v3);
                    oacc[0][0] = MFMA16(v0, pf[0][ks2], oacc[0][0]); oacc[0][1] = MFMA16(v0, pf[1][ks2], oacc[0][1]); oacc[1][0] = MFMA16(v1, pf[0][ks2], oacc[1][0]); oacc[1][1] = MFMA16(v1, pf[1][ks2], oacc[1][1]);
                    oacc[2][0] = MFMA16(v2, pf[0][ks2], oacc[2][0]); oacc[2][1] = MFMA16(v2, pf[1][ks2], oacc[2][1]); oacc[3][0] = MFMA16(v3, pf[0][ks2], oacc[3][0]); oacc[3][1] = MFMA16(v3, pf[1][ks2], oacc[3][1]); }
            }
#pragma unroll
            for (int q2 = 0; q2 < 2; ++q2) { float lt = lrun[q2]; lt += shx(lt, 16, F.lane); lt += shx(lt, 32, F.lane); lt += __builtin_amdgcn_exp2f(sk);
                const float inv = 1.0f / lt; const int tok = n * 128 + th * 64 + 32 * qh + 16 * q2 + ql; bf16* op = O + ((size_t)b * S + tok) * D + h * HD + 4 * g4;
#pragma unroll
                for (int db = 0; db < 4; ++db) { const f32x4 v = oacc[db][q2] * inv; v2u o; o.x = pk2(v.x, v.y); o.y = pk2(v.z, v.w); *(GAS v2u*)(op + 16 * db) = o; } }
        }
    }
}

__device__ __forceinline__ void phase_fa(const Params& p, Frame& F, int l, const float* xraw) {
    const bf16* H = (const bf16*)(p.ws + WS_H); bf16* TA = (bf16*)(p.ws + WS_TA);
    const bf16* R64B = (const bf16*)(p.ws + WS_TAB + 65536);
    const int lane = F.lane, g4 = lane >> 4, ql = lane & 15;
    for (int U = F.vcu; U < NB * 128; U += F.G) {
        const int b = U >> 7, s2 = U & 127;
        __syncthreads();
        if (xraw) {
            const float* mod = (const float*)(p.ws + WS_MOD) + (size_t)l * NB * 6 * D; const float* gain = (const float*)(p.ws + WS_PAR) + PAR_NMIX + l * D;
            f32x4 Av[4], Bv[4];
#pragma unroll
            for (int j = 0; j < 4; ++j) { const int c = 256 * j + 4 * lane; const f32x4 g = *(const f32x4*)(gain + c), sc = *(const f32x4*)(mod + b * 6 * D + 1 * D + c);
                Av[j] = g * (sc + 1.0f); Bv[j] = *(const f32x4*)(mod + b * 6 * D + 0 * D + c); }
#pragma unroll 1
            for (int r4 = 0; r4 < 2; ++r4) { f32x4 h[4][4];
#pragma unroll
                for (int r = 0; r < 4; ++r)
#pragma unroll
                    for (int j = 0; j < 4; ++j) h[r][j] = *(const GAS f32x4*)(xraw + ((size_t)b * S + 128 * (F.wave * 8 + r4 * 4 + r) + s2) * D + 256 * j + 4 * lane);
#pragma unroll
                for (int r = 0; r < 4; ++r) { const int s1 = F.wave * 8 + r4 * 4 + r; float ss = 0.f;
#pragma unroll
                    for (int j = 0; j < 4; ++j) ss += (h[r][j].x * h[r][j].x + h[r][j].y * h[r][j].y) + (h[r][j].z * h[r][j].z + h[r][j].w * h[r][j].w);
                    const float rstd = rsqrtf(wave_sum(ss, lane) * (1.0f / D) + EPS);
#pragma unroll
                    for (int j = 0; j < 4; ++j) { const f32x4 hv = h[r][j] * rstd * Av[j] + Bv[j]; const int c = 256 * j + 4 * lane;
                        v2u o; o.x = pk2(hv.x, hv.y); o.y = pk2(hv.z, hv.w); *(LAS v2u*)(F.lds + (c >> 7) * 16384 + off_b(s1, (c & 127) >> 3) + (c & 7) * 2) = o; } } }
        } else {
#pragma unroll 4
            for (int i = 0; i < 16; ++i) { const int q = F.tid + 512 * i, row = q >> 7, c128 = q & 127;
                const v4u v = *(const GAS v4u*)(H + ((size_t)b * S + 128 * row + s2) * D + c128 * 8);
                *(LAS v4u*)(F.lds + (c128 >> 4) * 16384 + off_b(row, c128 & 15)) = v; }
        }
        bf16x8 rf[4][2];
#pragma unroll
        for (int rb = 0; rb < 4; ++rb)
#pragma unroll
            for (int ks = 0; ks < 2; ++ks) rf[rb][ks] = *(const GAS bf16x8*)(R64B + (16 * rb + ql) * 64 + 32 * ks + 8 * g4);
        __syncthreads();
        const unsigned ibase = lds_addr(F.lds) + F.wave * 16384;
#pragma unroll 1
        for (int c4 = 0; c4 < 2; ++c4) {
            f32x4 acc[4][4];
#pragma unroll
            for (int cb = 0; cb < 4; ++cb)
#pragma unroll
                for (int rb = 0; rb < 4; ++rb) acc[cb][rb] = (f32x4){0.f, 0.f, 0.f, 0.f};
#pragma unroll
            for (int ks = 0; ks < 2; ++ks) { bf16x8 f0, f1, f2, f3; unsigned a[8];
#pragma unroll
                for (int i = 0; i < 4; ++i) { a[2 * i] = ibase + tr_read_addr_16(lane, 4 * c4 + i, ks, 0); a[2 * i + 1] = ibase + tr_read_addr_16(lane, 4 * c4 + i, ks, 1); }
                tr_frag4(a[0], a[1], a[2], a[3], a[4], a[5], a[6], a[7], f0, f1, f2, f3);
#pragma unroll
                for (int rb = 0; rb < 4; ++rb) { acc[0][rb] = MFMA16(f0, rf[rb][ks], acc[0][rb]); acc[1][rb] = MFMA16(f1, rf[rb][ks], acc[1][rb]);
                    acc[2][rb] = MFMA16(f2, rf[rb][ks], acc[2][rb]); acc[3][rb] = MFMA16(f3, rf[rb][ks], acc[3][rb]); } }
#pragma unroll
            for (int rb = 0; rb < 4; ++rb) { const int r = 16 * rb + ql; const int uh = (r == 0) ? 0 : (r == 32 ? 1 : (r < 32 ? 2 * r : 2 * (r - 32) + 1));
                bf16* tp = TA + (((size_t)b * 64 + uh) * 128 + s2) * 1024 + 128 * F.wave + 64 * c4 + 4 * g4;
#pragma unroll
                for (int cb = 0; cb < 4; ++cb) { const f32x4 v = acc[cb][rb]; v2u w; w.x = pk2(v.x, v.y); w.y = pk2(v.z, v.w); *(GAS v2u*)(tp + 16 * cb) = w; } }
        }
    }
}

__device__ __forceinline__ void phase_fb(const Params& p, Frame& F) {
    const bf16* TA = (const bf16*)(p.ws + WS_TA); const bf16* MBT = (const bf16*)(p.ws + WS_MBT); bf16* YF = (bf16*)(p.ws + WS_YF); float* Yr4096 = (float*)(p.ws + WS_MISC + 8192);
    const int lane = F.lane, g4 = lane >> 4, ql = lane & 15;
    for (int U = F.vcu; U < NB * 32 * 4; U += F.G) {
        const int b = U >> 7, u = (U >> 2) & 31, cq = U & 3;
        __syncthreads();
        const bf16* src = TA + ((size_t)(b * 32 + u) * 256) * 1024 + cq * 256;
#pragma unroll 4
        for (int i = 0; i < 16; ++i) { const int q = F.tid + 512 * i, row = q >> 5, c32 = q & 31;
            const v4u v = *(const GAS v4u*)(src + (size_t)row * 1024 + c32 * 8);
            *(LAS v4u*)(F.lds + (c32 >> 4) * 65536 + off_b(row, c32 & 15)) = v; }
        __syncthreads();
        f32x4 acc[16][2];
#pragma unroll
        for (int cb = 0; cb < 16; ++cb) { acc[cb][0] = (f32x4){0.f, 0.f, 0.f, 0.f}; acc[cb][1] = (f32x4){0.f, 0.f, 0.f, 0.f}; }
        const bf16* mrow = MBT + ((size_t)u * 256 + 32 * F.wave + ql) * 256 + 8 * g4;
        const unsigned lbase = lds_addr(F.lds);
#pragma unroll 1
        for (int ks = 0; ks < 8; ++ks) {
            const bf16x8 m0 = *(const GAS bf16x8*)(mrow + 32 * ks), m1 = *(const GAS bf16x8*)(mrow + 16 * 256 + 32 * ks);
#pragma unroll
            for (int c4 = 0; c4 < 4; ++c4) { bf16x8 f0, f1, f2, f3; unsigned a[8];
#pragma unroll
                for (int i = 0; i < 4; ++i) { const int cb = 4 * c4 + i; a[2 * i] = lbase + (cb >> 3) * 65536 + tr_read_addr_16(lane, cb & 7, ks, 0); a[2 * i + 1] = lbase + (cb >> 3) * 65536 + tr_read_addr_16(lane, cb & 7, ks, 1); }
                tr_frag4(a[0], a[1], a[2], a[3], a[4], a[5], a[6], a[7], f0, f1, f2, f3);
                acc[4 * c4 + 0][0] = MFMA16(f0, m0, acc[4 * c4 + 0][0]); acc[4 * c4 + 0][1] = MFMA16(f0, m1, acc[4 * c4 + 0][1]);
                acc[4 * c4 + 1][0] = MFMA16(f1, m0, acc[4 * c4 + 1][0]); acc[4 * c4 + 1][1] = MFMA16(f1, m1, acc[4 * c4 + 1][1]);
                acc[4 * c4 + 2][0] = MFMA16(f2, m0, acc[4 * c4 + 2][0]); acc[4 * c4 + 2][1] = MFMA16(f2, m1, acc[4 * c4 + 2][1]);
                acc[4 * c4 + 3][0] = MFMA16(f3, m0, acc[4 * c4 + 3][0]); acc[4 * c4 + 3][1] = MFMA16(f3, m1, acc[4 * c4 + 3][1]); }
        }
#pragma unroll
        for (int mb = 0; mb < 2; ++mb) { const int o = 32 * F.wave + 16 * mb + ql, ri = o >> 7, jj = o & 127;
            bf16* yp = YF + (((size_t)(b * 4096 + u * 128 + jj)) * 2 + ri) * 1024 + cq * 256 + 4 * g4;
#pragma unroll
            for (int cb = 0; cb < 16; ++cb) { const f32x4 v = acc[cb][mb]; v2u w; w.x = pk2(v.x, v.y); w.y = pk2(v.z, v.w); *(GAS v2u*)(yp + 16 * cb) = w; } }
        if (u == 0 && F.tid < 256) {
            const int col = F.tid; const LAS unsigned char* img = F.lds + (col >> 7) * 65536; const int cc = col & 127; float a = 0.f;
            for (int s2 = 0; s2 < 128; ++s2) { const unsigned short hv = *(const LAS unsigned short*)(img + off_b(s2, cc >> 3) + 2 * (cc & 7)); const float v = __builtin_bit_cast(float, (unsigned)hv << 16); a += (s2 & 1) ? -v : v; }
            Yr4096[b * 1024 + cq * 256 + col] = a; }
    }
}

__device__ __forceinline__ void fc_extra(const Params& p, Frame& F, int l) {
    const float* Yr = (const float*)(p.ws + WS_MISC + 8192); float* y4096 = (float*)(p.ws + WS_MISC); const bf16* W = (const bf16*)(p.ws + WS_WFF) + (size_t)(l >> 1) * 2048 * 1024;
    const int gw = F.vcu * NWAVES + F.wave, NGW = F.G * NWAVES;
    for (int o = gw; o < NB * 1024; o += NGW) { const int b = o >> 10, j = o & 1023; float a = 0.f;
#pragma unroll
        for (int i = 0; i < 2; ++i) { const int c = 512 * i + 8 * F.lane; const v4u w = *(const GAS v4u*)(W + (size_t)j * 1024 + c); const f32x4 y0 = *(const GAS f32x4*)(Yr + b * 1024 + c), y1 = *(const GAS f32x4*)(Yr + b * 1024 + c + 4);
            a += y0.x * bf_lo(w.x) + y0.y * bf_hi(w.x) + y0.z * bf_lo(w.y) + y0.w * bf_hi(w.y) + y1.x * bf_lo(w.z) + y1.y * bf_hi(w.z) + y1.z * bf_lo(w.w) + y1.w * bf_hi(w.w); }
        a = wave_sum(a, F.lane); if (F.lane == 0) y4096[o] = a; }
}

__device__ __forceinline__ void pro_small(const Params& p, Frame& F) {
    const int gt = F.vcu * NTHR + F.tid, NGT = F.G * NTHR;
    float* mod = (float*)(p.ws + WS_MOD);
    { LAS float* sc = (LAS float*)F.lds; LAS float* part = sc + 2 * D;
      for (int i = F.tid; i < 2 * D; i += NTHR) { const float cv = p.in[IN_C][i]; sc[i] = cv / (1.f + expf(-cv)); }
      __syncthreads();
      for (int cb = F.vcu; cb < DEPTH * 6 * D / 96; cb += F.G) {
          const int col0 = cb * 96, l = col0 / (6 * D), j0 = col0 - l * 6 * D;
          if (F.tid < 480) { const int cc = F.tid % 96, ks = F.tid / 96; const int k0 = ks * 205, k1 = (k0 + 205 < D) ? k0 + 205 : D;
              const float* w = p.in[IN_WADA] + (size_t)l * D * 6 * D + j0 + cc; float a0 = 0.f, a1 = 0.f;
#pragma unroll 16
              for (int i = k0; i < k1; ++i) { const float wv = w[(size_t)i * 6 * D]; a0 += sc[i] * wv; a1 += sc[D + i] * wv; }
              part[(ks * 2 + 0) * 96 + cc] = a0; part[(ks * 2 + 1) * 96 + cc] = a1; }
          __syncthreads();
          if (F.tid < 192) { const int bb = F.tid / 96, cc = F.tid % 96; float a = p.in[IN_BADA][l * 6 * D + j0 + cc];
#pragma unroll
              for (int ks = 0; ks < 5; ++ks) a += part[(ks * 2 + bb) * 96 + cc];
              mod[((size_t)l * NB + bb) * 6 * D + j0 + cc] = a; }
          __syncthreads(); } }
    { float* par = (float*)(p.ws + WS_PAR);
      for (int i = gt; i < 4096; i += NGT) { par[PAR_NMIX + i] = p.in[IN_NMIX][i]; par[PAR_NFFN + i] = p.in[IN_NFFN][i]; }
      for (int i = gt; i < 128; i += NGT) { par[PAR_QG + i] = p.in[IN_QG][i]; par[PAR_KG + i] = p.in[IN_KG][i]; }
      for (int i = gt; i < 32; i += NGT) par[PAR_SINK + i] = p.in[IN_SINK][i];
      for (int i = gt; i < DEPTH * D * NE; i += NGT) par[PAR_WR + i] = p.in[IN_WR][i]; }
    float* biasrel = (float*)(p.ws + WS_TAB); bf16* MBT = (bf16*)(p.ws + WS_MBT); bf16* CS = (bf16*)(p.ws + WS_CS);
    for (int i = gt; i < NH * 257; i += NGT) { const int h = i / 257, r = i - h * 257, rel = r - 128, n = rel < 0 ? -rel : rel;
        int bk = (n < 8) ? n : 8 + (n >= 12) + (n >= 16) + (n >= 23) + (n >= 32) + (n >= 46) + (n >= 64) + (n >= 91);
        bk += (rel > 0) ? 16 : 0; biasrel[i] = p.in[IN_RELB][bk * NH + h] * 1.44269504f; }
    { bf16* R64B = (bf16*)(p.ws + WS_TAB + 65536);
      for (int i = gt; i < 64 * 64; i += NGT) { const int r = i >> 6, s = i & 63; float sv, cv;
          if (r <= 32) { sincospif((float)((r * s) & 63) / 32.0f, &sv, &cv); R64B[i] = (bf16)f2bf(cv); } else { sincospif((float)(((r - 32) * s) & 63) / 32.0f, &sv, &cv); R64B[i] = (bf16)f2bf(-sv); } } }
    for (int i = gt; i < 512 * 256; i += NGT) { const int rr = i >> 8, m = i & 255, cs = rr >> 8, nn = rr & 255; float sv, cv; sincospif((float)((nn * m) & 255) / 128.0f, &sv, &cv); CS[i] = (bf16)f2bf(cs ? sv : cv); }
    for (int i = gt; i < 32 * 256 * 256; i += NGT) { const int u = i >> 16, o = (i >> 8) & 255, K = i & 255, ri = o >> 7, j = o & 127, half = K >> 7, s2 = K & 127; float val = 0.f;
        if (u >= 1) { const int k = u + 64 * j; float sv, cv; sincospif((float)((s2 * k) & 8191) / 4096.0f, &sv, &cv);
            val = (ri == 0) ? (half == 0 ? cv : sv) : (half == 0 ? -sv : cv); }
        else { const int blk = j >> 6, k = (blk ? 32 : 0) + 64 * (j & 63); if (half == blk) { float sv, cv; sincospif((float)((s2 * k) & 8191) / 4096.0f, &sv, &cv); val = (ri == 0) ? cv : -sv; } }
        MBT[i] = (bf16)f2bf(val); }
}
__device__ __forceinline__ CvtItem dense_item(const Params& p, int it) {
    constexpr int I_QKV = 16 * 24, I_SQ = 16 * 16; CvtItem ci; int r = it;
    if (r < 2 * I_QKV) { const int j = r / I_QKV; r -= j * I_QKV; const int kt = r / 24, ntile = r % 24;
        ci.src = p.in[IN_WQKV] + (size_t)j * D * QKVN + (size_t)kt * 64 * QKVN + ntile * 64; ci.N = QKVN; ci.dst = (bf16*)(p.ws + WS_WQKV) + ((size_t)j * QKVN + ntile * 64) * D + kt * 64; ci.ldk = D; return ci; }
    r -= 2 * I_QKV; const int which = r / (2 * I_SQ); r -= which * 2 * I_SQ; const int j = r / I_SQ; r -= j * I_SQ; const int kt = r >> 4, ntile = r & 15;
    ci.src = (which ? p.in[IN_WFO] : p.in[IN_WAO]) + (size_t)j * D * D + (size_t)kt * 64 * D + ntile * 64; ci.N = D;
    ci.dst = (bf16*)(p.ws + (which ? WS_WFO : WS_WAO)) + ((size_t)j * D + ntile * 64) * D + kt * 64; ci.ldk = D; return ci;
}
__device__ __forceinline__ void pro_cvt_dense(const Params& p, Frame& F) {
    LAS float* scr = (LAS float*)(F.lds + F.wave * 16640);
    const int gw = F.vcu * NWAVES + F.wave, NGW = F.G * NWAVES;
    constexpr int NIT = 2 * 16 * 24 + 4 * 16 * 16;
    for (int it = gw; it < NIT; it += NGW) { f32x4 v[16]; const CvtItem ci = dense_item(p, it); cvt_load(ci, v, F.lane); cvt_store(ci, v, scr, F.lane); }
}

namespace pg8 {
struct SchedFC { const char* A; const char* B; int G, c;
    __device__ __forceinline__ bool next(int i, Unit& u) const { int tm, tn; if (!tile_of(i, G, c, 32, 8, DENSE_WGM, tm, tn)) return false;
        u.pm = tm; u.pn = tn; u.A = A + (size_t)tm * (256 * 2048 * 2) + (tn >= 4 ? 2048 : 0); u.B = B + (size_t)tn * (256 * 1024 * 2); return true; } };
struct SchedFold { const char* A; const char* B; int G, c;
    __device__ __forceinline__ bool next(int i, Unit& u) const { const long L = (long)i * G + c; if (L >= 64) return false; const int g = (int)L & 3, tm = ((int)L >> 2) & 3, cs = ((int)L >> 4) & 1, jl = (int)L >> 5;
        u.pm = tm + 4 * cs + 8 * jl; u.pn = g; u.A = A + (size_t)jl * (1024 * 1024 * 2) + (size_t)tm * (256 * 1024 * 2) + g * 512; u.B = B + (size_t)cs * (256 * 256 * 2); return true; } };
}

constexpr int NPH_L = 8, NPHASE = 1 + NPH_L * DEPTH;
#ifndef PROBE_MASK
#define PROBE_MASK 0
#endif
#define DUP(bit) _Pragma("unroll 1") for (int rep_ = 0; rep_ < (((PROBE_MASK) >> (bit)) & 1) + 1; ++rep_)
__global__ void __launch_bounds__(NTHR, 2) mk_fwd(Params p) {
    extern __shared__ __attribute__((aligned(16))) unsigned char lds_raw[];
    Frame F; F.lds = (LAS unsigned char*)lds_raw;
    F.tid = threadIdx.x; F.lane = F.tid & 63; F.wave = __builtin_amdgcn_readfirstlane(F.tid >> 6); const int wave0 = F.wave;
    F.G = gridDim.x; { const int bx = blockIdx.x; F.vcu = (F.G % 8 == 0) ? (bx % 8) * (F.G / 8) + bx / 8 : bx; }
    volatile LAS unsigned* MISC = (volatile LAS unsigned*)(F.lds + MISC_OFF);
    if (F.tid < 32) MISC[F.tid] = 0u;
    __syncthreads();
    XcdBarrier bar = xcd_barrier_post((unsigned*)(p.ws + WS_CTL) + CW_BAR, MISC + 8);
#ifndef PROBE_SAMETILE
#define PROBE_SAMETILE 0
#endif
    if (F.tid == 0 && (bar.x != (blockIdx.x & 7u) || gridDim.x != 256u)) (void)xb_add(&bar.bar[XB_MISMAP], 1u);
    const int lo = p.ph_lo, hi = p.ph_hi;
#define IN(k) (lo <= (k) && (k) < hi)
#ifndef PROBE_SAMETILE
#define PROBE_SAMETILE 0
#endif
#ifndef PROBE_NOEPI
#define PROBE_NOEPI 0
#endif
#ifndef PROBE_BAR2
#define PROBE_BAR2 0
#endif
#define SEAM(k) do { if (IN(k) && IN((k) + 1)) { xcd_barrier(bar); if (PROBE_BAR2) xcd_barrier(bar); } } while (0)
#define SEAM_LC(k, c) do { if (IN(k) && IN((k) + 1)) { const bool loc_ = (c) && __builtin_amdgcn_readfirstlane((int)MISC[10]) != 0; xcd_barrier(bar, loc_); } } while (0)
#define SEAM_L(k) SEAM_LC(k, true)
#define RELAUNDER() do { int w_ = wave0; asm volatile("" : "+s"(w_)); F.wave = w_; F.lane = pg8::lane_id_asm(); F.tid = F.wave * 64 + F.lane; } while (0)
#define PHASE_CTX() Params q; do { unsigned long long w_ = (unsigned long long)p.ws, o_ = (unsigned long long)p.out; asm volatile("" : "+s"(w_), "+s"(o_)); q.ws = (unsigned char*)w_; q.out = (float*)o_; RELAUNDER(); } while (0)

    if (IN(0)) DUP(0) {
        RELAUNDER(); pro_small(p, F);
        __syncthreads();
        RELAUNDER(); pro_cvt_dense(p, F);
        const int gw = F.vcu * NWAVES + F.wave, NGW = F.G * NWAVES;
        RELAUNDER(); cvt_moe_layer(p, F, 0, gw, NGW, 3 * 8192);
        if (F.vcu == 0 && F.tid == 0) { unsigned long long* pt = (unsigned long long*)(p.ws + WS_PAR + 512 * 1024); pt[0] = (unsigned long long)p.in[IN_WG]; pt[1] = (unsigned long long)p.in[IN_WU]; pt[2] = (unsigned long long)p.in[IN_WD]; pt[3] = (unsigned long long)p.in[IN_X]; }
        __syncthreads();
    }
    SEAM(0);
    if (lo == 0 && hi == NPHASE) {
        if (F.tid == 0) MISC[10] = (xb_ld(&bar.bar[XB_MISMAP]) == 0u) ? 1u : 0u;
        __syncthreads(); }
    for (int l = 0; l < DEPTH; ++l) {
        const int base = 1 + NPH_L * l; const bool fourier = (l & 1) == 0; const int jl = l >> 1;
        if (IN(base + 0)) DUP(1) {
            PHASE_CTX();
            if (fourier) {
                const float* xin0 = nullptr; if (l == 0) xin0 = (const float*)((const unsigned long long*)(q.ws + WS_PAR + 512 * 1024))[3];
                phase_fa(q, F, l, xin0);
                __syncthreads();
                if (l == 0) {
                pg8::SchedFold Sc{(const char*)(q.ws + WS_WFO), (const char*)(q.ws + WS_CS), F.G, F.vcu};
                pg8::EpiBf16 E{(bf16*)(q.ws + WS_WFF), 1024, nullptr, 1.0f / 1448.15468787f, 0};
                pg8::gemm_phase<pg8::EpiBf16, pg8::SchedFold, 256, 1024, 256>(F.lds, Sc, E, F.wave); }
            } else {
                pg8::SchedPlain Sc{(const char*)(q.ws + WS_H), (const char*)(q.ws + WS_WQKV + (size_t)jl * QKVN * D * 2), (size_t)256 * 1024 * 2, (size_t)256 * 1024 * 2, 64, 6, F.G, (int)blockIdx.x, DENSE_WGM, 0};
                pg8::EpiBf16 E{(bf16*)(q.ws + WS_QKV), QKVN, nullptr, 1.0f, 0};
                pg8::gemm_phase<pg8::EpiBf16, pg8::SchedPlain, 1024, 1024, 1024>(F.lds, Sc, E, F.wave);
                if (CVT_PRE > 0 && F.G == 256 && blockIdx.x >= 128 && rep_ == 0) { RELAUNDER(); __syncthreads();
                    const unsigned long long* pt = (const unsigned long long*)(q.ws + WS_PAR + 512 * 1024);
                    q.in[IN_WG] = (const float*)pt[0]; q.in[IN_WU] = (const float*)pt[1]; q.in[IN_WD] = (const float*)pt[2];
                    const int xs = F.vcu >> 5, w = ((F.vcu & 31) - 16) * NWAVES + F.wave, per = 3 * 8192 / 8;
                    cvt_moe_layer(q, F, l == 1 ? 2 : 3, xs * per + w, 16 * NWAVES, xs * per + CVT_PRE); __syncthreads(); }
            }
        }
        SEAM(base + 0);
        if (IN(base + 1)) DUP(2) {
            PHASE_CTX();
            if (fourier) phase_fb(q, F); else phase_ac(q, F, l);
        }
        SEAM_LC(base + 1, !fourier);
        if (IN(base + 2)) _Pragma("unroll 1") for (int rep_ = 0; rep_ < (((((PROBE_MASK) >> 3) & 1) && fourier) || ((((PROBE_MASK) >> 10) & 1) && !fourier) ? 2 : 1); ++rep_) {
            PHASE_CTX();
            if (fourier) {
                pg8::SchedFC Sc{(const char*)(q.ws + WS_YF), (const char*)(q.ws + WS_WFF + (size_t)jl * 2048 * 1024 * 2), F.G, (int)blockIdx.x};
                pg8::EpiBf16 E{(bf16*)(q.ws + WS_PQ), 2048, nullptr, 1.0f, 0};
                pg8::gemm_phase<pg8::EpiBf16, pg8::SchedFC, 1024, 2048, 1024>(F.lds, Sc, E, F.wave);
                RELAUNDER(); fc_extra(q, F, l);
            } else {
                pg8::SchedPlain Sc{(const char*)(q.ws + WS_O), (const char*)(q.ws + WS_WAO + (size_t)jl * D * D * 2), (size_t)256 * 1024 * 2, (size_t)256 * 1024 * 2, 64, 4, F.G, (int)blockIdx.x, DENSE_WGM, 0};
                pg8::EpiResidB E{(bf16*)(q.ws + (rep_ == 1 ? WS_GOLD : WS_XB)), (const float*)(q.ws + WS_MOD) + (size_t)l * NB * 6 * D + 2 * D};
                pg8::gemm_phase<pg8::EpiResidB, pg8::SchedPlain, 1024, 1024, 1024>(F.lds, Sc, E, F.wave);
            }
        }
        SEAM_LC(base + 2, !fourier);
        if (IN(base + 3)) DUP(4) { PHASE_CTX(); const float* xin = nullptr; if (l == 0) xin = (const float*)((const unsigned long long*)(q.ws + WS_PAR + 512 * 1024))[3]; phase_ma(q, F, l, fourier && rep_ == 0, xin); }
        SEAM(base + 3);
        if (IN(base + 4)) DUP(5) { PHASE_CTX(); phase_mbc(q, F); }
        SEAM_L(base + 4);
        if (IN(base + 5)) DUP(7) {
            PHASE_CTX();
            const int nxg = F.G >> 3, xslot = F.vcu / nxg; const int nper = (2048 + F.G - 1) / F.G, rsplit = (l + 1 < DEPTH) ? (7 - xslot) * nper / 8 + 1 : nper;
#ifndef MD_SKEW_TICKS
#define MD_SKEW_TICKS 0
#endif
            if (MD_SKEW_TICKS) { const unsigned long long t0 = __builtin_amdgcn_s_memrealtime(), dl = (unsigned long long)((F.vcu & 3) * MD_SKEW_TICKS);
                while (__builtin_amdgcn_s_memrealtime() - t0 < dl) __builtin_amdgcn_s_sleep(8); }
#pragma unroll 1
            for (int part = 0; part < 2; ++part) {
                pg8::SchedMoE Sc{(const char*)(q.ws + WS_XIN), (const char*)(q.ws + WS_W1 + (size_t)l * NE * 4096 * 1024 * 2), (size_t)256 * 1024 * 2, (size_t)256 * 1024 * 2, 16, F.G, (int)blockIdx.x, part ? rsplit : 0, part ? nper - rsplit : rsplit, (PROBE_SAMETILE && rep_ == 1) ? 1 : 0};
                pg8::EpiSwiGLU E{(bf16*)(q.ws + WS_ACT), 2048, (PROBE_NOEPI && rep_ == 1) ? 1 : 0};
                pg8::gemm_phase<pg8::EpiSwiGLU, pg8::SchedMoE, 1024, 1024, 1024>(F.lds, Sc, E, F.wave);
                if (part == 0 && l + 1 < DEPTH && rep_ == 0) { RELAUNDER();
                    const unsigned long long* pt = (const unsigned long long*)(q.ws + WS_PAR + 512 * 1024);
                    q.in[IN_WG] = (const float*)pt[0]; q.in[IN_WU] = (const float*)pt[1]; q.in[IN_WD] = (const float*)pt[2];
                    const int nslotw = nxg * NWAVES, per = 3 * 8192 / 8;
                    const int pre = (F.G == 256 && l + 1 >= 2) ? CVT_PRE : 0;
                    cvt_moe_layer(q, F, l + 1, xslot * per + pre + (F.vcu - xslot * nxg) * NWAVES + F.wave, nslotw, (xslot + 1) * per); __syncthreads(); }
            }
        }
        SEAM_L(base + 5);
        if (IN(base + 6)) DUP(8) {
            PHASE_CTX();
            pg8::SchedMoE Sc{(const char*)(q.ws + WS_ACT), (const char*)(q.ws + WS_W2 + (size_t)l * NE * 1024 * 2048 * 2), (size_t)256 * 2048 * 2, (size_t)256 * 2048 * 2, 4, F.G, (int)blockIdx.x, 0, 1 << 20, 0};
            pg8::EpiBf16 E{(bf16*)(q.ws + WS_Y), 1024, (const float*)(q.ws + WS_GATE), 1.0f, 0};
            pg8::gemm_phase<pg8::EpiBf16, pg8::SchedMoE, 2048, 2048, 2048>(F.lds, Sc, E, F.wave);
        }
        SEAM(base + 6);
        if (IN(base + 7)) DUP(9) { PHASE_CTX(); phase_mf(q, F, l, rep_ == 1); }
        SEAM_LC(base + 7, fourier);
    }
#undef IN
#undef SEAM
}

#ifndef MK_MODE
#define MK_MODE 0
#endif
extern "C" void kernel_launch(void* const* d_in, const int* in_sizes, int n_in, void* d_out, int out_size, void* d_ws, size_t ws_size, hipStream_t stream) {
    static int grid = 0;
    if (grid == 0) {
        int dev = 0, cus = 0;
        if (n_in != 17 || ws_size < WS_END || hipGetDevice(&dev) != hipSuccess || hipDeviceGetAttribute(&cus, hipDeviceAttributeMultiprocessorCount, dev) != hipSuccess) { fprintf(stderr, "kernel_launch: bad arguments\n"); grid = -1; return; }
        if (hipFuncSetAttribute((const void*)mk_fwd, hipFuncAttributeMaxDynamicSharedMemorySize, LDS_BYTES) != hipSuccess) { fprintf(stderr, "kernel_launch: hipFuncSetAttribute failed\n"); grid = -1; return; }
        int per_cu = 0; (void)hipOccupancyMaxActiveBlocksPerMultiprocessor(&per_cu, (const void*)mk_fwd, NTHR, LDS_BYTES); (void)hipGetLastError();
        grid = cus;
    }
    if (grid < 0) return;
    Params P{}; for (int i = 0; i < 17; ++i) P.in[i] = (const float*)d_in[i]; P.out = (float*)d_out; P.ws = (unsigned char*)d_ws;
#if MK_MODE == 0
    (void)hipMemsetAsync((char*)d_ws + WS_CTL, 0, CTL_ZERO_BYTES, stream);
    P.ph_lo = 0; P.ph_hi = NPHASE; hipLaunchKernelGGL(mk_fwd, dim3(grid), dim3(NTHR), LDS_BYTES, stream, P);
#else
    for (int ph = 0; ph < NPHASE; ++ph) { (void)hipMemsetAsync((char*)d_ws + WS_CTL, 0, CTL_ZERO_BYTES, stream); P.ph_lo = ph; P.ph_hi = ph + 1; hipLaunchKernelGGL(mk_fwd, dim3(grid), dim3(NTHR), LDS_BYTES, stream, P); }
#endif
}
```

```cpp
#include <hip/hip_runtime.h>
#include <math.h>
#include <stdint.h>
#include <stdio.h>

#ifndef CVT_PRE
#define CVT_PRE 512
#endif
#ifndef DENSE_WGM
#define DENSE_WGM 8
#endif
#ifndef MOE_WGM_MD
#define MOE_WGM_MD 4
#endif
#ifndef MOE_WGM_ME
#define MOE_WGM_ME 4
#endif
namespace pg8 {
#define PG8_LAS __attribute__((address_space(3)))
typedef unsigned short bf16_t;
typedef short bf16x8 __attribute__((ext_vector_type(8)));
typedef float f32x4 __attribute__((ext_vector_type(4)));
typedef unsigned u32x4 __attribute__((ext_vector_type(4)));
constexpr int BM = 256, BK = 64, HALF = 128, HTB = HALF * BK * 2  , STAGE_BYTES = 8 * HTB, NXCD = 8;

__host__ __device__ __forceinline__ int lds_byte(int r, int c) { const int st = (r >> 4) * 2 + (c >> 5), rr = r & 15, cc = c & 31, ob = rr * 64 + cc * 2; return st * 1024 + (ob ^ (((ob >> 9) & 1) << 5)); }
__host__ __device__ __forceinline__ void stage_rc(int b, int& R, int& C) { const int st = b / 1024, sb = b % 1024, swz = sb ^ (((sb >> 9) & 1) << 5); R = (st >> 1) * 16 + swz / 64; C = (st & 1) * 32 + (swz % 64) / 2; }
__host__ __device__ __forceinline__ int perm32(int rho) { const int n = rho >> 4, i = rho & 15; return 8 * (i >> 2) + 4 * n + (i & 3); }

__device__ __forceinline__ int lane_id_asm() { int l; asm volatile("v_mbcnt_lo_u32_b32 %0, -1, 0\n\tv_mbcnt_hi_u32_b32 %0, -1, %0" : "=v"(l)); return l; }
struct Unit { const char* A; const char* B; int pm, pn; };

__device__ __forceinline__ bool tile_of(int i, int G, int c, int nM, int nN, int wgm, int& tm, int& tn) {
    const int nwg = nM * nN; const long L = (long)i * G + c; if (L >= nwg) return false;
    int wgid = (int)L; { const int q = nwg / NXCD, r = nwg % NXCD, xcd = wgid % NXCD, off = wgid / NXCD; wgid = (xcd < r ? xcd * (q + 1) : r * (q + 1) + (xcd - r) * q) + off; }
    const int nig = wgm * nN, gid = wgid / nig, fm = gid * wgm, gsz = (nM - fm) < wgm ? (nM - fm) : wgm;
    tm = fm + ((wgid % nig) % gsz); tn = (wgid % nig) / gsz; return true;
}

__device__ __forceinline__ unsigned cvt_pk_bf16(float lo, float hi) { unsigned r; asm volatile("v_cvt_pk_bf16_f32 %0, %1, %2" : "=v"(r) : "v"(lo), "v"(hi)); return r; }

template <class Epi, class Sched, int K, int lda, int ldb, bool ALIGN_EPI = true, bool SP2 = true>
__device__ __forceinline__ void gemm_phase(PG8_LAS unsigned char* lds, const Sched& S, const Epi& E, const int wave_sgpr) {
    int wid_l = wave_sgpr; asm volatile("" : "+s"(wid_l));
    const int wid = wid_l, lane = lane_id_asm(), tid = wid * 64 + lane, wr = wid >> 2, wc = wid & 3, fr = lane & 15, fq = lane >> 4;
    const int nt = K / BK;
    unsigned voffA[2], voffB[2];
#pragma unroll
    for (int i = 0; i < 2; ++i) { int R, C; stage_rc(tid * 16 + i * 8192, R, C); const int Rb = Epi::PERM ? ((R & ~31) + perm32(R & 31)) : R;
        voffA[i] = (unsigned)(R * lda + C) * 2u; voffB[i] = (unsigned)(Rb * ldb + C) * 2u; }
    const size_t kstep = (size_t)(BK * 2);
    const size_t hstepA = (size_t)HALF * lda * 2, hstepB = (size_t)HALF * ldb * 2;
    const unsigned ldsw = (unsigned)wid * 1024u;
    const int aoff = lds_byte(wr * 64 + fr, fq * 8), boff = lds_byte(wc * 32 + fr, fq * 8);
#define PG8_SA(b, h) (((b) * 2 + (h)) * HTB)
#define PG8_SB(b, h) ((4 + (b) * 2 + (h)) * HTB)
#define PG8_STAGE(bufoff, gbase, voff) do { _Pragma("unroll") for (int _i = 0; _i < 2; ++_i) \
        __builtin_amdgcn_global_load_lds((const unsigned*)((const char*)(gbase) + (voff)[_i]), (PG8_LAS unsigned*)(lds + (bufoff) + ldsw + _i * 8192), 16, 0, 0); } while (0)
#define PG8_LDA(dst, b, h) do { _Pragma("unroll") for (int m = 0; m < 4; ++m) _Pragma("unroll") for (int k = 0; k < 2; ++k) dst[m][k] = *(const PG8_LAS bf16x8*)(lds + PG8_SA(b, h) + aoff + m * 2048 + k * 1024); } while (0)
#define PG8_LDB(dst, b, h) do { _Pragma("unroll") for (int n = 0; n < 2; ++n) _Pragma("unroll") for (int k = 0; k < 2; ++k) dst[n][k] = *(const PG8_LAS bf16x8*)(lds + PG8_SB(b, h) + boff + n * 2048 + k * 1024); } while (0)
#define PG8_MMA(ai, bj, At, Bt) do { __builtin_amdgcn_s_setprio(1); _Pragma("unroll") for (int m = 0; m < 4; ++m) _Pragma("unroll") for (int n = 0; n < 2; ++n) _Pragma("unroll") for (int k = 0; k < 2; ++k) \
        acc[ai][bj][m][n] = __builtin_amdgcn_mfma_f32_16x16x32_bf16(Bt[n][k], At[m][k], acc[ai][bj][m][n], 0, 0, 0); __builtin_amdgcn_s_setprio(0); } while (0)
#define PG8_WAIT_V(n) asm volatile("s_waitcnt vmcnt(" #n ")" ::: "memory")
#define PG8_WAIT_L(n) asm volatile("s_waitcnt lgkmcnt(" #n ")" ::: "memory")
#define PG8_BAR __builtin_amdgcn_s_barrier()
#define PG8_SCHED __builtin_amdgcn_sched_barrier(0)
    Unit cur, nxt; int ui = 0;
    if (!S.next(0, cur)) return;
    f32x4 acc[2][2][4][2];
#pragma unroll
    for (int a = 0; a < 2; ++a)
#pragma unroll
        for (int b = 0; b < 2; ++b)
#pragma unroll
            for (int m = 0; m < 4; ++m)
#pragma unroll
                for (int n = 0; n < 2; ++n) acc[a][b][m][n] = (f32x4){0.f, 0.f, 0.f, 0.f};
    bf16x8 At[4][2], B0[2][2], B1[2][2];
    const char* cA = cur.A; const char* cB = cur.B;
    if constexpr (SP2) {
        PG8_STAGE(PG8_SB(0, 0), cB, voffB); PG8_STAGE(PG8_SB(0, 1), cB + hstepB, voffB); PG8_STAGE(PG8_SA(0, 0), cA, voffA); PG8_STAGE(PG8_SA(0, 1), cA + hstepA, voffA);
        if (wr == 1) PG8_BAR;
        PG8_WAIT_V(2); PG8_BAR;
        PG8_STAGE(PG8_SB(1, 0), cB + kstep, voffB); PG8_STAGE(PG8_SA(1, 0), cA + kstep, voffA); PG8_STAGE(PG8_SB(1, 1), cB + hstepB + kstep, voffB);
        PG8_WAIT_V(6); PG8_BAR;
    } else {
        PG8_STAGE(PG8_SB(0, 0), cB, voffB); PG8_STAGE(PG8_SA(0, 0), cA, voffA); PG8_STAGE(PG8_SB(0, 1), cB + hstepB, voffB); PG8_STAGE(PG8_SA(0, 1), cA + hstepA, voffA);
        if (wr == 1) PG8_BAR;
        PG8_WAIT_V(4); PG8_BAR;
        PG8_STAGE(PG8_SB(1, 0), cB + kstep, voffB); PG8_STAGE(PG8_SA(1, 0), cA + kstep, voffA); PG8_STAGE(PG8_SB(1, 1), cB + hstepB + kstep, voffB);
        PG8_WAIT_V(6); PG8_BAR;
    }
    for (;;) {
        const bool has_next = S.next(ui + 1, nxt);
        const char* nA = has_next ? nxt.A : cA; const char* nB = has_next ? nxt.B : cB;
        for (int t = 0; t < nt; t += 2) {
            const bool last = (t == nt - 2);
            const char* a1 = cA + (size_t)(t + 1) * kstep;
            const char* a2 = last ? nA : cA + (size_t)(t + 2) * kstep; const char* b2 = last ? nB : cB + (size_t)(t + 2) * kstep;
            const char* a3 = a2 + kstep; const char* b3 = b2 + kstep;
            if constexpr (SP2) {
            PG8_LDB(B0, 0, 0); PG8_LDB(B1, 0, 1); PG8_SCHED; PG8_LDA(At, 0, 0); PG8_STAGE(PG8_SA(1, 1), a1 + hstepA, voffA);
            PG8_WAIT_V(8); PG8_WAIT_L(0); PG8_BAR; PG8_MMA(0, 0, At, B0); PG8_MMA(0, 1, At, B1); PG8_BAR; PG8_SCHED;
            PG8_LDA(At, 0, 1); PG8_STAGE(PG8_SB(0, 0), b2, voffB); PG8_STAGE(PG8_SB(0, 1), b2 + hstepB, voffB); PG8_STAGE(PG8_SA(0, 0), a2, voffA);
            PG8_WAIT_V(8); PG8_WAIT_L(0); PG8_BAR; PG8_MMA(1, 0, At, B0); PG8_MMA(1, 1, At, B1); PG8_BAR; PG8_SCHED;
            PG8_LDB(B0, 1, 0); PG8_LDB(B1, 1, 1); PG8_SCHED; PG8_LDA(At, 1, 0); PG8_STAGE(PG8_SA(0, 1), a2 + hstepA, voffA);
            PG8_WAIT_V(8); PG8_WAIT_L(0); PG8_BAR; PG8_MMA(0, 0, At, B0); PG8_MMA(0, 1, At, B1); PG8_BAR; PG8_SCHED;
            PG8_LDA(At, 1, 1); PG8_STAGE(PG8_SB(1, 0), b3, voffB); PG8_STAGE(PG8_SB(1, 1), b3 + hstepB, voffB); PG8_STAGE(PG8_SA(1, 0), a3, voffA);
            PG8_WAIT_V(8); PG8_WAIT_L(0); PG8_BAR; PG8_MMA(1, 0, At, B0); PG8_MMA(1, 1, At, B1); PG8_BAR; PG8_SCHED;
            } else {
            PG8_LDB(B0, 0, 0); PG8_SCHED; PG8_LDA(At, 0, 0); PG8_STAGE(PG8_SA(1, 1), a1 + hstepA, voffA);
            PG8_WAIT_L(8); PG8_BAR; PG8_WAIT_L(0); PG8_MMA(0, 0, At, B0); PG8_BAR; PG8_SCHED;
            PG8_LDB(B1, 0, 1); PG8_STAGE(PG8_SB(0, 0), b2, voffB);
            PG8_BAR; PG8_WAIT_L(0); PG8_MMA(0, 1, At, B1); PG8_BAR;
            PG8_LDA(At, 0, 1); PG8_STAGE(PG8_SA(0, 0), a2, voffA);
            PG8_BAR; PG8_WAIT_L(0); PG8_MMA(1, 0, At, B0); PG8_BAR; PG8_SCHED;
            PG8_STAGE(PG8_SB(0, 1), b2 + hstepB, voffB);
            PG8_WAIT_V(6); PG8_BAR; PG8_MMA(1, 1, At, B1); PG8_BAR;
            PG8_LDB(B0, 1, 0); PG8_SCHED; PG8_LDA(At, 1, 0); PG8_STAGE(PG8_SA(0, 1), a2 + hstepA, voffA);
            PG8_WAIT_L(8); PG8_BAR; PG8_WAIT_L(0); PG8_MMA(0, 0, At, B0); PG8_BAR; PG8_SCHED;
            PG8_LDB(B1, 1, 1); PG8_STAGE(PG8_SB(1, 0), b3, voffB);
            PG8_BAR; PG8_WAIT_L(0); PG8_MMA(0, 1, At, B1); PG8_BAR;
            PG8_LDA(At, 1, 1); PG8_STAGE(PG8_SA(1, 0), a3, voffA);
            PG8_BAR; PG8_WAIT_L(0); PG8_MMA(1, 0, At, B0); PG8_BAR; PG8_SCHED;
            PG8_STAGE(PG8_SB(1, 1), b3 + hstepB, voffB);
            PG8_WAIT_V(6); PG8_BAR; PG8_MMA(1, 1, At, B1); PG8_BAR;
            }
        }
        if constexpr (ALIGN_EPI) { if (wr == 0) PG8_BAR; }
        { const int l2 = lane_id_asm(); E(acc, cur, wr, wc, l2 & 15, l2 >> 4); }
        if constexpr (false) { E(acc, cur, wr, wc, fr, fq); }
        if (!has_next) break;
#pragma unroll
        for (int a = 0; a < 2; ++a)
#pragma unroll
            for (int b = 0; b < 2; ++b)
#pragma unroll
                for (int m = 0; m < 4; ++m)
#pragma unroll
                    for (int n = 0; n < 2; ++n) acc[a][b][m][n] = (f32x4){0.f, 0.f, 0.f, 0.f};
        cur = nxt; cA = nA; cB = nB; ++ui;
        if constexpr (ALIGN_EPI) { if (wr == 1) PG8_BAR; }
    }
    PG8_WAIT_V(0);
    if constexpr (!ALIGN_EPI) { if (wr == 0) PG8_BAR; }
    PG8_BAR;
    #undef PG8_SA
#undef PG8_SB
#undef PG8_STAGE
#undef PG8_LDA
#undef PG8_LDB
#undef PG8_MMA
#undef PG8_WAIT_V
#undef PG8_WAIT_L
#undef PG8_BAR
#undef PG8_SCHED
}

#define PG8_GAS __attribute__((address_space(1)))
__device__ __forceinline__ float silu_f(float g) { return g * __builtin_amdgcn_rcpf(1.0f + __builtin_amdgcn_exp2f(-1.44269504f * g)); }
struct EpiSwiGLU { static constexpr bool PERM = true, AFTER_DRAIN = false; bf16_t* O; long long ldc; long long skip;
    __device__ __forceinline__ void operator()(const f32x4 (&acc)[2][2][4][2], const Unit& u, int wr, int wc, int fr, int fq) const {
        if (skip) return;
        const int row0 = u.pm * BM + wr * 64 + fr, col0 = u.pn * HALF + wc * 32 + 8 * fq;
#pragma unroll
        for (int ai = 0; ai < 2; ++ai)
#pragma unroll
            for (int m = 0; m < 4; ++m) { bf16_t* rowp = O + (size_t)(row0 + ai * HALF + m * 16) * ldc + col0;
                const f32x4 g0 = acc[ai][0][m][0], g1 = acc[ai][0][m][1], u0 = acc[ai][1][m][0], u1 = acc[ai][1][m][1];
                const f32x4 t0 = g0 * -1.44269504f, t1 = g1 * -1.44269504f, p0 = g0 * u0, p1 = g1 * u1;
                f32x4 d0 = (f32x4){__builtin_amdgcn_exp2f(t0[0]), __builtin_amdgcn_exp2f(t0[1]), __builtin_amdgcn_exp2f(t0[2]), __builtin_amdgcn_exp2f(t0[3])} + 1.0f;
                f32x4 d1 = (f32x4){__builtin_amdgcn_exp2f(t1[0]), __builtin_amdgcn_exp2f(t1[1]), __builtin_amdgcn_exp2f(t1[2]), __builtin_amdgcn_exp2f(t1[3])} + 1.0f;
                const float r00 = __builtin_amdgcn_rcpf(d0[0] * d0[1]), r01 = __builtin_amdgcn_rcpf(d0[2] * d0[3]), r10 = __builtin_amdgcn_rcpf(d1[0] * d1[1]), r11 = __builtin_amdgcn_rcpf(d1[2] * d1[3]);
                const f32x4 o0 = p0 * (f32x4){r00 * d0[1], r00 * d0[0], r01 * d0[3], r01 * d0[2]};
                const f32x4 o1 = p1 * (f32x4){r10 * d1[1], r10 * d1[0], r11 * d1[3], r11 * d1[2]};
                u32x4 w; w.x = cvt_pk_bf16(o0[0], o0[1]); w.y = cvt_pk_bf16(o0[2], o0[3]); w.z = cvt_pk_bf16(o1[0], o1[1]); w.w = cvt_pk_bf16(o1[2], o1[3]);
                *(PG8_GAS u32x4*)rowp = w; }
    }
};
struct EpiBf16 { static constexpr bool PERM = true, AFTER_DRAIN = false; bf16_t* O; long long ldc; const float* rs; float scale; int coff;
    __device__ __forceinline__ void operator()(const f32x4 (&acc)[2][2][4][2], const Unit& u, int wr, int wc, int fr, int fq) const {
        const int row0 = u.pm * BM + wr * 64 + fr, col0 = coff + u.pn * BM + wc * 32 + 8 * fq;
#pragma unroll
        for (int ai = 0; ai < 2; ++ai)
#pragma unroll
            for (int m = 0; m < 4; ++m) { const int row = row0 + ai * HALF + m * 16; bf16_t* rowp = O + (size_t)row * ldc + col0; const float s = rs ? *(const PG8_GAS float*)(rs + row) : scale;
#pragma unroll
                for (int bj = 0; bj < 2; ++bj) { const f32x4 v0 = acc[ai][bj][m][0] * s, v1 = acc[ai][bj][m][1] * s;
                    u32x4 w; w.x = cvt_pk_bf16(v0[0], v0[1]); w.y = cvt_pk_bf16(v0[2], v0[3]); w.z = cvt_pk_bf16(v1[0], v1[1]); w.w = cvt_pk_bf16(v1[2], v1[3]);
                    *(PG8_GAS u32x4*)(rowp + bj * HALF) = w; } }
    }
};
struct EpiResid { static constexpr bool PERM = false, AFTER_DRAIN = false; float* X; const float* g;
    __device__ __forceinline__ void operator()(const f32x4 (&acc)[2][2][4][2], const Unit& u, int wr, int wc, int fr, int fq) const {
        const int row0 = u.pm * BM + wr * 64 + fr, col0 = u.pn * BM + wc * 32 + 4 * fq;
        const float* gp = g + (size_t)((u.pm * BM) >> 13) * 6144 + col0;
        f32x4 gv[2][2];
#pragma unroll
        for (int bj = 0; bj < 2; ++bj)
#pragma unroll
            for (int n = 0; n < 2; ++n) gv[bj][n] = *(const PG8_GAS f32x4*)(gp + bj * HALF + n * 16);
#pragma unroll
        for (int ai = 0; ai < 2; ++ai)
#pragma unroll
            for (int m = 0; m < 4; ++m) { float* rowp = X + (size_t)(row0 + ai * HALF + m * 16) * 1024 + col0;
#pragma unroll
                for (int bj = 0; bj < 2; ++bj)
#pragma unroll
                    for (int n = 0; n < 2; ++n) { PG8_GAS f32x4* p = (PG8_GAS f32x4*)(rowp + bj * HALF + n * 16); *p = *p + gv[bj][n] * acc[ai][bj][m][n]; } }
    }
};
struct EpiResidB { static constexpr bool PERM = true, AFTER_DRAIN = false; bf16_t* X; const float* g;
    __device__ __forceinline__ void operator()(const f32x4 (&acc)[2][2][4][2], const Unit& u, int wr, int wc, int fr, int fq) const {
        const int row0 = u.pm * BM + wr * 64 + fr, col0 = u.pn * BM + wc * 32 + 8 * fq;
        const float* gp = g + (size_t)((u.pm * BM) >> 13) * 6144 + col0;
        f32x4 gv[2][2];
#pragma unroll
        for (int bj = 0; bj < 2; ++bj)
#pragma unroll
            for (int n = 0; n < 2; ++n) gv[bj][n] = *(const PG8_GAS f32x4*)(gp + bj * HALF + n * 4);
#pragma unroll
        for (int ai = 0; ai < 2; ++ai)
#pragma unroll
            for (int m = 0; m < 4; ++m) { bf16_t* rowp = X + (size_t)(row0 + ai * HALF + m * 16) * 1024 + col0;
#pragma unroll
                for (int bj = 0; bj < 2; ++bj) { PG8_GAS u32x4* p = (PG8_GAS u32x4*)(rowp + bj * HALF); const u32x4 xo = *p;
                    const f32x4 a0 = acc[ai][bj][m][0] * gv[bj][0], a1 = acc[ai][bj][m][1] * gv[bj][1];
                    u32x4 w; w.x = cvt_pk_bf16(__builtin_bit_cast(float, xo.x << 16) + a0[0], __builtin_bit_cast(float, xo.x & 0xffff0000u) + a0[1]);
                    w.y = cvt_pk_bf16(__builtin_bit_cast(float, xo.y << 16) + a0[2], __builtin_bit_cast(float, xo.y & 0xffff0000u) + a0[3]);
                    w.z = cvt_pk_bf16(__builtin_bit_cast(float, xo.z << 16) + a1[0], __builtin_bit_cast(float, xo.z & 0xffff0000u) + a1[1]);
                    w.w = cvt_pk_bf16(__builtin_bit_cast(float, xo.w << 16) + a1[2], __builtin_bit_cast(float, xo.w & 0xffff0000u) + a1[3]);
                    *p = w; } }
    }
};
struct EpiF32 { static constexpr bool PERM = false, AFTER_DRAIN = false; float* C; long long ldc;
    __device__ __forceinline__ void operator()(const f32x4 (&acc)[2][2][4][2], const Unit& u, int wr, int wc, int fr, int fq) const {
        const int row0 = u.pm * BM + wr * 64 + fr, col0 = u.pn * BM + wc * 32 + 4 * fq;
#pragma unroll
        for (int ai = 0; ai < 2; ++ai)
#pragma unroll
            for (int m = 0; m < 4; ++m) { float* rowp = C + (size_t)(row0 + ai * HALF + m * 16) * ldc + col0;
#pragma unroll
                for (int bj = 0; bj < 2; ++bj)
#pragma unroll
                    for (int n = 0; n < 2; ++n) *(PG8_GAS f32x4*)(rowp + bj * HALF + n * 16) = acc[ai][bj][m][n]; }
    }
};
struct SchedPlain { const char* A; const char* B; size_t a_tile, b_tile; int nM, nN, G, c, wgm, pad;
    __device__ __forceinline__ bool next(int i, Unit& u) const { int tm, tn; if (!tile_of(i, G, c, nM, nN, wgm, tm, tn)) return false;
        u.pm = tm; u.pn = tn; u.A = A + (size_t)tm * a_tile; u.B = B + (size_t)tn * b_tile; return true; } };
struct SchedMoE { const char* A; const char* B; size_t a_tile, b_tile; int nN, G, c, i0, cnt, pad;
    __device__ __forceinline__ bool next(int i, Unit& u) const { int tm, tn; if (i >= cnt || !tile_of(i + i0, G, c, 128, nN, (nN == 16) ? MOE_WGM_MD : MOE_WGM_ME, tm, tn)) return false;
        const int e = tm >> 3, b = (tm >> 2) & 1, r = tm & 3, pm = ((b * 16 + e) << 2) + r;
        u.pm = pm; u.pn = tn; u.A = A + (size_t)pm * a_tile; u.B = B + (size_t)(e * nN + tn) * b_tile; if (pad) { u.A = A; u.B = B; } return true; } };
}

constexpr int D = 1024, NB = 2, S = 8192, DEPTH = 4, T = NB * S;
constexpr int NG = 4, GD = 256, HD = 64, NH = 16, NKV = 4, WIN = 128, NE = 16, CAP = 1024, DE = 2048, QKVN = 1536;
constexpr float EPS = 1e-6f;
constexpr int NWAVES = 8, NTHR = 512;

constexpr size_t MiB = 1u << 20;
constexpr size_t WS_CTL = 0, CTL_ZERO_BYTES = 32768;
constexpr size_t WS_MOD = 1 * MiB;
constexpr size_t WS_TAB = 2 * MiB;
constexpr size_t WS_MBT = 4 * MiB;
constexpr size_t WS_WQKV = 8 * MiB;
constexpr size_t WS_WAO = 14 * MiB;
constexpr size_t WS_WFO = 18 * MiB;
constexpr size_t WS_WFF = 22 * MiB;
constexpr size_t WS_CS = 30 * MiB;
constexpr size_t WS_AFF = 32 * MiB;
constexpr size_t WS_IDX = 33 * MiB;
constexpr size_t WS_GATE = 33 * MiB + 512 * 1024;
constexpr size_t WS_SLOT = 34 * MiB;
constexpr size_t WS_MISC = 35 * MiB;
constexpr size_t WS_PAR = 36 * MiB;
constexpr int PAR_NMIX = 0, PAR_NFFN = 4096, PAR_QG = 8192, PAR_KG = 8192 + 128, PAR_SINK = 8192 + 256, PAR_WR = 16384;
constexpr size_t WS_H = 64 * MiB;
constexpr size_t WS_XIN = 96 * MiB;
constexpr size_t WS_ACT = 160 * MiB;
constexpr size_t WS_Y = 288 * MiB;
constexpr size_t WS_QKV = 352 * MiB;
constexpr size_t WS_O = 400 * MiB;
constexpr size_t WS_TA = 432 * MiB;
constexpr size_t WS_YF = 464 * MiB;
constexpr size_t WS_PQ = 496 * MiB;
constexpr size_t WS_W1 = 576 * MiB;
constexpr size_t WS_W2 = 1088 * MiB;
constexpr size_t WS_GOLD = 1344 * MiB;
constexpr size_t WS_XB = 1600 * MiB;
constexpr size_t WS_END = 1792 * MiB;
constexpr int CW_BAR = 4096;

constexpr int RING_BYTES = 133120;
constexpr int MISC_OFF = RING_BYTES;
constexpr int LDS_BYTES = 147456;

#define GAS __attribute__((address_space(1)))
#define LAS __attribute__((address_space(3)))
typedef unsigned short bf16;
typedef unsigned v4u __attribute__((ext_vector_type(4)));
typedef unsigned v2u __attribute__((ext_vector_type(2)));
typedef float f32x4 __attribute__((ext_vector_type(4)));
typedef short bf16x8 __attribute__((ext_vector_type(8)));
#define LDS_WAIT() asm volatile("s_waitcnt lgkmcnt(0)" ::: "memory")
#define VM_WAIT() asm volatile("s_waitcnt vmcnt(0)" ::: "memory")
__device__ __forceinline__ unsigned f2bf(float f) { unsigned u = __builtin_bit_cast(unsigned, f); return (u + 0x7fffu + ((u >> 16) & 1u)) >> 16; }
typedef __bf16 bf16x2_t __attribute__((ext_vector_type(2)));
typedef float f32x2_t __attribute__((ext_vector_type(2)));
__device__ __forceinline__ unsigned pk2(float lo, float hi) { const f32x2_t v = {lo, hi}; return __builtin_bit_cast(unsigned, __builtin_convertvector(v, bf16x2_t)); }
__device__ __forceinline__ float bf_lo(unsigned w) { return __builtin_bit_cast(float, w << 16); }
__device__ __forceinline__ float bf_hi(unsigned w) { return __builtin_bit_cast(float, w & 0xffff0000u); }
__device__ __forceinline__ float shx(float v, int o, int lane) { return __builtin_bit_cast(float, __builtin_amdgcn_ds_bpermute((lane ^ o) << 2, __builtin_bit_cast(int, v))); }
__device__ __forceinline__ unsigned shl_from(unsigned v, int src_lane) { return (unsigned)__builtin_amdgcn_ds_bpermute((src_lane & 63) << 2, (int)v); }
__device__ __forceinline__ float wave_sum(float v, int lane) {
#pragma unroll
    for (int o = 1; o < 64; o <<= 1) v += shx(v, o, lane);
    return v;
}

#define XB_TMO      128
#define XB_MISMAP   192
#define XB_XCNT(j)  (256  + 64 * (j))
#define XB_XSUB(j)  (1280 + 64 * (j))
#define XB_XGEN(j)  (2304 + 64 * (j))
#define XB_TOP      3328
#define XB_TOPGEN   3392
#define XCD_BAR_WORDS 3456
#define XB_SPIN_CAP (1u << 18)

__device__ __forceinline__ unsigned xb_ld(unsigned* p)              { return __hip_atomic_load(p, __ATOMIC_RELAXED, __HIP_MEMORY_SCOPE_AGENT); }
__device__ __forceinline__ unsigned xb_add(unsigned* p, unsigned v) { return __hip_atomic_fetch_add(p, v, __ATOMIC_RELAXED, __HIP_MEMORY_SCOPE_AGENT); }
__device__ __forceinline__ unsigned xb_xcc_id() { return (unsigned)__builtin_amdgcn_s_getreg((3 << 11) | 20) & 0xFu; }
#define XB_SPIN(cond, bar) do { unsigned _sp = 0; while (cond) { __builtin_amdgcn_s_sleep(1); \
    if ((++_sp & 255u) == 0u) { if (xb_ld(&(bar)[XB_TMO])) break; if (_sp > XB_SPIN_CAP) { atomicAdd(&(bar)[XB_TMO], 1u); break; } } } } while (0)

struct XcdBarrier {
    unsigned* bar; unsigned x;
    volatile LAS unsigned* st;
};

__device__ __forceinline__ XcdBarrier xcd_barrier_post(unsigned* bar, volatile LAS unsigned* st) {
    XcdBarrier b; b.bar = bar; b.x = xb_xcc_id(); b.st = st;
    if (threadIdx.x == 0) (void)xb_add(&bar[XB_XCNT(b.x)], 1u);
    return b;
}
__device__ __forceinline__ void xcd_barrier_complete(unsigned* bar, unsigned x, unsigned& nloc, unsigned& nx) {
    const unsigned G = gridDim.x * gridDim.y * gridDim.z;
    unsigned sum, cnt, mine, sp = 0u;
    for (;;) {
        sum = 0u; cnt = 0u; mine = 0u;
#pragma unroll
        for (unsigned j = 0; j < 16; ++j) { const unsigned c = xb_ld(&bar[XB_XCNT(j)]); sum += c; cnt += (c > 0u) ? 1u : 0u; mine = (j == x) ? c : mine; }
        if (sum == G) break;
        __builtin_amdgcn_s_sleep(1);
        if ((++sp & 255u) == 0u) { if (xb_ld(&bar[XB_TMO])) break; if (sp > XB_SPIN_CAP) { atomicAdd(&bar[XB_TMO], 1u); break; } }
    }
    nloc = mine > 0u ? mine : 1u; nx = cnt > 0u ? cnt : 1u;
}

__device__ __forceinline__ void xcd_barrier(const XcdBarrier& b, const bool local = false) {
    asm volatile("s_waitcnt vmcnt(0)" ::: "memory");
    __syncthreads();
    if (threadIdx.x == 0) {
        unsigned* bar = b.bar;
        __builtin_amdgcn_s_waitcnt(0);
        unsigned nloc = b.st[0], nx = b.st[1];
        if (nloc == 0u) { xcd_barrier_complete(bar, b.x, nloc, nx); b.st[0] = nloc; b.st[1] = nx; }
        const unsigned old = xb_add(&bar[XB_XSUB(b.x)], 1u);
        const unsigned gen = old / nloc;
        if (old + 1u == (gen + 1u) * nloc) {
            if (!local) {
            __builtin_amdgcn_fence(__ATOMIC_RELEASE, "agent");
            asm volatile("s_waitcnt vmcnt(0)" ::: "memory");
            const unsigned og = xb_add(&bar[XB_TOP], 1u);
            const unsigned tg = og / nx;
            if (og + 1u == (tg + 1u) * nx) xb_add(&bar[XB_TOPGEN], 1u);
            else XB_SPIN(xb_ld(&bar[XB_TOPGEN]) == tg, bar);
            }
            __builtin_amdgcn_fence(__ATOMIC_ACQUIRE, "agent");
            xb_add(&bar[XB_XGEN(b.x)], 1u);
            asm volatile("s_waitcnt vmcnt(0)" ::: "memory");
        } else {
            XB_SPIN(xb_ld(&bar[XB_XGEN(b.x)]) == gen, bar);
            __builtin_amdgcn_fence(__ATOMIC_ACQUIRE, "agent");
            asm volatile("s_waitcnt vmcnt(0)" ::: "memory");
        }
    }
    __syncthreads();
}


struct Params { const float* in[17]; float* out; unsigned char* ws; int ph_lo, ph_hi; };
enum { IN_X = 0, IN_C, IN_WADA, IN_BADA, IN_NMIX, IN_NFFN, IN_WFO, IN_WQKV, IN_WAO, IN_QG, IN_KG, IN_SINK, IN_RELB, IN_WR, IN_WG, IN_WU, IN_WD };
struct Frame { LAS unsigned char* lds; int tid, lane, wave, vcu, G; };

struct CvtItem { const float* src; bf16* dst; int N, ldk; };
__device__ __forceinline__ void cvt_load(const CvtItem& it, f32x4 (&v)[16], int lane) {
    const int kr = lane >> 4, nc = (lane & 15) * 4;
#pragma unroll
    for (int i = 0; i < 16; ++i) v[i] = __builtin_nontemporal_load((const GAS f32x4*)(it.src + (size_t)(4 * i + kr) * it.N + nc));
}
__device__ __forceinline__ void cvt_store(const CvtItem& it, const f32x4 (&v)[16], LAS float* scr, int lane) {
    const int kr = lane >> 4, nc = (lane & 15) * 4;
#pragma unroll
    for (int i = 0; i < 16; ++i) { LAS float* p = scr + (4 * i + kr) * 65 + nc; p[0] = v[i].x; p[1] = v[i].y; p[2] = v[i].z; p[3] = v[i].w; }
    LDS_WAIT(); asm volatile("" ::: "memory");
    const int c = lane & 7;
#pragma unroll
    for (int j = 0; j < 8; ++j) { const int n = (lane >> 3) + 8 * j; const LAS float* s = scr + (8 * c) * 65 + n;
        v4u o; o.x = pk2(s[0 * 65], s[1 * 65]); o.y = pk2(s[2 * 65], s[3 * 65]); o.z = pk2(s[4 * 65], s[5 * 65]); o.w = pk2(s[6 * 65], s[7 * 65]);
        __builtin_nontemporal_store(o, (GAS v4u*)(it.dst + (size_t)n * it.ldk + 8 * c)); }
    LDS_WAIT(); asm volatile("" ::: "memory");
}

__device__ __forceinline__ CvtItem moe_item(const Params& p, int l, int it) {
    bf16* W1 = (bf16*)(p.ws + WS_W1) + (size_t)l * NE * 4096 * 1024; bf16* W2 = (bf16*)(p.ws + WS_W2) + (size_t)l * NE * 1024 * 2048;
    const int kind = it >> 13, r = it & 8191; CvtItem ci;
    if (kind < 2) { const int e = r >> 9, kt = (r >> 5) & 15, ntile = r & 31; const int n0 = ntile * 64, k0 = kt * 64;
        ci.src = (kind ? p.in[IN_WU] : p.in[IN_WG]) + (size_t)l * NE * D * DE + (size_t)e * D * DE + (size_t)k0 * DE + n0; ci.N = DE;
        ci.dst = W1 + ((size_t)e * 4096 + (size_t)(n0 >> 7) * 256 + kind * 128 + (n0 & 127)) * 1024 + k0; ci.ldk = 1024;
    } else { const int e = r >> 9, kt = (r >> 4) & 31, ntile = r & 15; const int n0 = ntile * 64, k0 = kt * 64;
        ci.src = p.in[IN_WD] + (size_t)l * NE * DE * D + (size_t)e * DE * D + (size_t)k0 * D + n0; ci.N = D;
        ci.dst = W2 + ((size_t)e * 1024 + n0) * 2048 + k0; ci.ldk = 2048; }
    return ci;
}
__device__ __forceinline__ void cvt_moe_layer(const Params& p, Frame& F, int l, int w0, int nw, int iend) {
    LAS float* scr = (LAS float*)(F.lds + F.wave * 16640);
    if (w0 >= iend) return;
    f32x4 va[16], vb[16];
    CvtItem ca = moe_item(p, l, w0), cb = ca; cvt_load(ca, va, F.lane);
    for (int it = w0; it < iend; it += 2 * nw) {
        const bool hb = it + nw < iend;
        if (hb) { cb = moe_item(p, l, it + nw); cvt_load(cb, vb, F.lane); }
        cvt_store(ca, va, scr, F.lane);
        const bool ha = it + 2 * nw < iend;
        if (ha) { ca = moe_item(p, l, it + 2 * nw); cvt_load(ca, va, F.lane); }
        if (hb) cvt_store(cb, vb, scr, F.lane);
    }
}

__device__ __forceinline__ void phase_ma(const Params& p, Frame& F, int l, const bool fd, const float* xin32) {
    LAS float* wrp = (LAS float*)F.lds;
    const float* wr = (const float*)(p.ws + WS_PAR) + PAR_WR + (size_t)l * D * NE;
    for (int s = 4 * F.tid; s < D * NE; s += 4 * NTHR) *(LAS f32x4*)(wrp + s) = *(const GAS f32x4*)(wr + s);
    __syncthreads();
    const float* mod = (const float*)(p.ws + WS_MOD) + (size_t)l * NB * 6 * D;
    const float* gain = (const float*)(p.ws + WS_PAR) + PAR_NFFN + l * D;
    const int gw = F.vcu * NWAVES + F.wave, NGW = F.G * NWAVES;
    const int b = (gw * 2) / NGW, wsub = gw - b * (NGW / 2), nsub = NGW / 2;
    f32x4 Av[4], Bv[4];
#pragma unroll
    for (int j = 0; j < 4; ++j) { const int c = 256 * j + 4 * F.lane; const f32x4 g = *(const f32x4*)(gain + c), sc = *(const f32x4*)(mod + b * 6 * D + 4 * D + c);
        Av[j] = g * (sc + 1.0f); Bv[j] = *(const f32x4*)(mod + b * 6 * D + 3 * D + c); }
    bf16* xb = (bf16*)(p.ws + WS_XB); bf16* H = (bf16*)(p.ws + WS_H); float* aff = (float*)(p.ws + WS_AFF);
    const bf16* PQ = (const bf16*)(p.ws + WS_PQ); const float* y4096 = (const float*)(p.ws + WS_MISC);
    f32x4 G1[4];
#pragma unroll
    for (int j = 0; j < 4; ++j) G1[j] = fd ? *(const f32x4*)(mod + b * 6 * D + 2 * D + 256 * j + 4 * F.lane) : (f32x4){0.f, 0.f, 0.f, 0.f};
    const bool xmap = (nsub == 1024);
    const int rb0 = xmap ? ((wsub >> 8) << 11) + (wsub & 255) : wsub, rstep = xmap ? 256 : nsub;
    for (int s0 = rb0; s0 < (xmap ? rb0 + 8 * rstep : S); s0 += 4 * rstep) {
        asm volatile("" ::: "memory");
        f32x4 h[4][4]; float rs[4];
#pragma unroll
        for (int r = 0; r < 4; ++r) { const int row = b * S + s0 + r * rstep; float ss = 0.f;
            if (fd) { const int k = s0 + r * rstep, m = k & 63, qd = k >> 6; int rr; float sg = 1.0f; bool special = false;
                if (m >= 1 && m <= 31) { rr = m * 128 + qd; }
                else if (m >= 33) { const int kp = S - k; rr = (kp & 63) * 128 + (kp >> 6); sg = -1.0f; }
                else if (m == 0) { if (qd <= 63) rr = qd; else if (qd == 64) { rr = 0; special = true; } else { rr = 128 - qd; sg = -1.0f; } }
                else { if (qd <= 63) rr = 64 + qd; else { rr = 64 + (127 - qd); sg = -1.0f; } }
                const bf16* P = PQ + ((size_t)(b * 4096 + rr)) * 2048;
#pragma unroll
                for (int j = 0; j < 4; ++j) { const int cc = 256 * j + 4 * F.lane; f32x4 y;
                    if (special) y = *(const f32x4*)(y4096 + b * 1024 + cc); else { const v2u pw = *(const GAS v2u*)(P + cc), qw = *(const GAS v2u*)(P + 1024 + cc);
                        y.x = bf_lo(pw.x) + sg * bf_lo(qw.x); y.y = bf_hi(pw.x) + sg * bf_hi(qw.x); y.z = bf_lo(pw.y) + sg * bf_lo(qw.y); y.w = bf_hi(pw.y) + sg * bf_hi(qw.y); }
                    f32x4 xo; if (xin32) xo = *(const GAS f32x4*)(xin32 + (size_t)row * D + cc); else { const v2u xw = *(const GAS v2u*)(xb + (size_t)row * D + cc); xo = (f32x4){bf_lo(xw.x), bf_hi(xw.x), bf_lo(xw.y), bf_hi(xw.y)}; }
                    const f32x4 xn = xo + G1[j] * y; v2u ow; ow.x = pk2(xn.x, xn.y); ow.y = pk2(xn.z, xn.w); *(GAS v2u*)(xb + (size_t)row * D + cc) = ow;
                    h[r][j] = (f32x4){bf_lo(ow.x), bf_hi(ow.x), bf_lo(ow.y), bf_hi(ow.y)}; } }
#pragma unroll
            for (int j = 0; j < 4; ++j) { if (!fd) { const v2u xw = *(const GAS v2u*)(xb + (size_t)row * D + 256 * j + 4 * F.lane); h[r][j] = (f32x4){bf_lo(xw.x), bf_hi(xw.x), bf_lo(xw.y), bf_hi(xw.y)}; } ss += (h[r][j].x * h[r][j].x + h[r][j].y * h[r][j].y) + (h[r][j].z * h[r][j].z + h[r][j].w * h[r][j].w); }
            rs[r] = ss; }
#pragma unroll
        for (int r = 0; r < 4; ++r) { const int row = b * S + s0 + r * rstep; const float rstd = rsqrtf(wave_sum(rs[r], F.lane) * (1.0f / D) + EPS);
#pragma unroll
            for (int j = 0; j < 4; ++j) { h[r][j] = h[r][j] * rstd * Av[j] + Bv[j];
                v2u o; o.x = pk2(h[r][j].x, h[r][j].y); o.y = pk2(h[r][j].z, h[r][j].w); *(GAS v2u*)(H + (size_t)row * D + 256 * j + 4 * F.lane) = o; } }
        float th2[4][2];
#pragma unroll
        for (int hh = 0; hh < 2; ++hh) {
            asm volatile("" ::: "memory");
            float v[4][8];
#pragma unroll
            for (int ei = 0; ei < 8; ++ei) { const int e = 8 * hh + ei; float a0 = 0.f, a1 = 0.f, a2 = 0.f, a3 = 0.f;
#pragma unroll
                for (int j = 0; j < 4; ++j) { const LAS float* w = wrp + (((e * 4 + j) * 4) << 6) + F.lane; const float w0 = w[0], w1 = w[64], w2 = w[128], w3 = w[192];
                    a0 += h[0][j].x * w0 + h[0][j].y * w1 + h[0][j].z * w2 + h[0][j].w * w3; a1 += h[1][j].x * w0 + h[1][j].y * w1 + h[1][j].z * w2 + h[1][j].w * w3;
                    a2 += h[2][j].x * w0 + h[2][j].y * w1 + h[2][j].z * w2 + h[2][j].w * w3; a3 += h[3][j].x * w0 + h[3][j].y * w1 + h[3][j].z * w2 + h[3][j].w * w3; }
                v[0][ei] = a0; v[1][ei] = a1; v[2][ei] = a2; v[3][ei] = a3; }
#pragma unroll
            for (int r = 0; r < 4; ++r) { float t4[4], t2[2];
                { const bool hi = (F.lane & 32) != 0;
#pragma unroll
                  for (int i = 0; i < 4; ++i) { const float send = hi ? v[r][i] : v[r][i + 4], keep = hi ? v[r][i + 4] : v[r][i]; t4[i] = keep + shx(send, 32, F.lane); } }
                { const bool hi = (F.lane & 16) != 0;
#pragma unroll
                  for (int i = 0; i < 2; ++i) { const float send = hi ? t4[i] : t4[i + 2], keep = hi ? t4[i + 2] : t4[i]; t2[i] = keep + shx(send, 16, F.lane); } }
                { const bool hi = (F.lane & 8) != 0; const float send = hi ? t2[0] : t2[1], keep = hi ? t2[1] : t2[0]; th2[r][hh] = keep + shx(send, 8, F.lane); } }
        }
#pragma unroll
        for (int r = 0; r < 4; ++r) { float t1;
            { const bool hi = (F.lane & 4) != 0; const float send = hi ? th2[r][0] : th2[r][1], keep = hi ? th2[r][1] : th2[r][0]; t1 = keep + shx(send, 4, F.lane); }
            t1 += shx(t1, 1, F.lane); t1 += shx(t1, 2, F.lane);
            float mx = t1;
#pragma unroll
            for (int o = 4; o < 64; o <<= 1) mx = fmaxf(mx, shx(mx, o, F.lane));
            const float pe = expf(t1 - mx); float sum = pe;
#pragma unroll
            for (int o = 4; o < 64; o <<= 1) sum += shx(sum, o, F.lane);
            const int e = ((F.lane >> 2) & 1) * 8 + ((F.lane >> 5) & 1) * 4 + ((F.lane >> 4) & 1) * 2 + ((F.lane >> 3) & 1);
            if ((F.lane & 3) == 0) aff[((size_t)b * NE + e) * S + s0 + r * rstep] = pe / sum; }
    }
}

__device__ __forceinline__ void phase_mbc(const Params& p, Frame& F) {
    LAS unsigned* hist = (LAS unsigned*)F.lds;
    LAS unsigned* ctl = hist + 8 * 256;
    LAS unsigned* wtot = ctl + 64;
    LAS int* sel = (LAS int*)(wtot + 64);
    const float* aff = (const float*)(p.ws + WS_AFF); float* gate = (float*)(p.ws + WS_GATE); int* slotmap = (int*)(p.ws + WS_SLOT);
    const bf16* H = (const bf16*)(p.ws + WS_H); bf16* X = (bf16*)(p.ws + WS_XIN);
    const int nsub = (F.G >= 8 * NB * NE) ? 8 : 1;
    for (int zz = F.vcu; zz < NB * NE * nsub; zz += F.G) {
        int z = zz / nsub, sub = zz - z * nsub;
        if (nsub == 8 && F.G == 256) { const int xg = zz >> 5, j = (zz >> 3) & 3; z = (j & 1) * 16 + 2 * xg + (j >> 1); sub = zz & 7; }
        unsigned key[16];
#pragma unroll
        for (int q = 0; q < 4; ++q) { const v4u k4 = *(const GAS v4u*)(aff + (size_t)z * S + F.tid * 16 + 4 * q); key[4 * q] = k4.x; key[4 * q + 1] = k4.y; key[4 * q + 2] = k4.z; key[4 * q + 3] = k4.w; }
        unsigned prefix = 0u, need = CAP;
#pragma unroll
        for (int pass = 0; pass < 4; ++pass) {
            const int shift = 24 - 8 * pass;
            __syncthreads();
            for (int i = F.tid; i < 8 * 256; i += NTHR) hist[i] = 0u;
            __syncthreads();
            LAS unsigned* myh = hist + F.wave * 256;
#pragma unroll
            for (int u = 0; u < 16; ++u) { const unsigned hi = (pass == 0) ? 0u : (key[u] >> ((shift + 8) & 31)); if (hi == prefix) atomicAdd((unsigned*)&myh[(key[u] >> shift) & 255u], 1u); }
            __syncthreads();
            if (F.wave == 0) {
                unsigned h0 = 0u, h1 = 0u, h2 = 0u, h3 = 0u;
#pragma unroll
                for (int w = 0; w < 8; ++w) { const LAS unsigned* hw = hist + w * 256 + 4 * F.lane; h0 += hw[0]; h1 += hw[1]; h2 += hw[2]; h3 += hw[3]; }
                const unsigned tot = h0 + h1 + h2 + h3; unsigned suf = tot;
#pragma unroll
                for (int o = 1; o < 64; o <<= 1) { const unsigned t = shl_from(suf, F.lane + o); if (F.lane + o < 64) suf += t; }
                unsigned cum = suf - tot;
                if (cum < need && need <= cum + tot) {
                    unsigned d = 4 * F.lane + 3, c = h3;
                    if (cum + c < need) { cum += c; d = 4 * F.lane + 2; c = h2;
                        if (cum + c < need) { cum += c; d = 4 * F.lane + 1; c = h1;
                            if (cum + c < need) { cum += c; d = 4 * F.lane; c = h0; } } }
                    ctl[0] = (prefix << 8) | d; ctl[1] = need - cum; }
            }
            __syncthreads();
            prefix = ctl[0]; need = ctl[1];
        }
        unsigned cnt = 0u;
#pragma unroll
        for (int u = 0; u < 16; ++u) cnt += (key[u] > prefix ? 1u : 0u) + (key[u] == prefix ? 65536u : 0u);
        unsigned inc = cnt;
#pragma unroll
        for (int o = 1; o < 64; o <<= 1) { const unsigned t = shl_from(inc, F.lane - o); if (F.lane >= o) inc += t; }
        if (F.lane == 63) wtot[F.wave] = inc;
        __syncthreads();
        unsigned base = inc - cnt;
        for (int w = 0; w < F.wave; ++w) base += wtot[w];
        unsigned ng = base & 0xffffu, ne = base >> 16;
#pragma unroll
        for (int u = 0; u < 16; ++u) { const int i = F.tid * 16 + u; const bool gt = key[u] > prefix, eq = key[u] == prefix; const bool selq = gt || (eq && ne < need);
            const int slot = (int)(ng + (ne < need ? ne : need));
            const bool mine = (nsub == 1) || ((u & (nsub - 1)) == sub);
            if (selq) { sel[slot] = i; if (mine) gate[z * CAP + slot] = __builtin_bit_cast(float, key[u]); }
            if (mine) slotmap[((size_t)(z >> 4) * S + i) * NE + (z & 15)] = selq ? slot : -1;
            ng += gt ? 1u : 0u; ne += eq ? 1u : 0u; }
        __syncthreads();
        const int per = CAP / nsub, b = z >> 4;
        for (int s = F.wave; s < per; s += NWAVES) { const int slot = sub * per + s; const int src = b * S + sel[slot];
            const GAS v4u* sp = (const GAS v4u*)(H + (size_t)src * D) + F.lane; GAS v4u* dp = (GAS v4u*)(X + ((size_t)z * CAP + slot) * D) + F.lane;
            const v4u a = sp[0], cc = sp[64]; dp[0] = a; dp[64] = cc; }
    }
}

__device__ __forceinline__ void phase_mf(const Params& p, Frame& F, int l, const bool dry) {
    const int* slotmap = (const int*)(p.ws + WS_SLOT); const bf16* Y = (const bf16*)(p.ws + WS_Y); bf16* xb = (bf16*)(p.ws + WS_XB); bf16* xbo = (bf16*)(p.ws + (dry ? WS_GOLD : WS_XB)); float* xo32 = dry ? (float*)(p.ws + WS_GOLD) : p.out; bf16* H = (bf16*)(p.ws + (dry ? WS_GOLD + 128 * MiB : WS_H));
    const float* mod = (const float*)(p.ws + WS_MOD) + (size_t)l * NB * 6 * D;
    const bool nxt = (l + 1 < DEPTH);
    const float* modn = mod + NB * 6 * D; const float* gainn = (const float*)(p.ws + WS_PAR) + PAR_NMIX + (l + 1) * D;
    const int gw = F.vcu * NWAVES + F.wave, NGW = F.G * NWAVES;
    const int b = (gw * 2) / NGW, wsub = gw - b * (NGW / 2), nsub = NGW / 2;
    const bool xmap = (nsub == 1024); const int rb0 = xmap ? ((wsub >> 8) << 11) + (wsub & 255) : wsub, rstep = xmap ? 256 : nsub;
    f32x4 g2v[2][2], Anv[2][2], Bnv[2][2];
#pragma unroll
    for (int j = 0; j < 2; ++j) { const int c0 = 512 * j + 8 * F.lane; const f32x4* gp = (const f32x4*)(mod + b * 6 * D + 5 * D + c0); g2v[j][0] = gp[0]; g2v[j][1] = gp[1];
#pragma unroll
        for (int hf = 0; hf < 2; ++hf) { if (nxt) { const f32x4 gn = *(const f32x4*)(gainn + c0 + 4 * hf), sn = *(const f32x4*)(modn + b * 6 * D + 1 * D + c0 + 4 * hf); Anv[j][hf] = gn * (sn + 1.0f); Bnv[j][hf] = *(const f32x4*)(modn + b * 6 * D + c0 + 4 * hf); }
            else { Anv[j][hf] = (f32x4){0.f, 0.f, 0.f, 0.f}; Bnv[j][hf] = Anv[j][hf]; } } }
    for (int s4 = rb0; s4 < (xmap ? rb0 + 8 * rstep : S); s4 += 4 * rstep) {
      const int slv = slotmap[((size_t)b * S + s4 + (F.lane >> 4) * rstep) * NE + (F.lane & 15)];
      const unsigned long long selmask = __builtin_amdgcn_ballot_w64(slv >= 0);
#pragma unroll
      for (int k = 0; k < 4; ++k) { const int s = s4 + k * rstep, row = b * S + s;
        unsigned m = (unsigned)(selmask >> (16 * k)) & 0xffffu;
        f32x4 xv[4];
#pragma unroll
        for (int j = 0; j < 2; ++j) { const v4u xw = *(const GAS v4u*)(xb + (size_t)row * D + 512 * j + 8 * F.lane);
            xv[2 * j] = (f32x4){bf_lo(xw.x), bf_hi(xw.x), bf_lo(xw.y), bf_hi(xw.y)}; xv[2 * j + 1] = (f32x4){bf_lo(xw.z), bf_hi(xw.z), bf_lo(xw.w), bf_hi(xw.w)}; }
        float acc[16];
#pragma unroll
        for (int i = 0; i < 16; ++i) acc[i] = 0.f;
        while (m) {
            int ex[4]; int cnt = 0;
#pragma unroll
            for (int j = 0; j < 4; ++j) { if (m) { ex[j] = __builtin_ctz(m); m &= m - 1u; cnt = j + 1; } else ex[j] = ex[0]; }
            v4u ya[4], yc[4];
#pragma unroll
            for (int j = 0; j < 4; ++j) { const int sj = __builtin_amdgcn_readlane(slv, k * 16 + ex[j]);
                const GAS v4u* yp = (const GAS v4u*)(Y + ((size_t)(b * NE + ex[j]) * CAP + sj) * D) + F.lane; ya[j] = yp[0]; yc[j] = yp[64]; }
#pragma unroll
            for (int j = 0; j < 4; ++j) if (j < cnt) { const v4u a = ya[j], c = yc[j];
                acc[0] += bf_lo(a.x); acc[1] += bf_hi(a.x); acc[2] += bf_lo(a.y); acc[3] += bf_hi(a.y); acc[4] += bf_lo(a.z); acc[5] += bf_hi(a.z); acc[6] += bf_lo(a.w); acc[7] += bf_hi(a.w);
                acc[8] += bf_lo(c.x); acc[9] += bf_hi(c.x); acc[10] += bf_lo(c.y); acc[11] += bf_hi(c.y); acc[12] += bf_lo(c.z); acc[13] += bf_hi(c.z); acc[14] += bf_lo(c.w); acc[15] += bf_hi(c.w); } }
        float ss = 0.f;
#pragma unroll
        for (int j = 0; j < 2; ++j) { const int c0 = 512 * j + 8 * F.lane;
            const f32x4 g0 = g2v[j][0], g1 = g2v[j][1]; f32x4 x0 = xv[2 * j], x1 = xv[2 * j + 1];
            x0.x += g0.x * acc[8 * j + 0]; x0.y += g0.y * acc[8 * j + 1]; x0.z += g0.z * acc[8 * j + 2]; x0.w += g0.w * acc[8 * j + 3];
            x1.x += g1.x * acc[8 * j + 4]; x1.y += g1.y * acc[8 * j + 5]; x1.z += g1.z * acc[8 * j + 6]; x1.w += g1.w * acc[8 * j + 7];
            if (nxt) { v4u ow; ow.x = pk2(x0.x, x0.y); ow.y = pk2(x0.z, x0.w); ow.z = pk2(x1.x, x1.y); ow.w = pk2(x1.z, x1.w); *(GAS v4u*)(xbo + (size_t)row * D + c0) = ow;
                x0 = (f32x4){bf_lo(ow.x), bf_hi(ow.x), bf_lo(ow.y), bf_hi(ow.y)}; x1 = (f32x4){bf_lo(ow.z), bf_hi(ow.z), bf_lo(ow.w), bf_hi(ow.w)}; }
            else { GAS f32x4* xp = (GAS f32x4*)(xo32 + (size_t)row * D + c0); xp[0] = x0; xp[1] = x1; }
            acc[8 * j + 0] = x0.x; acc[8 * j + 1] = x0.y; acc[8 * j + 2] = x0.z; acc[8 * j + 3] = x0.w; acc[8 * j + 4] = x1.x; acc[8 * j + 5] = x1.y; acc[8 * j + 6] = x1.z; acc[8 * j + 7] = x1.w;
            ss += (x0.x * x0.x + x0.y * x0.y) + (x0.z * x0.z + x0.w * x0.w) + (x1.x * x1.x + x1.y * x1.y) + (x1.z * x1.z + x1.w * x1.w); }
        if (nxt) { const float rstd = rsqrtf(wave_sum(ss, F.lane) * (1.0f / D) + EPS);
#pragma unroll
            for (int j = 0; j < 2; ++j) { const int c0 = 512 * j + 8 * F.lane; v4u o; float hv[8];
#pragma unroll
                for (int i = 0; i < 8; ++i) hv[i] = acc[8 * j + i] * rstd * Anv[j][i >> 2][i & 3] + Bnv[j][i >> 2][i & 3];
                o.x = pk2(hv[0], hv[1]); o.y = pk2(hv[2], hv[3]); o.z = pk2(hv[4], hv[5]); o.w = pk2(hv[6], hv[7]); *(GAS v4u*)(H + (size_t)row * D + c0) = o; } }
      }
    }
}


#define MFMA16(a, b, c) __builtin_amdgcn_mfma_f32_16x16x32_bf16((a), (b), (c), 0, 0, 0)
typedef short s16x4 __attribute__((ext_vector_type(4)));
__device__ __forceinline__ unsigned lds_addr(LAS void* p) { return (unsigned)(size_t)p; }
__device__ __forceinline__ bf16x8 tr_frag(unsigned a0, unsigned a1) {
    s16x4 lo, hi;
    asm volatile("ds_read_b64_tr_b16 %0, %2\n\tds_read_b64_tr_b16 %1, %3\n\ts_waitcnt lgkmcnt(0)" : "=&v"(lo), "=&v"(hi) : "v"(a0), "v"(a1) : "memory");
    return __builtin_shufflevector(lo, hi, 0, 1, 2, 3, 4, 5, 6, 7);
}
__device__ __forceinline__ void tr_frag4(unsigned a0, unsigned a1, unsigned a2, unsigned a3, unsigned a4, unsigned a5, unsigned a6, unsigned a7, bf16x8& f0, bf16x8& f1, bf16x8& f2, bf16x8& f3) {
    s16x4 r0, r1, r2, r3, r4, r5, r6, r7;
    asm volatile("ds_read_b64_tr_b16 %0, %8\n\tds_read_b64_tr_b16 %1, %9\n\tds_read_b64_tr_b16 %2, %10\n\tds_read_b64_tr_b16 %3, %11\n\t"
                 "ds_read_b64_tr_b16 %4, %12\n\tds_read_b64_tr_b16 %5, %13\n\tds_read_b64_tr_b16 %6, %14\n\tds_read_b64_tr_b16 %7, %15\n\ts_waitcnt lgkmcnt(0)"
                 : "=&v"(r0), "=&v"(r1), "=&v"(r2), "=&v"(r3), "=&v"(r4), "=&v"(r5), "=&v"(r6), "=&v"(r7)
                 : "v"(a0), "v"(a1), "v"(a2), "v"(a3), "v"(a4), "v"(a5), "v"(a6), "v"(a7) : "memory");
    f0 = __builtin_shufflevector(r0, r1, 0, 1, 2, 3, 4, 5, 6, 7); f1 = __builtin_shufflevector(r2, r3, 0, 1, 2, 3, 4, 5, 6, 7);
    f2 = __builtin_shufflevector(r4, r5, 0, 1, 2, 3, 4, 5, 6, 7); f3 = __builtin_shufflevector(r6, r7, 0, 1, 2, 3, 4, 5, 6, 7);
}
__device__ __forceinline__ unsigned off_b(unsigned row, unsigned ch) { return 256u * row + 16u * (ch ^ (((row & 3u) << 2) | ((row >> 2) & 3u))); }
__device__ __forceinline__ unsigned tr_read_addr_16(unsigned lane, unsigned c, unsigned ks, unsigned t) {
    const unsigned g = lane >> 4, q = (lane & 15) >> 2, pp = lane & 3;
    return off_b(32 * ks + 8 * g + 4 * t + q, 2 * c + (pp >> 1)) + 8 * (pp & 1);
}

__device__ __forceinline__ void phase_aa(const Params& p, Frame& F, int l, const float* x) {
    const float* mod = (const float*)(p.ws + WS_MOD) + (size_t)l * NB * 6 * D; const float* gain = (const float*)(p.ws + WS_PAR) + PAR_NMIX + l * D;
    const int gw = F.vcu * NWAVES + F.wave, NGW = F.G * NWAVES;
    const int b = (gw * 2) / NGW, wsub = gw - b * (NGW / 2), nsub = NGW / 2;
    f32x4 Av[4], Bv[4];
#pragma unroll
    for (int j = 0; j < 4; ++j) { const int c = 256 * j + 4 * F.lane; const f32x4 g = *(const f32x4*)(gain + c), sc = *(const f32x4*)(mod + b * 6 * D + 1 * D + c);
        Av[j] = g * (sc + 1.0f); Bv[j] = *(const f32x4*)(mod + b * 6 * D + 0 * D + c); }
    bf16* H = (bf16*)(p.ws + WS_H);
    for (int s = wsub; s < S; s += nsub) {
        const int row = b * S + s;
        asm volatile("" ::: "memory");
        f32x4 h[4]; float ss = 0.f;
#pragma unroll
        for (int j = 0; j < 4; ++j) { h[j] = *(const GAS f32x4*)(x + (size_t)row * D + 256 * j + 4 * F.lane); ss += (h[j].x * h[j].x + h[j].y * h[j].y) + (h[j].z * h[j].z + h[j].w * h[j].w); }
        const float rstd = rsqrtf(wave_sum(ss, F.lane) * (1.0f / D) + EPS);
#pragma unroll
        for (int j = 0; j < 4; ++j) { h[j] = h[j] * rstd * Av[j] + Bv[j];
            v2u o; o.x = pk2(h[j].x, h[j].y); o.y = pk2(h[j].z, h[j].w); *(GAS v2u*)(H + (size_t)row * D + 256 * j + 4 * F.lane) = o; }
    }
}

constexpr float ATT_COFF = 16.0f;
constexpr int AT_KP = 144, AT_VP = 160;
constexpr int AT_KOFF = 0, AT_VOFF = 384 * AT_KP, AT_BOFF = AT_VOFF + 384 * AT_VP;
__device__ __forceinline__ void phase_ac(const Params& p, Frame& F, int l) {
    const int jl = l >> 1;
    const bf16* QKV = (const bf16*)(p.ws + WS_QKV); bf16* O = (bf16*)(p.ws + WS_O);
    const float* biasrel = (const float*)(p.ws + WS_TAB);
    const float* par = (const float*)(p.ws + WS_PAR); const float* qg = par + PAR_QG + jl * HD; const float* kg = par + PAR_KG + jl * HD; const float* sink = par + PAR_SINK + jl * NH;
    LAS unsigned char* Kimg = F.lds + AT_KOFF; LAS unsigned char* Vimg = F.lds + AT_VOFF; LAS float* btab = (LAS float*)(F.lds + AT_BOFF);
    const int lane = F.lane, g4 = lane >> 4, ql = lane & 15;
    const int hq = F.wave >> 1, th = F.wave & 1;
    constexpr float LOG2E = 1.44269504f;
    for (int U = F.vcu; U < NB * 64 * NKV; U += F.G) {
        int b = U >> 8, n = (U >> 2) & 63, kvh = U & 3;
        if (F.G == 256) { const int xg = F.vcu >> 5, lu = (F.vcu & 31) + ((U >= 256) ? 32 : 0); b = xg >> 2; n = 16 * (xg & 3) + (lu >> 2); kvh = lu & 3; }
        const int h = kvh * 4 + hq;
        __syncthreads();
        { const int part = F.tid & 7; f32x4 kg0 = *(const f32x4*)(kg + part * 8), kg1 = *(const f32x4*)(kg + part * 8 + 4);
          v4u kqa[6], vqa[6];
#pragma unroll
          for (int i = 0; i < 6; ++i) { const int row = (F.tid >> 3) + 64 * i; const int kpos = n * 128 - 128 + row; const bool ok = (kpos >= 0) && (kpos < S);
              kqa[i] = (v4u){0u, 0u, 0u, 0u}; vqa[i] = (v4u){0u, 0u, 0u, 0u};
              if (ok) { const bf16* base = QKV + ((size_t)b * S + kpos) * QKVN + NH * HD + kvh * HD + part * 8; kqa[i] = *(const GAS v4u*)base; vqa[i] = *(const GAS v4u*)(base + NKV * HD); } }
#pragma unroll
          for (int i = 0; i < 6; ++i) { const int row = (F.tid >> 3) + 64 * i; const v4u kq = kqa[i], vq = vqa[i];
              float f[8] = {bf_lo(kq.x), bf_hi(kq.x), bf_lo(kq.y), bf_hi(kq.y), bf_lo(kq.z), bf_hi(kq.z), bf_lo(kq.w), bf_hi(kq.w)};
              float ss = 0.f;
#pragma unroll
              for (int e = 0; e < 8; ++e) ss += f[e] * f[e];
              ss += shx(ss, 1, F.lane); ss += shx(ss, 2, F.lane); ss += shx(ss, 4, F.lane);
              const float r = rsqrtf(ss * (1.0f / HD) + EPS);
              v4u ko; ko.x = pk2(f[0] * r * kg0.x, f[1] * r * kg0.y); ko.y = pk2(f[2] * r * kg0.z, f[3] * r * kg0.w); ko.z = pk2(f[4] * r * kg1.x, f[5] * r * kg1.y); ko.w = pk2(f[6] * r * kg1.z, f[7] * r * kg1.w);
              *(LAS v4u*)(Kimg + row * AT_KP + part * 16) = ko; *(LAS v4u*)(Vimg + row * AT_VP + part * 16) = vq; } }
        for (int i = F.tid; i < 4 * 257; i += NTHR) { const int gg = i / 257, r = i - gg * 257; btab[gg * 260 + r] = biasrel[(kvh * 4 + gg) * 257 + r] - ATT_COFF; }
        __syncthreads();
        const float sk = sink[h] * LOG2E - ATT_COFF;
        const LAS float* bt = btab + hq * 260;
        const unsigned vbase = lds_addr(Vimg) + (unsigned)(((lane & 15) >> 2) * AT_VP + (lane & 3) * 8);
        f32x4 qa[2][2];
        const bf16x8 ones8 = __builtin_bit_cast(bf16x8, (v4u){0x3f803f80u, 0x3f803f80u, 0x3f803f80u, 0x3f803f80u});
#pragma unroll
        for (int ds = 0; ds < 2; ++ds) { qa[ds][0] = *(const f32x4*)(qg + 32 * ds + 8 * g4); qa[ds][1] = *(const f32x4*)(qg + 32 * ds + 8 * g4 + 4); }
#pragma unroll 1
        for (int qh = 0; qh < 2; ++qh) {
            bf16x8 qf[2][2];
#pragma unroll
            for (int q2 = 0; q2 < 2; ++q2) { const int tok = n * 128 + th * 64 + 32 * qh + 16 * q2 + ql; const bf16* qp = QKV + ((size_t)b * S + tok) * QKVN + h * HD + 8 * g4;
                const v4u w0 = *(const GAS v4u*)qp, w1 = *(const GAS v4u*)(qp + 32);
                float f[16] = {bf_lo(w0.x), bf_hi(w0.x), bf_lo(w0.y), bf_hi(w0.y), bf_lo(w0.z), bf_hi(w0.z), bf_lo(w0.w), bf_hi(w0.w), bf_lo(w1.x), bf_hi(w1.x), bf_lo(w1.y), bf_hi(w1.y), bf_lo(w1.z), bf_hi(w1.z), bf_lo(w1.w), bf_hi(w1.w)};
                float ss = 0.f;
#pragma unroll
                for (int e = 0; e < 16; ++e) ss += f[e] * f[e];
                ss += shx(ss, 16, F.lane); ss += shx(ss, 32, F.lane);
                const float r = rsqrtf(ss * (1.0f / HD) + EPS) * (0.125f * LOG2E);
#pragma unroll
                for (int ds = 0; ds < 2; ++ds) { v4u o; o.x = pk2(f[8 * ds + 0] * r * qa[ds][0].x, f[8 * ds + 1] * r * qa[ds][0].y); o.y = pk2(f[8 * ds + 2] * r * qa[ds][0].z, f[8 * ds + 3] * r * qa[ds][0].w);
                    o.z = pk2(f[8 * ds + 4] * r * qa[ds][1].x, f[8 * ds + 5] * r * qa[ds][1].y); o.w = pk2(f[8 * ds + 6] * r * qa[ds][1].z, f[8 * ds + 7] * r * qa[ds][1].w);
                    qf[q2][ds] = __builtin_bit_cast(bf16x8, o); } }
            f32x4 osum[2]; f32x4 oacc[4][2];
#pragma unroll
            for (int q2 = 0; q2 < 2; ++q2) { osum[q2] = (f32x4){0.f, 0.f, 0.f, 0.f};
#pragma unroll
                for (int db = 0; db < 4; ++db) oacc[db][q2] = (f32x4){0.f, 0.f, 0.f, 0.f}; }
#pragma unroll 1
            for (int c = th; c < th + 5; ++c) {
                bf16x8 kf[4][2];
#pragma unroll
                for (int kb = 0; kb < 4; ++kb)
#pragma unroll
                    for (int ds = 0; ds < 2; ++ds) kf[kb][ds] = *(const LAS bf16x8*)(Kimg + (64 * c + 16 * kb + ql) * AT_KP + (32 * ds + 8 * g4) * 2);
                bf16x8 pf[2][2];
#pragma unroll
                for (int q2 = 0; q2 < 2; ++q2) { const int q0 = th * 64 + 32 * qh + 16 * q2, qoff = q0 + ql;
                    f32x4 sacc[4];
                    const bool full = (64 * c - 143 - q0 >= -128) && (64 * c - 65 - q0 <= 128) && (n * 128 + 64 * c - 128 >= 0) && (n * 128 + 64 * c - 65 < S);
                    if (full) { const LAS float* bp = bt + (64 * c + 4 * g4 - qoff);
#pragma unroll
                        for (int kb = 0; kb < 4; ++kb) sacc[kb] = (f32x4){bp[16 * kb], bp[16 * kb + 1], bp[16 * kb + 2], bp[16 * kb + 3]};
                    } else {
#pragma unroll
                        for (int kb = 0; kb < 4; ++kb)
#pragma unroll
                            for (int j = 0; j < 4; ++j) { const int koff = 64 * c + 16 * kb + 4 * g4 + j - 128; const int rel = koff - qoff; const int kpos = n * 128 + koff;
                                const bool ok = ((unsigned)(rel + 128) <= 256u) && (kpos >= 0) && (kpos < S);
                                sacc[kb][j] = ok ? bt[ok ? rel + 128 : 0] : -1e30f; } }
                    float pv[4][4];
#pragma unroll
                    for (int kb = 0; kb < 4; ++kb) { f32x4 a = MFMA16(kf[kb][0], qf[q2][0], sacc[kb]); a = MFMA16(kf[kb][1], qf[q2][1], a);
#pragma unroll
                        for (int j = 0; j < 4; ++j) pv[kb][j] = __builtin_amdgcn_exp2f(a[j]); }
#pragma unroll
                    for (int ks2 = 0; ks2 < 2; ++ks2) { v4u o; o.x = pk2(pv[2 * ks2][0], pv[2 * ks2][1]); o.y = pk2(pv[2 * ks2][2], pv[2 * ks2][3]); o.z = pk2(pv[2 * ks2 + 1][0], pv[2 * ks2 + 1][1]); o.w = pk2(pv[2 * ks2 + 1][2], pv[2 * ks2 + 1][3]);
                        pf[q2][ks2] = __builtin_bit_cast(bf16x8, o); } }
#pragma unroll
                for (int ks2 = 0; ks2 < 2; ++ks2) { const unsigned a0 = vbase + (unsigned)((64 * c + 32 * ks2 + 4 * g4) * AT_VP); bf16x8 v0, v1, v2, v3;
                    tr_frag4(a0, a0 + 16u * AT_VP, a0 + 32u, a0 + 32u + 16u * AT_VP, a0 + 64u, a0 + 64u + 16u * AT_VP, a0 + 96u, a0 + 96u + 16u * AT_VP, v0, v1, v2, v3);
                    oacc[0][0] = MFMA16(v0, pf[0][ks2], oacc[0][0]); oacc[0][1] = MFMA16(v0, pf[1][ks2], oacc[0][1]); oacc[1][0] = MFMA16(v1, pf[0][ks2], oacc[1][0]); oacc[1][1] = MFMA16(v1, pf[1][ks2], oacc[1][1]);
                    oacc[2][0] = MFMA16(v2, pf[0][ks2], oacc[2][0]); oacc[2][1] = MFMA16(v2, pf[1][ks2], oacc[2][1]); oacc[3][0] = MFMA16(v3, pf[0][ks2], oacc[3][0]); oacc[3][1] = MFMA16(v3, pf[1][ks2], oacc[3][1]);
                    osum[0] = MFMA16(ones8, pf[0][ks2], osum[0]); osum[1] = MFMA16(ones8, pf[1][ks2], osum[1]); }
            }
#pragma unroll
            for (int q2 = 0; q2 < 2; ++q2) { const float lt = osum[q2].x + __builtin_amdgcn_exp2f(sk);
                const float inv = 1.0f / lt; const int tok = n * 128 + th * 64 + 32 * qh + 16 * q2 + ql; bf16* op = O + ((size_t)b * S + tok) * D + h * HD + 4 * g4;
#pragma unroll
                for (int db = 0; db < 4; ++db) { const f32x4 v = oacc[db][q2] * inv; v2u o; o.x = pk2(v.x, v.y); o.y = pk2(v.z, v.w); *(GAS v2u*)(op + 16 * db) = o; } }
        }
    }
}

__device__ __forceinline__ void phase_fa(const Params& p, Frame& F, int l, const float* xraw) {
    const bf16* H = (const bf16*)(p.ws + WS_H); bf16* TA = (bf16*)(p.ws + WS_TA);
    const bf16* R64B = (const bf16*)(p.ws + WS_TAB + 65536);
    const int lane = F.lane, g4 = lane >> 4, ql = lane & 15;
    for (int U = F.vcu; U < NB * 128; U += F.G) {
        const int b = U >> 7, s2 = U & 127;
        __syncthreads();
        if (xraw) {
            const float* mod = (const float*)(p.ws + WS_MOD) + (size_t)l * NB * 6 * D; const float* gain = (const float*)(p.ws + WS_PAR) + PAR_NMIX + l * D;
            f32x4 Av[4], Bv[4];
#pragma unroll
            for (int j = 0; j < 4; ++j) { const int c = 256 * j + 4 * lane; const f32x4 g = *(const f32x4*)(gain + c), sc = *(const f32x4*)(mod + b * 6 * D + 1 * D + c);
                Av[j] = g * (sc + 1.0f); Bv[j] = *(const f32x4*)(mod + b * 6 * D + 0 * D + c); }
#pragma unroll 1
            for (int r4 = 0; r4 < 2; ++r4) { f32x4 h[4][4];
#pragma unroll
                for (int r = 0; r < 4; ++r)
#pragma unroll
                    for (int j = 0; j < 4; ++j) h[r][j] = *(const GAS f32x4*)(xraw + ((size_t)b * S + 128 * (F.wave * 8 + r4 * 4 + r) + s2) * D + 256 * j + 4 * lane);
#pragma unroll
                for (int r = 0; r < 4; ++r) { const int s1 = F.wave * 8 + r4 * 4 + r; float ss = 0.f;
#pragma unroll
                    for (int j = 0; j < 4; ++j) ss += (h[r][j].x * h[r][j].x + h[r][j].y * h[r][j].y) + (h[r][j].z * h[r][j].z + h[r][j].w * h[r][j].w);
                    const float rstd = rsqrtf(wave_sum(ss, lane) * (1.0f / D) + EPS);
#pragma unroll
                    for (int j = 0; j < 4; ++j) { const f32x4 hv = h[r][j] * rstd * Av[j] + Bv[j]; const int c = 256 * j + 4 * lane;
                        v2u o; o.x = pk2(hv.x, hv.y); o.y = pk2(hv.z, hv.w); *(LAS v2u*)(F.lds + (c >> 7) * 16384 + off_b(s1, (c & 127) >> 3) + (c & 7) * 2) = o; } } }
        } else {
#pragma unroll 4
            for (int i = 0; i < 16; ++i) { const int q = F.tid + 512 * i, row = q >> 7, c128 = q & 127;
                const v4u v = *(const GAS v4u*)(H + ((size_t)b * S + 128 * row + s2) * D + c128 * 8);
                *(LAS v4u*)(F.lds + (c128 >> 4) * 16384 + off_b(row, c128 & 15)) = v; }
        }
        bf16x8 rf[4][2];
#pragma unroll
        for (int rb = 0; rb < 4; ++rb)
#pragma unroll
            for (int ks = 0; ks < 2; ++ks) rf[rb][ks] = *(const GAS bf16x8*)(R64B + (16 * rb + ql) * 64 + 32 * ks + 8 * g4);
        __syncthreads();
        const unsigned ibase = lds_addr(F.lds) + F.wave * 16384;
#pragma unroll 1
        for (int c4 = 0; c4 < 2; ++c4) {
            f32x4 acc[4][4];
#pragma unroll
            for (int cb = 0; cb < 4; ++cb)
#pragma unroll
                for (int rb = 0; rb < 4; ++rb) acc[cb][rb] = (f32x4){0.f, 0.f, 0.f, 0.f};
#pragma unroll
            for (int ks = 0; ks < 2; ++ks) { bf16x8 f0, f1, f2, f3; unsigned a[8];
#pragma unroll
                for (int i = 0; i < 4; ++i) { a[2 * i] = ibase + tr_read_addr_16(lane, 4 * c4 + i, ks, 0); a[2 * i + 1] = ibase + tr_read_addr_16(lane, 4 * c4 + i, ks, 1); }
                tr_frag4(a[0], a[1], a[2], a[3], a[4], a[5], a[6], a[7], f0, f1, f2, f3);
#pragma unroll
                for (int rb = 0; rb < 4; ++rb) { acc[0][rb] = MFMA16(f0, rf[rb][ks], acc[0][rb]); acc[1][rb] = MFMA16(f1, rf[rb][ks], acc[1][rb]);
                    acc[2][rb] = MFMA16(f2, rf[rb][ks], acc[2][rb]); acc[3][rb] = MFMA16(f3, rf[rb][ks], acc[3][rb]); } }
#pragma unroll
            for (int rb = 0; rb < 4; ++rb) { const int r = 16 * rb + ql; const int uh = (r == 0) ? 0 : (r == 32 ? 1 : (r < 32 ? 2 * r : 2 * (r - 32) + 1));
                bf16* tp = TA + (((size_t)b * 64 + uh) * 128 + s2) * 1024 + 128 * F.wave + 64 * c4 + 4 * g4;
#pragma unroll
                for (int cb = 0; cb < 4; ++cb) { const f32x4 v = acc[cb][rb]; v2u w; w.x = pk2(v.x, v.y); w.y = pk2(v.z, v.w); *(GAS v2u*)(tp + 16 * cb) = w; } }
        }
    }
}

__device__ __forceinline__ void phase_fb(const Params& p, Frame& F) {
    const bf16* TA = (const bf16*)(p.ws + WS_TA); const bf16* MBT = (const bf16*)(p.ws + WS_MBT); bf16* YF = (bf16*)(p.ws + WS_YF); float* Yr4096 = (float*)(p.ws + WS_MISC + 8192);
    const int lane = F.lane, g4 = lane >> 4, ql = lane & 15;
    for (int U = F.vcu; U < NB * 32 * 4; U += F.G) {
        const int b = U >> 7, u = (U >> 2) & 31, cq = U & 3;
        __syncthreads();
        const bf16* src = TA + ((size_t)(b * 32 + u) * 256) * 1024 + cq * 256;
#pragma unroll 4
        for (int i = 0; i < 16; ++i) { const int q = F.tid + 512 * i, row = q >> 5, c32 = q & 31;
            const v4u v = *(const GAS v4u*)(src + (size_t)row * 1024 + c32 * 8);
            *(LAS v4u*)(F.lds + (c32 >> 4) * 65536 + off_b(row, c32 & 15)) = v; }
        __syncthreads();
        f32x4 acc[16][2];
#pragma unroll
        for (int cb = 0; cb < 16; ++cb) { acc[cb][0] = (f32x4){0.f, 0.f, 0.f, 0.f}; acc[cb][1] = (f32x4){0.f, 0.f, 0.f, 0.f}; }
        const bf16* mrow = MBT + ((size_t)u * 256 + 32 * F.wave + ql) * 256 + 8 * g4;
        const unsigned lbase = lds_addr(F.lds);
#pragma unroll 1
        for (int ks = 0; ks < 8; ++ks) {
            const bf16x8 m0 = *(const GAS bf16x8*)(mrow + 32 * ks), m1 = *(const GAS bf16x8*)(mrow + 16 * 256 + 32 * ks);
#pragma unroll
            for (int c4 = 0; c4 < 4; ++c4) { bf16x8 f0, f1, f2, f3; unsigned a[8];
#pragma unroll
                for (int i = 0; i < 4; ++i) { const int cb = 4 * c4 + i; a[2 * i] = lbase + (cb >> 3) * 65536 + tr_read_addr_16(lane, cb & 7, ks, 0); a[2 * i + 1] = lbase + (cb >> 3) * 65536 + tr_read_addr_16(lane, cb & 7, ks, 1); }
                tr_frag4(a[0], a[1], a[2], a[3], a[4], a[5], a[6], a[7], f0, f1, f2, f3);
                acc[4 * c4 + 0][0] = MFMA16(f0, m0, acc[4 * c4 + 0][0]); acc[4 * c4 + 0][1] = MFMA16(f0, m1, acc[4 * c4 + 0][1]);
                acc[4 * c4 + 1][0] = MFMA16(f1, m0, acc[4 * c4 + 1][0]); acc[4 * c4 + 1][1] = MFMA16(f1, m1, acc[4 * c4 + 1][1]);
                acc[4 * c4 + 2][0] = MFMA16(f2, m0, acc[4 * c4 + 2][0]); acc[4 * c4 + 2][1] = MFMA16(f2, m1, acc[4 * c4 + 2][1]);
                acc[4 * c4 + 3][0] = MFMA16(f3, m0, acc[4 * c4 + 3][0]); acc[4 * c4 + 3][1] = MFMA16(f3, m1, acc[4 * c4 + 3][1]); }
        }
#pragma unroll
        for (int mb = 0; mb < 2; ++mb) { const int o = 32 * F.wave + 16 * mb + ql, ri = o >> 7, jj = o & 127;
            bf16* yp = YF + (((size_t)(b * 4096 + u * 128 + jj)) * 2 + ri) * 1024 + cq * 256 + 4 * g4;
#pragma unroll
            for (int cb = 0; cb < 16; ++cb) { const f32x4 v = acc[cb][mb]; v2u w; w.x = pk2(v.x, v.y); w.y = pk2(v.z, v.w); *(GAS v2u*)(yp + 16 * cb) = w; } }
        if (u == 0 && F.tid < 256) {
            const int col = F.tid; const LAS unsigned char* img = F.lds + (col >> 7) * 65536; const int cc = col & 127; float a = 0.f;
            for (int s2 = 0; s2 < 128; ++s2) { const unsigned short hv = *(const LAS unsigned short*)(img + off_b(s2, cc >> 3) + 2 * (cc & 7)); const float v = __builtin_bit_cast(float, (unsigned)hv << 16); a += (s2 & 1) ? -v : v; }
            Yr4096[b * 1024 + cq * 256 + col] = a; }
    }
}

__device__ __forceinline__ void fc_extra(const Params& p, Frame& F, int l) {
    const float* Yr = (const float*)(p.ws + WS_MISC + 8192); float* y4096 = (float*)(p.ws + WS_MISC); const bf16* W = (const bf16*)(p.ws + WS_WFF) + (size_t)(l >> 1) * 2048 * 1024;
    const int gw = F.vcu * NWAVES + F.wave, NGW = F.G * NWAVES;
    for (int o = gw; o < NB * 1024; o += NGW) { const int b = o >> 10, j = o & 1023; float a = 0.f;
#pragma unroll
        for (int i = 0; i < 2; ++i) { const int c = 512 * i + 8 * F.lane; const v4u w = *(const GAS v4u*)(W + (size_t)j * 1024 + c); const f32x4 y0 = *(const GAS f32x4*)(Yr + b * 1024 + c), y1 = *(const GAS f32x4*)(Yr + b * 1024 + c + 4);
            a += y0.x * bf_lo(w.x) + y0.y * bf_hi(w.x) + y0.z * bf_lo(w.y) + y0.w * bf_hi(w.y) + y1.x * bf_lo(w.z) + y1.y * bf_hi(w.z) + y1.z * bf_lo(w.w) + y1.w * bf_hi(w.w); }
        a = wave_sum(a, F.lane); if (F.lane == 0) y4096[o] = a; }
}

__device__ __forceinline__ void pro_small(const Params& p, Frame& F) {
    const int gt = F.vcu * NTHR + F.tid, NGT = F.G * NTHR;
    float* mod = (float*)(p.ws + WS_MOD);
    { LAS float* sc = (LAS float*)F.lds; LAS float* part = sc + 2 * D;
      for (int i = F.tid; i < 2 * D; i += NTHR) { const float cv = p.in[IN_C][i]; sc[i] = cv / (1.f + expf(-cv)); }
      __syncthreads();
      for (int cb = F.vcu; cb < DEPTH * 6 * D / 96; cb += F.G) {
          const int col0 = cb * 96, l = col0 / (6 * D), j0 = col0 - l * 6 * D;
          if (F.tid < 480) { const int cc = F.tid % 96, ks = F.tid / 96; const int k0 = ks * 205, k1 = (k0 + 205 < D) ? k0 + 205 : D;
              const float* w = p.in[IN_WADA] + (size_t)l * D * 6 * D + j0 + cc; float a0 = 0.f, a1 = 0.f;
#pragma unroll 16
              for (int i = k0; i < k1; ++i) { const float wv = w[(size_t)i * 6 * D]; a0 += sc[i] * wv; a1 += sc[D + i] * wv; }
              part[(ks * 2 + 0) * 96 + cc] = a0; part[(ks * 2 + 1) * 96 + cc] = a1; }
          __syncthreads();
          if (F.tid < 192) { const int bb = F.tid / 96, cc = F.tid % 96; float a = p.in[IN_BADA][l * 6 * D + j0 + cc];
#pragma unroll
              for (int ks = 0; ks < 5; ++ks) a += part[(ks * 2 + bb) * 96 + cc];
              mod[((size_t)l * NB + bb) * 6 * D + j0 + cc] = a; }
          __syncthreads(); } }
    { float* par = (float*)(p.ws + WS_PAR);
      for (int i = gt; i < 4096; i += NGT) { par[PAR_NMIX + i] = p.in[IN_NMIX][i]; par[PAR_NFFN + i] = p.in[IN_NFFN][i]; }
      for (int i = gt; i < 128; i += NGT) { par[PAR_QG + i] = p.in[IN_QG][i]; par[PAR_KG + i] = p.in[IN_KG][i]; }
      for (int i = gt; i < 32; i += NGT) par[PAR_SINK + i] = p.in[IN_SINK][i];
      for (int i = gt; i < DEPTH * D * NE; i += NGT) { const int ly = i >> 14, sl = i & 16383, c = sl >> 4, e = sl & 15;
          par[PAR_WR + (ly << 14) + ((((e * 4 + (c >> 8)) * 4 + (c & 3)) << 6) + ((c & 255) >> 2))] = p.in[IN_WR][i]; } }
    float* biasrel = (float*)(p.ws + WS_TAB); bf16* MBT = (bf16*)(p.ws + WS_MBT); bf16* CS = (bf16*)(p.ws + WS_CS);
    for (int i = gt; i < NH * 257; i += NGT) { const int h = i / 257, r = i - h * 257, rel = r - 128, n = rel < 0 ? -rel : rel;
        int bk = (n < 8) ? n : 8 + (n >= 12) + (n >= 16) + (n >= 23) + (n >= 32) + (n >= 46) + (n >= 64) + (n >= 91);
        bk += (rel > 0) ? 16 : 0; biasrel[i] = p.in[IN_RELB][bk * NH + h] * 1.44269504f; }
    { bf16* R64B = (bf16*)(p.ws + WS_TAB + 65536);
      for (int i = gt; i < 64 * 64; i += NGT) { const int r = i >> 6, s = i & 63; float sv, cv;
          if (r <= 32) { sincospif((float)((r * s) & 63) / 32.0f, &sv, &cv); R64B[i] = (bf16)f2bf(cv); } else { sincospif((float)(((r - 32) * s) & 63) / 32.0f, &sv, &cv); R64B[i] = (bf16)f2bf(-sv); } } }
    for (int i = gt; i < 512 * 256; i += NGT) { const int rr = i >> 8, m = i & 255, cs = rr >> 8, nn = rr & 255; float sv, cv; sincospif((float)((nn * m) & 255) / 128.0f, &sv, &cv); CS[i] = (bf16)f2bf(cs ? sv : cv); }
    for (int i = gt; i < 32 * 256 * 256; i += NGT) { const int u = i >> 16, o = (i >> 8) & 255, K = i & 255, ri = o >> 7, j = o & 127, half = K >> 7, s2 = K & 127; float val = 0.f;
        if (u >= 1) { const int k = u + 64 * j; float sv, cv; sincospif((float)((s2 * k) & 8191) / 4096.0f, &sv, &cv);
            val = (ri == 0) ? (half == 0 ? cv : sv) : (half == 0 ? -sv : cv); }
        else { const int blk = j >> 6, k = (blk ? 32 : 0) + 64 * (j & 63); if (half == blk) { float sv, cv; sincospif((float)((s2 * k) & 8191) / 4096.0f, &sv, &cv); val = (ri == 0) ? cv : -sv; } }
        MBT[i] = (bf16)f2bf(val); }
}
__device__ __forceinline__ CvtItem dense_item(const Params& p, int it) {
    constexpr int I_QKV = 16 * 24, I_SQ = 16 * 16; CvtItem ci; int r = it;
    if (r < 2 * I_QKV) { const int j = r / I_QKV; r -= j * I_QKV; const int kt = r / 24, ntile = r % 24;
        ci.src = p.in[IN_WQKV] + (size_t)j * D * QKVN + (size_t)kt * 64 * QKVN + ntile * 64; ci.N = QKVN; ci.dst = (bf16*)(p.ws + WS_WQKV) + ((size_t)j * QKVN + ntile * 64) * D + kt * 64; ci.ldk = D; return ci; }
    r -= 2 * I_QKV; const int which = r / (2 * I_SQ); r -= which * 2 * I_SQ; const int j = r / I_SQ; r -= j * I_SQ; const int kt = r >> 4, ntile = r & 15;
    ci.src = (which ? p.in[IN_WFO] : p.in[IN_WAO]) + (size_t)j * D * D + (size_t)kt * 64 * D + ntile * 64; ci.N = D;
    ci.dst = (bf16*)(p.ws + (which ? WS_WFO : WS_WAO)) + ((size_t)j * D + ntile * 64) * D + kt * 64; ci.ldk = D; return ci;
}
__device__ __forceinline__ void pro_cvt_dense(const Params& p, Frame& F) {
    LAS float* scr = (LAS float*)(F.lds + F.wave * 16640);
    const int gw = F.vcu * NWAVES + F.wave, NGW = F.G * NWAVES;
    constexpr int NIT = 2 * 16 * 24 + 4 * 16 * 16;
    for (int it = gw; it < NIT; it += NGW) { f32x4 v[16]; const CvtItem ci = dense_item(p, it); cvt_load(ci, v, F.lane); cvt_store(ci, v, scr, F.lane); }
}

namespace pg8 {
struct SchedFC { const char* A; const char* B; int G, c;
    __device__ __forceinline__ bool next(int i, Unit& u) const { int tm, tn; if (!tile_of(i, G, c, 32, 8, DENSE_WGM, tm, tn)) return false;
        u.pm = tm; u.pn = tn; u.A = A + (size_t)tm * (256 * 2048 * 2) + (tn >= 4 ? 2048 : 0); u.B = B + (size_t)tn * (256 * 1024 * 2); return true; } };
struct SchedFold { const char* A; const char* B; int G, c;
    __device__ __forceinline__ bool next(int i, Unit& u) const { const long L = (long)i * G + c; if (L >= 64) return false; const int g = (int)L & 3, tm = ((int)L >> 2) & 3, cs = ((int)L >> 4) & 1, jl = (int)L >> 5;
        u.pm = tm + 4 * cs + 8 * jl; u.pn = g; u.A = A + (size_t)jl * (1024 * 1024 * 2) + (size_t)tm * (256 * 1024 * 2) + g * 512; u.B = B + (size_t)cs * (256 * 256 * 2); return true; } };
}

constexpr int NPH_L = 8, NPHASE = 1 + NPH_L * DEPTH;
#ifndef PROBE_MASK
#define PROBE_MASK 0
#endif
#define DUP(bit) _Pragma("unroll 1") for (int rep_ = 0; rep_ < (((PROBE_MASK) >> (bit)) & 1) + 1; ++rep_)
__global__ void __launch_bounds__(NTHR, 2) mk_fwd(Params p) {
    extern __shared__ __attribute__((aligned(16))) unsigned char lds_raw[];
    Frame F; F.lds = (LAS unsigned char*)lds_raw;
    F.tid = threadIdx.x; F.lane = F.tid & 63; F.wave = __builtin_amdgcn_readfirstlane(F.tid >> 6); const int wave0 = F.wave;
    F.G = gridDim.x; { const int bx = blockIdx.x; F.vcu = (F.G % 8 == 0) ? (bx % 8) * (F.G / 8) + bx / 8 : bx; }
    volatile LAS unsigned* MISC = (volatile LAS unsigned*)(F.lds + MISC_OFF);
    if (F.tid < 32) MISC[F.tid] = 0u;
    __syncthreads();
    XcdBarrier bar = xcd_barrier_post((unsigned*)(p.ws + WS_CTL) + CW_BAR, MISC + 8);
#ifndef PROBE_SAMETILE
#define PROBE_SAMETILE 0
#endif
    if (F.tid == 0 && (bar.x != (blockIdx.x & 7u) || gridDim.x != 256u)) (void)xb_add(&bar.bar[XB_MISMAP], 1u);
    const int lo = p.ph_lo, hi = p.ph_hi;
#define IN(k) (lo <= (k) && (k) < hi)
#ifndef PROBE_SAMETILE
#define PROBE_SAMETILE 0
#endif
#ifndef PROBE_NOEPI
#define PROBE_NOEPI 0
#endif
#ifndef PROBE_BAR2
#define PROBE_BAR2 0
#endif
#define SEAM(k) do { if (IN(k) && IN((k) + 1)) { xcd_barrier(bar); if (PROBE_BAR2) xcd_barrier(bar); } } while (0)
#define SEAM_LC(k, c) do { if (IN(k) && IN((k) + 1)) { const bool loc_ = (c) && __builtin_amdgcn_readfirstlane((int)MISC[10]) != 0; xcd_barrier(bar, loc_); } } while (0)
#define SEAM_L(k) SEAM_LC(k, true)
#define RELAUNDER() do { int w_ = wave0; asm volatile("" : "+s"(w_)); F.wave = w_; F.lane = pg8::lane_id_asm(); F.tid = F.wave * 64 + F.lane; } while (0)
#define PHASE_CTX() Params q; do { unsigned long long w_ = (unsigned long long)p.ws, o_ = (unsigned long long)p.out; asm volatile("" : "+s"(w_), "+s"(o_)); q.ws = (unsigned char*)w_; q.out = (float*)o_; RELAUNDER(); } while (0)

    if (IN(0)) DUP(0) {
        RELAUNDER(); pro_small(p, F);
        __syncthreads();
        RELAUNDER(); pro_cvt_dense(p, F);
        const int gw = F.vcu * NWAVES + F.wave, NGW = F.G * NWAVES;
        RELAUNDER(); cvt_moe_layer(p, F, 0, gw, NGW, 3 * 8192);
        if (F.vcu == 0 && F.tid == 0) { unsigned long long* pt = (unsigned long long*)(p.ws + WS_PAR + 512 * 1024); pt[0] = (unsigned long long)p.in[IN_WG]; pt[1] = (unsigned long long)p.in[IN_WU]; pt[2] = (unsigned long long)p.in[IN_WD]; pt[3] = (unsigned long long)p.in[IN_X]; }
        __syncthreads();
    }
    SEAM(0);
    if (lo == 0 && hi == NPHASE) {
        if (F.tid == 0) MISC[10] = (xb_ld(&bar.bar[XB_MISMAP]) == 0u) ? 1u : 0u;
        __syncthreads(); }
    for (int l = 0; l < DEPTH; ++l) {
        const int base = 1 + NPH_L * l; const bool fourier = (l & 1) == 0; const int jl = l >> 1;
        if (IN(base + 0)) DUP(1) {
            PHASE_CTX();
            if (fourier) {
                const float* xin0 = nullptr; if (l == 0) xin0 = (const float*)((const unsigned long long*)(q.ws + WS_PAR + 512 * 1024))[3];
                phase_fa(q, F, l, xin0);
                __syncthreads();
                if (l == 0) {
                pg8::SchedFold Sc{(const char*)(q.ws + WS_WFO), (const char*)(q.ws + WS_CS), F.G, F.vcu};
                pg8::EpiBf16 E{(bf16*)(q.ws + WS_WFF), 1024, nullptr, 1.0f / 1448.15468787f, 0};
                pg8::gemm_phase<pg8::EpiBf16, pg8::SchedFold, 256, 1024, 256>(F.lds, Sc, E, F.wave); }
            } else {
                pg8::SchedPlain Sc{(const char*)(q.ws + WS_H), (const char*)(q.ws + WS_WQKV + (size_t)jl * QKVN * D * 2), (size_t)256 * 1024 * 2, (size_t)256 * 1024 * 2, 64, 6, F.G, (int)blockIdx.x, DENSE_WGM, 0};
                pg8::EpiBf16 E{(bf16*)(q.ws + WS_QKV), QKVN, nullptr, 1.0f, 0};
                pg8::gemm_phase<pg8::EpiBf16, pg8::SchedPlain, 1024, 1024, 1024>(F.lds, Sc, E, F.wave);
                if (CVT_PRE > 0 && F.G == 256 && blockIdx.x >= 128 && rep_ == 0) { RELAUNDER(); __syncthreads();
                    const unsigned long long* pt = (const unsigned long long*)(q.ws + WS_PAR + 512 * 1024);
                    q.in[IN_WG] = (const float*)pt[0]; q.in[IN_WU] = (const float*)pt[1]; q.in[IN_WD] = (const float*)pt[2];
                    const int xs = F.vcu >> 5, w = ((F.vcu & 31) - 16) * NWAVES + F.wave, per = 3 * 8192 / 8;
                    cvt_moe_layer(q, F, l == 1 ? 2 : 3, xs * per + w, 16 * NWAVES, xs * per + CVT_PRE); __syncthreads(); }
            }
        }
        SEAM(base + 0);
        if (IN(base + 1)) DUP(2) {
            PHASE_CTX();
            if (fourier) phase_fb(q, F); else phase_ac(q, F, l);
        }
        SEAM_LC(base + 1, !fourier);
        if (IN(base + 2)) _Pragma("unroll 1") for (int rep_ = 0; rep_ < (((((PROBE_MASK) >> 3) & 1) && fourier) || ((((PROBE_MASK) >> 10) & 1) && !fourier) ? 2 : 1); ++rep_) {
            PHASE_CTX();
            if (fourier) {
                pg8::SchedFC Sc{(const char*)(q.ws + WS_YF), (const char*)(q.ws + WS_WFF + (size_t)jl * 2048 * 1024 * 2), F.G, (int)blockIdx.x};
                pg8::EpiBf16 E{(bf16*)(q.ws + WS_PQ), 2048, nullptr, 1.0f, 0};
                pg8::gemm_phase<pg8::EpiBf16, pg8::SchedFC, 1024, 2048, 1024>(F.lds, Sc, E, F.wave);
                RELAUNDER(); fc_extra(q, F, l);
            } else {
                pg8::SchedPlain Sc{(const char*)(q.ws + WS_O), (const char*)(q.ws + WS_WAO + (size_t)jl * D * D * 2), (size_t)256 * 1024 * 2, (size_t)256 * 1024 * 2, 64, 4, F.G, (int)blockIdx.x, DENSE_WGM, 0};
                pg8::EpiResidB E{(bf16*)(q.ws + (rep_ == 1 ? WS_GOLD : WS_XB)), (const float*)(q.ws + WS_MOD) + (size_t)l * NB * 6 * D + 2 * D};
                pg8::gemm_phase<pg8::EpiResidB, pg8::SchedPlain, 1024, 1024, 1024>(F.lds, Sc, E, F.wave);
            }
        }
        SEAM_LC(base + 2, !fourier);
        if (IN(base + 3)) DUP(4) { PHASE_CTX(); const float* xin = nullptr; if (l == 0) xin = (const float*)((const unsigned long long*)(q.ws + WS_PAR + 512 * 1024))[3]; phase_ma(q, F, l, fourier && rep_ == 0, xin); }
        SEAM(base + 3);
        if (IN(base + 4)) DUP(5) { PHASE_CTX(); phase_mbc(q, F); }
        SEAM_L(base + 4);
        if (IN(base + 5)) DUP(7) {
            PHASE_CTX();
            const int nxg = F.G >> 3, xslot = F.vcu / nxg; const int nper = (2048 + F.G - 1) / F.G, rsplit = (l + 1 < DEPTH) ? (7 - xslot) * nper / 8 : nper;
#ifndef MD_SKEW_TICKS
#define MD_SKEW_TICKS 0
#endif
            if (MD_SKEW_TICKS) { const unsigned long long t0 = __builtin_amdgcn_s_memrealtime(), dl = (unsigned long long)((F.vcu & 3) * MD_SKEW_TICKS);
                while (__builtin_amdgcn_s_memrealtime() - t0 < dl) __builtin_amdgcn_s_sleep(8); }
#pragma unroll 1
            for (int part = 0; part < 2; ++part) {
                pg8::SchedMoE Sc{(const char*)(q.ws + WS_XIN), (const char*)(q.ws + WS_W1 + (size_t)l * NE * 4096 * 1024 * 2), (size_t)256 * 1024 * 2, (size_t)256 * 1024 * 2, 16, F.G, (int)blockIdx.x, part ? rsplit : 0, part ? nper - rsplit : rsplit, (PROBE_SAMETILE && rep_ == 1) ? 1 : 0};
                pg8::EpiSwiGLU E{(bf16*)(q.ws + WS_ACT), 2048, (PROBE_NOEPI && rep_ == 1) ? 1 : 0};
                pg8::gemm_phase<pg8::EpiSwiGLU, pg8::SchedMoE, 1024, 1024, 1024>(F.lds, Sc, E, F.wave);
                if (part == 0 && l + 1 < DEPTH && rep_ == 0) { RELAUNDER();
                    const unsigned long long* pt = (const unsigned long long*)(q.ws + WS_PAR + 512 * 1024);
                    q.in[IN_WG] = (const float*)pt[0]; q.in[IN_WU] = (const float*)pt[1]; q.in[IN_WD] = (const float*)pt[2];
                    const int nslotw = nxg * NWAVES, per = 3 * 8192 / 8;
                    const int pre = (F.G == 256 && l + 1 >= 2) ? CVT_PRE : 0;
                    cvt_moe_layer(q, F, l + 1, xslot * per + pre + (F.vcu - xslot * nxg) * NWAVES + F.wave, nslotw, (xslot + 1) * per); __syncthreads(); }
            }
        }
        SEAM_L(base + 5);
        if (IN(base + 6)) DUP(8) {
            PHASE_CTX();
            pg8::SchedMoE Sc{(const char*)(q.ws + WS_ACT), (const char*)(q.ws + WS_W2 + (size_t)l * NE * 1024 * 2048 * 2), (size_t)256 * 2048 * 2, (size_t)256 * 2048 * 2, 4, F.G, (int)blockIdx.x, 0, 1 << 20, 0};
            pg8::EpiBf16 E{(bf16*)(q.ws + WS_Y), 1024, (const float*)(q.ws + WS_GATE), 1.0f, 0};
            pg8::gemm_phase<pg8::EpiBf16, pg8::SchedMoE, 2048, 2048, 2048>(F.lds, Sc, E, F.wave);
        }
        SEAM(base + 6);
        if (IN(base + 7)) DUP(9) { PHASE_CTX(); phase_mf(q, F, l, rep_ == 1); }
        SEAM_LC(base + 7, fourier);
    }
#undef IN
#undef SEAM
}

#ifndef MK_MODE
#define MK_MODE 0
#endif
extern "C" void kernel_launch(void* const* d_in, const int* in_sizes, int n_in, void* d_out, int out_size, void* d_ws, size_t ws_size, hipStream_t stream) {
    static int grid = 0;
    if (grid == 0) {
        int dev = 0, cus = 0;
        if (n_in != 17 || ws_size < WS_END || hipGetDevice(&dev) != hipSuccess || hipDeviceGetAttribute(&cus, hipDeviceAttributeMultiprocessorCount, dev) != hipSuccess) { fprintf(stderr, "kernel_launch: bad arguments\n"); grid = -1; return; }
        if (hipFuncSetAttribute((const void*)mk_fwd, hipFuncAttributeMaxDynamicSharedMemorySize, LDS_BYTES) != hipSuccess) { fprintf(stderr, "kernel_launch: hipFuncSetAttribute failed\n"); grid = -1; return; }
        int per_cu = 0; (void)hipOccupancyMaxActiveBlocksPerMultiprocessor(&per_cu, (const void*)mk_fwd, NTHR, LDS_BYTES); (void)hipGetLastError();
        grid = cus;
    }
    if (grid < 0) return;
    Params P{}; for (int i = 0; i < 17; ++i) P.in[i] = (const float*)d_in[i]; P.out = (float*)d_out; P.ws = (unsigned char*)d_ws;
#if MK_MODE == 0
    (void)hipMemsetAsync((char*)d_ws + WS_CTL, 0, CTL_ZERO_BYTES, stream);
    P.ph_lo = 0; P.ph_hi = NPHASE; hipLaunchKernelGGL(mk_fwd, dim3(grid), dim3(NTHR), LDS_BYTES, stream, P);
#else
    for (int ph = 0; ph < NPHASE; ++ph) { (void)hipMemsetAsync((char*)d_ws + WS_CTL, 0, CTL_ZERO_BYTES, stream); P.ph_lo = ph; P.ph_hi = ph + 1; hipLaunchKernelGGL(mk_fwd, dim3(grid), dim3(NTHR), LDS_BYTES, stream, P); }
#endif
}
```
